# Optimizing an MI355X kernel written in HIP

```python
import math
import jax, jax.numpy as jnp
from jax import lax
import numpy as np

D_MODEL = 2048
BATCH = 4
SEQ = 4096
DEPTH = 4

GRID_W = 64
CTX_LEN = 256
HEAD_DIM = 128
MIX_HEADS = D_MODEL // HEAD_DIM
SGU_GROUPS = MIX_HEADS // 2
SGU_GROUP_DIM = HEAD_DIM
SGU_W = SGU_GROUPS * SGU_GROUP_DIM
CHUNK = 128
NA_HEADS = MIX_HEADS - SGU_GROUPS
NA_W = NA_HEADS * HEAD_DIM
NA_KH = 8
NA_KW = 16
DIFF_HEADS = (MIX_HEADS * 3) // 4
DIFF_QK_DIM = HEAD_DIM // 2
DIFF_V_DIM = HEAD_DIM
DIFF_QK_W = DIFF_HEADS * 2 * DIFF_QK_DIM
DIFF_V_W = DIFF_HEADS * DIFF_V_DIM
FNET_GROUPS = MIX_HEADS - DIFF_HEADS
FNET_GROUP_DIM = HEAD_DIM
FNET_W = FNET_GROUPS * FNET_GROUP_DIM
IN_WIDTH = 2 * SGU_W + 3 * NA_W
MIX_W = SGU_W + NA_W
D_FF = 4 * D_MODEL
ROPE_THETA = 10000.0
ROPE_AXIS_DIM = DIFF_QK_DIM // 2
Q_BLOCK = 128
N_EVEN = (DEPTH + 1) // 2
N_ODD = DEPTH // 2
RMS_EPS = 1e-6
LN_EPS = 1e-5
ADA_CHUNKS = 6

kernel_name = "hybrid_dit_sgu_natten_diffattn_fnet"

F32 = jnp.float32


def rmsnorm(x, g):
    xf = x.astype(F32)
    y = xf * lax.rsqrt(jnp.mean(jnp.square(xf), axis=-1, keepdims=True) + RMS_EPS)
    return (y * g.astype(F32)).astype(x.dtype)


def modulate(h, shift, scale):
    return h * (1 + scale) + shift


def sq_relu_mlp(h, w1, w2):
    return jnp.square(jax.nn.relu(h @ w1)) @ w2


def chunk_sgu(u, v, g, w_s, b_s):
    bsz, n, _ = u.shape
    shp = (bsz, n // CHUNK, CHUNK, SGU_GROUPS, SGU_GROUP_DIM)
    vf = v.reshape(shp).astype(F32)
    mu = jnp.mean(vf, axis=-1, keepdims=True)
    var = jnp.mean(jnp.square(vf - mu), axis=-1, keepdims=True)
    vn = ((vf - mu) * lax.rsqrt(var + LN_EPS) * g.reshape(SGU_GROUPS, SGU_GROUP_DIM).astype(F32)).astype(v.dtype)
    mixed = jnp.einsum('gpq,bnqgc->bnpgc', w_s, vn) + b_s.T[:, :, None]
    return (u.reshape(shp) * mixed).reshape(bsz, n, SGU_W)


def softmax_attend(q, k, v):
    s = jnp.einsum('bqhd,bkhd->bhqk', q, k).astype(F32)
    p = jax.nn.softmax(s, axis=-1).astype(v.dtype)
    return jnp.einsum('bhqk,bkhd->bqhd', p, v)


def neighbourhood_attention(q, k, v, k_ctx, v_ctx, rows, rpb):
    bsz, n, _ = q.shape
    kh = min(NA_KH, rows)
    kw = NA_KW
    grid = (bsz, rows, GRID_W, NA_HEADS, HEAD_DIM)
    qg = q.reshape(grid) * (HEAD_DIM ** -0.5)
    kg = k.reshape(grid)
    vg = v.reshape(grid)
    col = jnp.arange(GRID_W)
    col_start = jnp.clip(col - kw // 2, 0, GRID_W - kw)
    col_mask = (col[None, :] >= col_start[:, None]) & (col[None, :] < col_start[:, None] + kw)
    dx = jnp.clip(col[None, :] - col[:, None], -(kw - 1), kw - 1) + (kw - 1)
    rpb_x = rpb.astype(F32)[:, :, dx]
    n_loc = kh * GRID_W

    def row_block(r):
        rs = jnp.clip(r - kh // 2, 0, rows - kh)
        kb = lax.dynamic_slice_in_dim(kg, rs, kh, axis=1)
        vb = lax.dynamic_slice_in_dim(vg, rs, kh, axis=1)
        qr = lax.dynamic_index_in_dim(qg, r, axis=1, keepdims=False)
        dy = rs + jnp.arange(kh) - r + (NA_KH - 1)
        bias = jnp.take(rpb_x, dy, axis=1).transpose(0, 2, 1, 3)
        bias = jnp.where(col_mask[:, None, :], bias, -jnp.inf)
        s_loc = jnp.einsum('bqhd,bawhd->bhqaw', qr, kb).astype(F32) + bias[None]
        s_ctx = jnp.einsum('bqhd,bchd->bhqc', qr, k_ctx).astype(F32)
        s = jnp.concatenate([s_loc.reshape(bsz, NA_HEADS, GRID_W, n_loc), s_ctx], axis=-1)
        p = jax.nn.softmax(s, axis=-1).astype(v.dtype)
        p_loc = p[..., :n_loc].reshape(bsz, NA_HEADS, GRID_W, kh, GRID_W)
        p_ctx = p[..., n_loc:]
        return (jnp.einsum('bhqaw,bawhd->bqhd', p_loc, vb)
                + jnp.einsum('bhqc,bchd->bqhd', p_ctx, v_ctx))

    o = lax.map(row_block, jnp.arange(rows))
    return o.transpose(1, 0, 2, 3, 4).reshape(bsz, n, NA_W)


def axial_rope_tables(n):
    t = jnp.arange(n)
    row = (t // GRID_W).astype(F32)
    col = (t % GRID_W).astype(F32)
    inv = ROPE_THETA ** (-jnp.arange(0, ROPE_AXIS_DIM, 2, dtype=F32) / ROPE_AXIS_DIM)
    ang_r = row[:, None] * inv
    ang_c = col[:, None] * inv
    return (jnp.cos(ang_r), jnp.sin(ang_r), jnp.cos(ang_c), jnp.sin(ang_c))


def _rotate(z, cos, sin):
    half = z.shape[-1] // 2
    z1, z2 = z[..., :half], z[..., half:]
    return jnp.concatenate([z1 * cos - z2 * sin, z2 * cos + z1 * sin], axis=-1)


def apply_axial_rope(t, tables):
    cos_r, sin_r, cos_c, sin_c = [a[None, :, None, None, :] for a in tables]
    tf = t.astype(F32)
    out = jnp.concatenate([_rotate(tf[..., :ROPE_AXIS_DIM], cos_r, sin_r),
                           _rotate(tf[..., ROPE_AXIS_DIM:], cos_c, sin_c)], axis=-1)
    return out.astype(t.dtype)


def diff_attend(q, k, v, lam):
    s = jnp.einsum('bqhmd,bkhmd->bhmqk', q, k).astype(F32)
    p = jax.nn.softmax(s, axis=-1)
    a = (p[:, :, 0] - lam * p[:, :, 1]).astype(v.dtype)
    return jnp.einsum('bhqk,bkhd->bqhd', a, v)


def fourier_mix(f):
    bsz, n, _ = f.shape
    fg = f.reshape(bsz, n, FNET_GROUPS, FNET_GROUP_DIM).astype(F32)
    y = jnp.real(jnp.fft.fft2(fg, axes=(1, 3), norm='ortho'))
    return y.astype(f.dtype).reshape(bsz, n, FNET_W)


def even_mixer(p_lat, p_ctx, rows, sgu_g, sgu_w, sgu_b, rpb, need_ctx):
    cuts = [SGU_W, 2 * SGU_W, 2 * SGU_W + NA_W, 2 * SGU_W + 2 * NA_W]
    u, v, q, k, vv = jnp.split(p_lat, cuts, axis=-1)
    uc, vc, qc, kc, vvc = jnp.split(p_ctx, cuts, axis=-1)
    bsz, nc, _ = p_ctx.shape
    kc_h = kc.reshape(bsz, nc, NA_HEADS, HEAD_DIM)
    vc_h = vvc.reshape(bsz, nc, NA_HEADS, HEAD_DIM)
    a_lat = chunk_sgu(u, v, sgu_g, sgu_w, sgu_b)
    b_lat = neighbourhood_attention(q, k, vv, kc_h, vc_h, rows, rpb)
    m_lat = jnp.concatenate([a_lat, b_lat], axis=-1)
    if not need_ctx:
        return m_lat, None
    a_ctx = chunk_sgu(uc, vc, sgu_g, sgu_w, sgu_b)
    qc_h = qc.reshape(bsz, nc, NA_HEADS, HEAD_DIM) * (HEAD_DIM ** -0.5)
    b_ctx = softmax_attend(qc_h, kc_h, vc_h).reshape(bsz, nc, NA_W)
    return m_lat, jnp.concatenate([a_ctx, b_ctx], axis=-1)


def odd_mixer(p_lat, p_ctx, tables, lq1, lk1, lq2, lk2, sub_g, lam_init, need_ctx):
    cuts = [DIFF_QK_W, 2 * DIFF_QK_W, 2 * DIFF_QK_W + DIFF_V_W]
    q, k, v, f = jnp.split(p_lat, cuts, axis=-1)
    qc, kc, vc, fc = jnp.split(p_ctx, cuts, axis=-1)
    bsz, n, _ = p_lat.shape
    nc = p_ctx.shape[1]
    scale = DIFF_QK_DIM ** -0.5
    h5 = lambda t, m: t.reshape(bsz, m, DIFF_HEADS, 2, DIFF_QK_DIM)
    q_lat = apply_axial_rope(h5(q, n), tables) * scale
    k_lat = apply_axial_rope(h5(k, n), tables)
    v_lat = v.reshape(bsz, n, DIFF_HEADS, DIFF_V_DIM)
    k_c = h5(kc, nc)
    v_c = vc.reshape(bsz, nc, DIFF_HEADS, DIFF_V_DIM)
    lam = (jnp.exp(jnp.sum(lq1.astype(F32) * lk1.astype(F32)))
           - jnp.exp(jnp.sum(lq2.astype(F32) * lk2.astype(F32))) + lam_init)
    k_all = jnp.concatenate([k_lat, k_c], axis=1)
    v_all = jnp.concatenate([v_lat, v_c], axis=1)
    qb = q_lat.reshape(bsz, n // Q_BLOCK, Q_BLOCK, DIFF_HEADS, 2, DIFF_QK_DIM).swapaxes(0, 1)
    o = lax.map(lambda qq: diff_attend(qq, k_all, v_all, lam), qb)
    o = o.swapaxes(0, 1).reshape(bsz, n, DIFF_HEADS, DIFF_V_DIM)
    c_lat = (rmsnorm(o, sub_g) * (1 - lam_init)).reshape(bsz, n, DIFF_V_W)
    m_lat = jnp.concatenate([c_lat, fourier_mix(f)], axis=-1)
    if not need_ctx:
        return m_lat, None
    o_c = diff_attend(h5(qc, nc) * scale, k_c, v_c, lam)
    c_ctx = (rmsnorm(o_c, sub_g) * (1 - lam_init)).reshape(bsz, nc, DIFF_V_W)
    return m_lat, jnp.concatenate([c_ctx, fourier_mix(fc)], axis=-1)


def setup_inputs(seed: int = 0) -> dict:
    key = jax.random.key(seed)
    ks = jax.random.split(key, 24)
    nrm = lambda k, shp, s: jax.random.normal(k, shp, F32) * s
    gain = lambda k, shp: 1.0 + nrm(k, shp, 0.05)
    return {
        'x': nrm(ks[0], (BATCH, SEQ, D_MODEL), 1.0),
        'c': nrm(ks[1], (BATCH, D_MODEL), 1.0),
        'ctx': nrm(ks[2], (BATCH, CTX_LEN, D_MODEL), 1.0),
        'c_ctx': nrm(ks[3], (D_MODEL,), 1.0),
        'ada_w': nrm(ks[4], (DEPTH, D_MODEL, ADA_CHUNKS * D_MODEL), 0.5 * D_MODEL ** -0.5),
        'ada_b': nrm(ks[5], (DEPTH, ADA_CHUNKS * D_MODEL), 0.01),
        'norm1_g': gain(ks[6], (DEPTH, D_MODEL)),
        'norm2_g': gain(ks[7], (DEPTH, D_MODEL)),
        'w_in': nrm(ks[8], (DEPTH, D_MODEL, IN_WIDTH), D_MODEL ** -0.5),
        'w_out': nrm(ks[9], (DEPTH, MIX_W, D_MODEL), MIX_W ** -0.5),
        'sgu_norm_g': gain(ks[10], (N_EVEN, SGU_W)),
        'sgu_w': nrm(ks[11], (N_EVEN, SGU_GROUPS, CHUNK, CHUNK), CHUNK ** -0.5),
        'sgu_b': gain(ks[12], (N_EVEN, SGU_GROUPS, CHUNK)),
        'na_rpb': nrm(ks[13], (N_EVEN, NA_HEADS, 2 * NA_KH - 1, 2 * NA_KW - 1), 0.1),
        'diff_lq1': nrm(ks[14], (N_ODD, DIFF_QK_DIM), 0.1),
        'diff_lk1': nrm(ks[15], (N_ODD, DIFF_QK_DIM), 0.1),
        'diff_lq2': nrm(ks[16], (N_ODD, DIFF_QK_DIM), 0.1),
        'diff_lk2': nrm(ks[17], (N_ODD, DIFF_QK_DIM), 0.1),
        'diff_subln_g': gain(ks[18], (N_ODD, DIFF_V_DIM)),
        'mlp_w1': nrm(ks[19], (DEPTH, D_MODEL, D_FF), D_MODEL ** -0.5),
        'mlp_w2': nrm(ks[20], (DEPTH, D_FF, D_MODEL), D_FF ** -0.5),
        'final_g': gain(ks[21], (D_MODEL,)),
    }


def reference(x, c, ctx, c_ctx, ada_w, ada_b, norm1_g, norm2_g, w_in, w_out, sgu_norm_g, sgu_w, sgu_b,
              na_rpb, diff_lq1, diff_lk1, diff_lq2, diff_lk2, diff_subln_g, mlp_w1, mlp_w2, final_g):
    n = x.shape[1]
    rows = n // GRID_W
    tables = axial_rope_tables(n)
    x_lat, x_ctx = x, ctx
    s_lat = jax.nn.silu(c)
    s_ctx = jax.nn.silu(c_ctx)
    for l in range(DEPTH):
        need_ctx = l < DEPTH - 1
        sh1, sc1, g1, sh2, sc2, g2 = jnp.split(s_lat @ ada_w[l] + ada_b[l], ADA_CHUNKS, axis=-1)
        csh1, csc1, cg1, csh2, csc2, cg2 = jnp.split(s_ctx @ ada_w[l] + ada_b[l], ADA_CHUNKS, axis=-1)
        h_lat = modulate(rmsnorm(x_lat, norm1_g[l]), sh1[:, None], sc1[:, None])
        h_ctx = modulate(rmsnorm(x_ctx, norm1_g[l]), csh1, csc1)
        p_lat = h_lat @ w_in[l]
        p_ctx = h_ctx @ w_in[l]
        if l % 2 == 0:
            i = l // 2
            m_lat, m_ctx = even_mixer(p_lat, p_ctx, rows, sgu_norm_g[i], sgu_w[i], sgu_b[i], na_rpb[i], need_ctx)
        else:
            i = l // 2
            lam_init = 0.8 - 0.6 * math.exp(-0.3 * l)
            m_lat, m_ctx = odd_mixer(p_lat, p_ctx, tables, diff_lq1[i], diff_lk1[i], diff_lq2[i], diff_lk2[i],
                                     diff_subln_g[i], lam_init, need_ctx)
        x_lat = x_lat + g1[:, None] * (m_lat @ w_out[l])
        h2 = modulate(rmsnorm(x_lat, norm2_g[l]), sh2[:, None], sc2[:, None])
        x_lat = x_lat + g2[:, None] * sq_relu_mlp(h2, mlp_w1[l], mlp_w2[l])
        if need_ctx:
            x_ctx = x_ctx + cg1 * (m_ctx @ w_out[l])
            h2c = modulate(rmsnorm(x_ctx, norm2_g[l]), csh2, csc2)
            x_ctx = x_ctx + cg2 * sq_relu_mlp(h2c, mlp_w1[l], mlp_w2[l])
    return rmsnorm(x_lat, final_g)
```

```cpp
#include <hip/hip_runtime.h>
#include <cstdio>
#include <cstdint>
namespace pg8 {
#define PG8_LAS __attribute__((address_space(3)))
typedef unsigned short bf16_t;
typedef short bf16x8 __attribute__((ext_vector_type(8)));
typedef float f32x4 __attribute__((ext_vector_type(4)));
typedef unsigned u32x4 __attribute__((ext_vector_type(4)));
constexpr int BM = 256, BK = 64, HALF = 128, HTB = HALF * BK * 2  , STAGE_BYTES = 8 * HTB, NXCD = 8, WGM = 8;

__host__ __device__ __forceinline__ int lds_byte(int r, int c) { const int st = (r >> 4) * 2 + (c >> 5), rr = r & 15, cc = c & 31, ob = rr * 64 + cc * 2; return st * 1024 + (ob ^ (((ob >> 9) & 1) << 5)); }
__host__ __device__ __forceinline__ void stage_rc(int b, int& R, int& C) { const int st = b / 1024, sb = b % 1024, swz = sb ^ (((sb >> 9) & 1) << 5); R = (st >> 1) * 16 + swz / 64; C = (st & 1) * 32 + (swz % 64) / 2; }
__host__ __device__ __forceinline__ int perm32(int rho) { const int n = rho >> 4, i = rho & 15; return 8 * (i >> 2) + 4 * n + (i & 3); }

struct Unit { int pm, pn; };
struct Gemm { const bf16_t* A; const bf16_t* Bt; int M, N, K; };

struct StaticOrder {
    int nM, nN, nwg, G, c;
    __host__ __device__ void init(int M, int N, int G_, int c_) { nM = M / BM; nN = N / BM; nwg = nM * nN; G = G_; c = c_; }
    __host__ __device__ bool next(int i, Unit& u) const {
        const long L = (long)i * G + c; if (L >= nwg) return false;
        int wgid = (int)L; { const int q = nwg / NXCD, r = nwg % NXCD, xcd = wgid % NXCD, off = wgid / NXCD; wgid = (xcd < r ? xcd * (q + 1) : r * (q + 1) + (xcd - r) * q) + off; }
        const int nig = WGM * nN, gid = wgid / nig, fm = gid * WGM, gsz = (nM - fm) < WGM ? (nM - fm) : WGM;
        u.pm = fm + ((wgid % nig) % gsz); u.pn = (wgid % nig) / gsz; return true;
    }
    __device__ __forceinline__ void a_ready(const Unit&) const {}
    __device__ __forceinline__ void done(const Unit&) const {}
};

__device__ __forceinline__ unsigned cvt_pk_bf16(float lo, float hi) { unsigned r; asm volatile("v_cvt_pk_bf16_f32 %0, %1, %2" : "=v"(r) : "v"(lo), "v"(hi)); return r; }

template <int ACT  > struct EpiBf16 {
    static constexpr bool PERM = true, AFTER_DRAIN = false;
    bf16_t* O; int ldc;
    __device__ __forceinline__ void operator()(const f32x4 (&acc)[2][2][4][2], const Unit& u, int wr, int wc, int fr, int fq) const {
        const int row0 = u.pm * BM + wr * 64 + fr; const int col0 = u.pn * BM + wc * 32 + 8 * fq;
#pragma unroll
        for (int ai = 0; ai < 2; ++ai)
#pragma unroll
            for (int m = 0; m < 4; ++m) { bf16_t* rowp = O + (size_t)(row0 + ai * HALF + m * 16) * ldc + col0;
#pragma unroll
                for (int bj = 0; bj < 2; ++bj) { f32x4 v0 = acc[ai][bj][m][0], v1 = acc[ai][bj][m][1];
                    if (ACT == 1) {
#pragma unroll
                        for (int j = 0; j < 4; ++j) { const float a = fmaxf(v0[j], 0.f), b = fmaxf(v1[j], 0.f); v0[j] = a * a; v1[j] = b * b; } }
                    u32x4 w; w.x = cvt_pk_bf16(v0[0], v0[1]); w.y = cvt_pk_bf16(v0[2], v0[3]); w.z = cvt_pk_bf16(v1[0], v1[1]); w.w = cvt_pk_bf16(v1[2], v1[3]);
                    *(u32x4*)(rowp + bj * HALF) = w; } }
    }
};
struct EpiResid {
    static constexpr bool PERM = false, AFTER_DRAIN = false;
    float* X; int ldc; const float* gate; int gate_stride;
    __device__ __forceinline__ void operator()(const f32x4 (&acc)[2][2][4][2], const Unit& u, int wr, int wc, int fr, int fq) const {
        const int row0 = u.pm * BM + wr * 64 + fr, col0 = u.pn * BM + wc * 32 + 4 * fq;
        const float* g = gate + (size_t)(u.pm < 64 ? (u.pm >> 4) : 4) * gate_stride;
        f32x4 gv[2][2];
#pragma unroll
        for (int bj = 0; bj < 2; ++bj)
#pragma unroll
            for (int n = 0; n < 2; ++n) gv[bj][n] = *(const f32x4*)(g + col0 + bj * HALF + n * 16);
#pragma unroll
        for (int ai = 0; ai < 2; ++ai)
#pragma unroll
            for (int m = 0; m < 4; ++m) { float* rowp = X + (size_t)(row0 + ai * HALF + m * 16) * ldc + col0;
#pragma unroll
                for (int bj = 0; bj < 2; ++bj)
#pragma unroll
                    for (int n = 0; n < 2; ++n) { const f32x4 xo = *(const f32x4*)(rowp + bj * HALF + n * 16); *(f32x4*)(rowp + bj * HALF + n * 16) = xo + gv[bj][n] * acc[ai][bj][m][n]; } }
    }
};

template <class Epi, class Sched, bool ALIGN_EPI = false, bool SP2 = false>
__device__ __forceinline__ void gemm_phase(PG8_LAS unsigned char* lds, const Gemm g, const Sched& S, const Epi& E, const int tid) {
    const int wid = __builtin_amdgcn_readfirstlane(tid >> 6), lane = tid & 63, wr = wid >> 2, wc = wid & 3, fr = lane & 15, fq = lane >> 4;
    const int K = g.K, nt = K / BK;
    unsigned voffA[2], voffB[2];
#pragma unroll
    for (int i = 0; i < 2; ++i) { int R, C; stage_rc(tid * 16 + i * 8192, R, C); const int Rb = Epi::PERM ? ((R & ~31) + perm32(R & 31)) : R;
        voffA[i] = (unsigned)(R * K + C) * 2u; voffB[i] = (unsigned)(Rb * K + C) * 2u; }
    const size_t kstep = (size_t)(BK * 2);
    const size_t hstep = (size_t)HALF * K * 2;
    const size_t tstep = 2 * hstep;
    const unsigned ldsw = (unsigned)wid * 1024u;
    const int aoff = lds_byte(wr * 64 + fr, fq * 8), boff = lds_byte(wc * 32 + fr, fq * 8);
#define PG8_SA(b, h) (((b) * 2 + (h)) * HTB)
#define PG8_SB(b, h) ((4 + (b) * 2 + (h)) * HTB)
#define PG8_STAGE(bufoff, gbase, voff) do { _Pragma("unroll") for (int _i = 0; _i < 2; ++_i) \
        __builtin_amdgcn_global_load_lds((const unsigned*)((const char*)(gbase) + (voff)[_i]), (PG8_LAS unsigned*)(lds + (bufoff) + ldsw + _i * 8192), 16, 0, 0); } while (0)
#define PG8_LDA(dst, b, h) do { _Pragma("unroll") for (int m = 0; m < 4; ++m) _Pragma("unroll") for (int k = 0; k < 2; ++k) dst[m][k] = *(const PG8_LAS bf16x8*)(lds + PG8_SA(b, h) + aoff + m * 2048 + k * 1024); } while (0)
#define PG8_LDB(dst, b, h) do { _Pragma("unroll") for (int n = 0; n < 2; ++n) _Pragma("unroll") for (int k = 0; k < 2; ++k) dst[n][k] = *(const PG8_LAS bf16x8*)(lds + PG8_SB(b, h) + boff + n * 2048 + k * 1024); } while (0)
#define PG8_MMA(ai, bj, At, Bt) do { __builtin_amdgcn_s_setprio(1); _Pragma("unroll") for (int m = 0; m < 4; ++m) _Pragma("unroll") for (int n = 0; n < 2; ++n) _Pragma("unroll") for (int k = 0; k < 2; ++k) \
        acc[ai][bj][m][n] = __builtin_amdgcn_mfma_f32_16x16x32_bf16(Bt[n][k], At[m][k], acc[ai][bj][m][n], 0, 0, 0); __builtin_amdgcn_s_setprio(0); } while (0)
#define PG8_WAIT_V(n) asm volatile("s_waitcnt vmcnt(" #n ")" ::: "memory")
#define PG8_WAIT_L(n) asm volatile("s_waitcnt lgkmcnt(" #n ")" ::: "memory")
#define PG8_BAR __builtin_amdgcn_s_barrier()
#define PG8_SCHED __builtin_amdgcn_sched_barrier(0)
    Unit cur, nxt; int ui = 0;
    if (!S.next(0, cur)) return;
    f32x4 acc[2][2][4][2];
#pragma unroll
    for (int a = 0; a < 2; ++a)
#pragma unroll
        for (int b = 0; b < 2; ++b)
#pragma unroll
            for (int m = 0; m < 4; ++m)
#pragma unroll
                for (int n = 0; n < 2; ++n) acc[a][b][m][n] = (f32x4){0.f, 0.f, 0.f, 0.f};
    bf16x8 At[4][2], B0[2][2], B1[2][2];
    const char* cA = (const char*)g.A + (size_t)cur.pm * tstep; const char* cB = (const char*)g.Bt + (size_t)cur.pn * tstep;
    S.a_ready(cur);
    if constexpr (SP2) {
        PG8_STAGE(PG8_SB(0, 0), cB, voffB); PG8_STAGE(PG8_SB(0, 1), cB + hstep, voffB); PG8_STAGE(PG8_SA(0, 0), cA, voffA); PG8_STAGE(PG8_SA(0, 1), cA + hstep, voffA);
        if (wr == 1) PG8_BAR;
        PG8_WAIT_V(2); PG8_BAR;
        PG8_STAGE(PG8_SB(1, 0), cB + kstep, voffB); PG8_STAGE(PG8_SA(1, 0), cA + kstep, voffA); PG8_STAGE(PG8_SB(1, 1), cB + hstep + kstep, voffB);
        PG8_WAIT_V(6); PG8_BAR;
    } else {
        PG8_STAGE(PG8_SB(0, 0), cB, voffB); PG8_STAGE(PG8_SA(0, 0), cA, voffA); PG8_STAGE(PG8_SB(0, 1), cB + hstep, voffB); PG8_STAGE(PG8_SA(0, 1), cA + hstep, voffA);
        if (wr == 1) PG8_BAR;
        PG8_WAIT_V(4); PG8_BAR;
        PG8_STAGE(PG8_SB(1, 0), cB + kstep, voffB); PG8_STAGE(PG8_SA(1, 0), cA + kstep, voffA); PG8_STAGE(PG8_SB(1, 1), cB + hstep + kstep, voffB);
        PG8_WAIT_V(6); PG8_BAR;
    }
    for (;;) {
        const bool has_next = S.next(ui + 1, nxt);
        const char* nA = has_next ? (const char*)g.A + (size_t)nxt.pm * tstep : cA; const char* nB = has_next ? (const char*)g.Bt + (size_t)nxt.pn * tstep : cB;
        for (int t = 0; t < nt; t += 2) {
            const bool last = (t == nt - 2);
            const char* a1 = cA + (size_t)(t + 1) * kstep;
            const char* a2 = last ? nA : cA + (size_t)(t + 2) * kstep; const char* b2 = last ? nB : cB + (size_t)(t + 2) * kstep;
            const char* a3 = a2 + kstep; const char* b3 = b2 + kstep;
            if (last && has_next) S.a_ready(nxt);
            if constexpr (SP2) {
            PG8_LDB(B0, 0, 0); PG8_LDB(B1, 0, 1); PG8_SCHED; PG8_LDA(At, 0, 0); PG8_STAGE(PG8_SA(1, 1), a1 + hstep, voffA);
            PG8_WAIT_V(8); PG8_WAIT_L(0); PG8_BAR; PG8_MMA(0, 0, At, B0); PG8_MMA(0, 1, At, B1); PG8_BAR; PG8_SCHED;
            PG8_LDA(At, 0, 1); PG8_STAGE(PG8_SB(0, 0), b2, voffB); PG8_STAGE(PG8_SB(0, 1), b2 + hstep, voffB); PG8_STAGE(PG8_SA(0, 0), a2, voffA);
            PG8_WAIT_V(8); PG8_WAIT_L(0); PG8_BAR; PG8_MMA(1, 0, At, B0); PG8_MMA(1, 1, At, B1); PG8_BAR; PG8_SCHED;
            PG8_LDB(B0, 1, 0); PG8_LDB(B1, 1, 1); PG8_SCHED; PG8_LDA(At, 1, 0); PG8_STAGE(PG8_SA(0, 1), a2 + hstep, voffA);
            PG8_WAIT_V(8); PG8_WAIT_L(0); PG8_BAR; PG8_MMA(0, 0, At, B0); PG8_MMA(0, 1, At, B1); PG8_BAR; PG8_SCHED;
            PG8_LDA(At, 1, 1); PG8_STAGE(PG8_SB(1, 0), b3, voffB); PG8_STAGE(PG8_SB(1, 1), b3 + hstep, voffB); PG8_STAGE(PG8_SA(1, 0), a3, voffA);
            PG8_WAIT_V(8); PG8_WAIT_L(0); PG8_BAR; PG8_MMA(1, 0, At, B0); PG8_MMA(1, 1, At, B1); PG8_BAR; PG8_SCHED;
            } else {
            PG8_LDB(B0, 0, 0); PG8_SCHED; PG8_LDA(At, 0, 0); PG8_STAGE(PG8_SA(1, 1), a1 + hstep, voffA);
            PG8_WAIT_L(8); PG8_BAR; PG8_WAIT_L(0); PG8_MMA(0, 0, At, B0); PG8_BAR; PG8_SCHED;
            PG8_LDB(B1, 0, 1); PG8_STAGE(PG8_SB(0, 0), b2, voffB);
            PG8_BAR; PG8_WAIT_L(0); PG8_MMA(0, 1, At, B1); PG8_BAR;
            PG8_LDA(At, 0, 1); PG8_STAGE(PG8_SA(0, 0), a2, voffA);
            PG8_BAR; PG8_WAIT_L(0); PG8_MMA(1, 0, At, B0); PG8_BAR; PG8_SCHED;
            PG8_STAGE(PG8_SB(0, 1), b2 + hstep, voffB);
            PG8_WAIT_V(6); PG8_BAR; PG8_MMA(1, 1, At, B1); PG8_BAR;
            PG8_LDB(B0, 1, 0); PG8_SCHED; PG8_LDA(At, 1, 0); PG8_STAGE(PG8_SA(0, 1), a2 + hstep, voffA);
            PG8_WAIT_L(8); PG8_BAR; PG8_WAIT_L(0); PG8_MMA(0, 0, At, B0); PG8_BAR; PG8_SCHED;
            PG8_LDB(B1, 1, 1); PG8_STAGE(PG8_SB(1, 0), b3, voffB);
            PG8_BAR; PG8_WAIT_L(0); PG8_MMA(0, 1, At, B1); PG8_BAR;
            PG8_LDA(At, 1, 1); PG8_STAGE(PG8_SA(1, 0), a3, voffA);
            PG8_BAR; PG8_WAIT_L(0); PG8_MMA(1, 0, At, B0); PG8_BAR; PG8_SCHED;
            PG8_STAGE(PG8_SB(1, 1), b3 + hstep, voffB);
            PG8_WAIT_V(6); PG8_BAR; PG8_MMA(1, 1, At, B1); PG8_BAR;
            }
        }
        if constexpr (ALIGN_EPI) { if (wr == 0) PG8_BAR; }
        if constexpr (!Epi::AFTER_DRAIN) { E(acc, cur, wr, wc, fr, fq); S.done(cur); }
        if (!has_next) break;
#pragma unroll
        for (int a = 0; a < 2; ++a)
#pragma unroll
            for (int b = 0; b < 2; ++b)
#pragma unroll
                for (int m = 0; m < 4; ++m)
#pragma unroll
                    for (int n = 0; n < 2; ++n) acc[a][b][m][n] = (f32x4){0.f, 0.f, 0.f, 0.f};
        cur = nxt; cA = nA; cB = nB; ++ui;
        if constexpr (ALIGN_EPI) { if (wr == 1) PG8_BAR; }
    }
    PG8_WAIT_V(0);
    if constexpr (!ALIGN_EPI) { if (wr == 0) PG8_BAR; }
    PG8_BAR;
    if constexpr (Epi::AFTER_DRAIN) { E.fused(acc, cur, wr, wc, fr, fq, lds, wid, lane); S.done(cur); }
#undef PG8_SA
#undef PG8_SB
#undef PG8_STAGE
#undef PG8_LDA
#undef PG8_LDB
#undef PG8_MMA
#undef PG8_WAIT_V
#undef PG8_WAIT_L
#undef PG8_BAR
#undef PG8_SCHED
}
}

constexpr int NWAVES = 8;
#ifndef MK_ONE_LAUNCH
#define MK_ONE_LAUNCH 0
#endif

constexpr int DM = 2048, NB = 4, SEQ = 4096, DEPTH = 4, NCTX = 256, INW = 5120, DFF = 8192, ADA = 6 * DM;
constexpr int MLAT = NB * SEQ, MCTX = NB * NCTX, MALL = MLAT + MCTX;
constexpr float LAM_INIT1 = 0.35550906759096926f, LAM_INIT3 = 0.5560582041556405f;

constexpr size_t MiB = 1u << 20;
constexpr size_t WS_CTL = 0, CTL_ZERO_BYTES = 1 * MiB;
constexpr size_t WS_MOD = 1 * MiB;
constexpr size_t WS_LAM = 2 * MiB;
constexpr size_t WS_ADAP = 3 * MiB;
constexpr size_t WS_WIN = 16 * MiB, WS_WOUT = 96 * MiB, WS_W1 = 128 * MiB, WS_W2 = 256 * MiB;
constexpr size_t WS_X = 384 * MiB;
constexpr size_t WS_H = 520 * MiB;
constexpr size_t WS_P = 588 * MiB;
constexpr size_t WS_MIX = 758 * MiB;
constexpr size_t WS_HID = 826 * MiB;
constexpr size_t WS_VN = 826 * MiB;
constexpr size_t WS_O12 = 826 * MiB;
constexpr size_t WS_FA = 1030 * MiB, WS_FB = 1064 * MiB;
constexpr size_t WS_END = 1098 * MiB;
constexpr int CW_BAR = 4096;

constexpr int RING_OFF = 0, RING_BYTES = 131072;
constexpr int LDSCTL_OFF = RING_BYTES, MISC_OFF = LDSCTL_OFF + 320;
constexpr int LDS_BYTES = 147456;

#define GAS __attribute__((address_space(1)))
#define LAS __attribute__((address_space(3)))
typedef unsigned short bf16;
typedef unsigned v4u __attribute__((ext_vector_type(4)));
typedef unsigned v2u __attribute__((ext_vector_type(2)));
typedef float f32x4 __attribute__((ext_vector_type(4)));
typedef float f32x2 __attribute__((ext_vector_type(2)));
#define LDS_WAIT() asm volatile("s_waitcnt lgkmcnt(0)" ::: "memory")
__device__ __forceinline__ unsigned f2bf(float f) { unsigned u = __builtin_bit_cast(unsigned, f); return (u + 0x7fffu + ((u >> 16) & 1u)) >> 16; }
__device__ __forceinline__ unsigned pk2(float lo, float hi) { return f2bf(lo) | (f2bf(hi) << 16); }
__device__ __forceinline__ float bf2f(bf16 v) { return __builtin_bit_cast(float, (unsigned)v << 16); }
__device__ __forceinline__ float bflo(unsigned w) { return __builtin_bit_cast(float, w << 16); }
__device__ __forceinline__ float bfhi(unsigned w) { return __builtin_bit_cast(float, w & 0xffff0000u); }
#define XB_TMO      128
#define XB_XCNT(j)  (256  + 64 * (j))
#define XB_XSUB(j)  (1280 + 64 * (j))
#define XB_XGEN(j)  (2304 + 64 * (j))
#define XB_TOP      3328
#define XB_TOPGEN   3392
#define XCD_BAR_WORDS 3456
#define XB_SPIN_CAP (1u << 18)

__device__ __forceinline__ unsigned xb_ld(unsigned* p)              { return __hip_atomic_load(p, __ATOMIC_RELAXED, __HIP_MEMORY_SCOPE_AGENT); }
__device__ __forceinline__ unsigned xb_add(unsigned* p, unsigned v) { return __hip_atomic_fetch_add(p, v, __ATOMIC_RELAXED, __HIP_MEMORY_SCOPE_AGENT); }
__device__ __forceinline__ unsigned xb_xcc_id() { return (unsigned)__builtin_amdgcn_s_getreg((3 << 11) | 20) & 0xFu; }
#define XB_SPIN(cond, bar) do { unsigned _sp = 0; while (cond) { __builtin_amdgcn_s_sleep(1); \
    if ((++_sp & 255u) == 0u) { if (xb_ld(&(bar)[XB_TMO])) break; if (_sp > XB_SPIN_CAP) { atomicAdd(&(bar)[XB_TMO], 1u); break; } } } } while (0)

struct XcdBarrier {
    unsigned* bar; unsigned x;
    volatile LAS unsigned* st;
};

__device__ __forceinline__ XcdBarrier xcd_barrier_post(unsigned* bar, volatile LAS unsigned* st) {
    XcdBarrier b; b.bar = bar; b.x = xb_xcc_id(); b.st = st;
    if (threadIdx.x == 0) (void)xb_add(&bar[XB_XCNT(b.x)], 1u);
    return b;
}
__device__ __forceinline__ void xcd_barrier_complete(unsigned* bar, unsigned x, unsigned& nloc, unsigned& nx) {
    const unsigned G = gridDim.x * gridDim.y * gridDim.z;
    unsigned sum, cnt, mine, sp = 0u;
    for (;;) {
        sum = 0u; cnt = 0u; mine = 0u;
#pragma unroll
        for (unsigned j = 0; j < 16; ++j) { const unsigned c = xb_ld(&bar[XB_XCNT(j)]); sum += c; cnt += (c > 0u) ? 1u : 0u; mine = (j == x) ? c : mine; }
        if (sum == G) break;
        __builtin_amdgcn_s_sleep(1);
        if ((++sp & 255u) == 0u) { if (xb_ld(&bar[XB_TMO])) break; if (sp > XB_SPIN_CAP) { atomicAdd(&bar[XB_TMO], 1u); break; } }
    }
    nloc = mine > 0u ? mine : 1u; nx = cnt > 0u ? cnt : 1u;
}

__device__ __forceinline__ void xcd_barrier(const XcdBarrier& b) {
    asm volatile("s_waitcnt vmcnt(0)" ::: "memory");
    __syncthreads();
    if (threadIdx.x == 0) {
        unsigned* bar = b.bar;
        __builtin_amdgcn_s_waitcnt(0);
        unsigned nloc = b.st[0], nx = b.st[1];
        if (nloc == 0u) { xcd_barrier_complete(bar, b.x, nloc, nx); b.st[0] = nloc; b.st[1] = nx; }
        const unsigned old = xb_add(&bar[XB_XSUB(b.x)], 1u);
        const unsigned gen = old / nloc;
        if (old + 1u == (gen + 1u) * nloc) {
            __builtin_amdgcn_fence(__ATOMIC_RELEASE, "agent");
            asm volatile("s_waitcnt vmcnt(0)" ::: "memory");
            const unsigned og = xb_add(&bar[XB_TOP], 1u);
            const unsigned tg = og / nx;
            if (og + 1u == (tg + 1u) * nx) xb_add(&bar[XB_TOPGEN], 1u);
            else XB_SPIN(xb_ld(&bar[XB_TOPGEN]) == tg, bar);
            __builtin_amdgcn_fence(__ATOMIC_ACQUIRE, "agent");
            xb_add(&bar[XB_XGEN(b.x)], 1u);
            asm volatile("s_waitcnt vmcnt(0)" ::: "memory");
        } else {
            XB_SPIN(xb_ld(&bar[XB_XGEN(b.x)]) == gen, bar);
            __builtin_amdgcn_fence(__ATOMIC_ACQUIRE, "agent");
            asm volatile("s_waitcnt vmcnt(0)" ::: "memory");
        }
    }
    __syncthreads();
}

__device__ __forceinline__ float wave_sum(float v) {
#pragma unroll
    for (int o = 1; o < 64; o <<= 1) v += __shfl_xor(v, o);
    return v;
}
__device__ __forceinline__ void p0_transpose_item(const float* W, int K, int N, bf16* WT, LAS float* scr, int item, int lane) {
    const int nblk = N / 32, kb = item / nblk, nb = item % nblk, k0 = 64 * kb, n0 = 32 * nb;
#pragma unroll 8
    for (int i = 0; i < 32; ++i) { const int kk = 2 * i + (lane >> 5); scr[kk * 33 + (lane & 31)] = W[(size_t)(k0 + kk) * N + n0 + (lane & 31)]; }
    LDS_WAIT(); asm volatile("" ::: "memory");
    const int c = lane & 7;
#pragma unroll
    for (int j = 0; j < 4; ++j) { const int n = (lane >> 3) + 8 * j; const LAS float* s = scr + (8 * c) * 33 + n;
        v4u o; o.x = pk2(s[0 * 33], s[1 * 33]); o.y = pk2(s[2 * 33], s[3 * 33]); o.z = pk2(s[4 * 33], s[5 * 33]); o.w = pk2(s[6 * 33], s[7 * 33]);
        *(GAS v4u*)(WT + (size_t)(n0 + n) * K + k0 + 8 * c) = o; }
    LDS_WAIT(); asm volatile("" ::: "memory");
}

template <int MODE>
__device__ __forceinline__ void norm_rows(const float* X, bf16* H, float* OUT, const float* gain, const float* modl, int sh_chunk, int M, int gw, int NGW, int lane) {
    for (int row = gw; row < M; row += NGW) {
        const GAS f32x4* xr = (const GAS f32x4*)(X + (size_t)row * DM) + lane;
        f32x4 v[8]; float ss = 0.f;
#pragma unroll
        for (int j = 0; j < 8; ++j) { v[j] = xr[64 * j]; ss += (v[j].x * v[j].x + v[j].y * v[j].y) + (v[j].z * v[j].z + v[j].w * v[j].w); }
        const float rstd = 1.0f / sqrtf(wave_sum(ss) * (1.0f / DM) + 1e-6f);
        if (MODE == 0) {
            const float* mr = modl + (size_t)(row < MLAT ? (row >> 12) : 4) * ADA;
            const GAS f32x4* sh = (const GAS f32x4*)(mr + sh_chunk * DM) + lane; const GAS f32x4* sc = (const GAS f32x4*)(mr + (sh_chunk + 1) * DM) + lane;
            const GAS f32x4* gg = (const GAS f32x4*)gain + lane;
            GAS v2u* o8 = (GAS v2u*)(H + (size_t)row * DM) + lane;
#pragma unroll
            for (int j = 0; j < 8; ++j) { const f32x4 g4 = gg[64 * j], s4 = sc[64 * j], h4 = sh[64 * j]; const f32x4 y = v[j] * rstd * g4 * (s4 + 1.0f) + h4;
                v2u w; w.x = pk2(y.x, y.y); w.y = pk2(y.z, y.w); o8[64 * j] = w; }
        } else {
            const GAS f32x4* gg = (const GAS f32x4*)gain + lane; GAS f32x4* o = (GAS f32x4*)(OUT + (size_t)row * DM) + lane;
#pragma unroll
            for (int j = 0; j < 8; ++j) o[64 * j] = v[j] * rstd * gg[64 * j];
        }
    }
}

template <int N> __device__ __forceinline__ float dot_bf(const bf16* kp, const float (&q)[N]) {
    float s = 0.f;
#pragma unroll
    for (int c = 0; c < N / 8; ++c) { const v4u w = ((const GAS v4u*)kp)[c];
        s += q[8 * c + 0] * bflo(w.x) + q[8 * c + 1] * bfhi(w.x) + q[8 * c + 2] * bflo(w.y) + q[8 * c + 3] * bfhi(w.y)
           + q[8 * c + 4] * bflo(w.z) + q[8 * c + 5] * bfhi(w.z) + q[8 * c + 6] * bflo(w.w) + q[8 * c + 7] * bfhi(w.w); }
    return s;
}
template <int DQK, int DVS, class KeyF>
__device__ __forceinline__ void naive_attn(const bf16* P, const float (&q)[DQK], int nkeys, const KeyF& keyf, float (&o)[DVS]) {
    float m = -1e30f, l = 0.f;
    for (int i = 0; i < nkeys; ++i) { size_t koff, voff; float bias; keyf(i, koff, voff, bias);
        const float s = dot_bf<DQK>(P + koff, q) + bias; const float mn = fmaxf(m, s); l = l * __expf(m - mn) + __expf(s - mn); m = mn; }
    const float il = 1.0f / l;
#pragma unroll
    for (int j = 0; j < DVS; ++j) o[j] = 0.f;
    for (int i = 0; i < nkeys; ++i) { size_t koff, voff; float bias; keyf(i, koff, voff, bias);
        const float s = dot_bf<DQK>(P + koff, q) + bias; const float p = __expf(s - m) * il;
#pragma unroll
        for (int c = 0; c < DVS / 8; ++c) { const v4u w = ((const GAS v4u*)(P + voff))[c];
            o[8 * c + 0] += p * bflo(w.x); o[8 * c + 1] += p * bfhi(w.x); o[8 * c + 2] += p * bflo(w.y); o[8 * c + 3] += p * bfhi(w.y);
            o[8 * c + 4] += p * bflo(w.z); o[8 * c + 5] += p * bfhi(w.z); o[8 * c + 6] += p * bflo(w.w); o[8 * c + 7] += p * bfhi(w.w); } }
}
template <int N> __device__ __forceinline__ void load_q(const bf16* qp, float scale, float (&q)[N]) {
#pragma unroll
    for (int c = 0; c < N / 8; ++c) { const v4u w = ((const GAS v4u*)qp)[c];
        q[8 * c + 0] = scale * bflo(w.x); q[8 * c + 1] = scale * bfhi(w.x); q[8 * c + 2] = scale * bflo(w.y); q[8 * c + 3] = scale * bfhi(w.y);
        q[8 * c + 4] = scale * bflo(w.z); q[8 * c + 5] = scale * bfhi(w.z); q[8 * c + 6] = scale * bflo(w.w); q[8 * c + 7] = scale * bfhi(w.w); }
}
template <int N> __device__ __forceinline__ void store_bf(bf16* op, const float (&o)[N]) {
#pragma unroll
    for (int c = 0; c < N / 8; ++c) { v4u w; w.x = pk2(o[8 * c], o[8 * c + 1]); w.y = pk2(o[8 * c + 2], o[8 * c + 3]); w.z = pk2(o[8 * c + 4], o[8 * c + 5]); w.w = pk2(o[8 * c + 6], o[8 * c + 7]); ((GAS v4u*)op)[c] = w; }
}

constexpr int NPH = 39;
struct Args { const float* in[22]; float* out; unsigned char* ws; int ph_lo, ph_hi; };
__global__ void __launch_bounds__(NWAVES * 64, 2) fwd(Args args) {
    extern __shared__ __attribute__((aligned(16))) unsigned char lds_raw[];
    LAS unsigned char* lds = (LAS unsigned char*)lds_raw;
    volatile LAS unsigned* MISC = (volatile LAS unsigned*)(lds + MISC_OFF);
    const int G = gridDim.x;
    typedef const __attribute__((address_space(4))) Args* KArgs;
    const KArgs ka0 = (KArgs)__builtin_amdgcn_kernarg_segment_ptr();
#define KA() ({ KArgs _p = ka0; asm volatile("" : "+s"(_p)); _p; })
#define ARG(i) (KA()->in[i])
#define WSP(T, off) ((T*)(KA()->ws + (off)))
#define THREAD_IDS() int tid = threadIdx.x; asm volatile("" : "+v"(tid)); int bx = blockIdx.x; asm volatile("" : "+s"(bx)); \
    const int lane = tid & 63, wave = __builtin_amdgcn_readfirstlane(tid >> 6); const int gw = bx * NWAVES + wave, NGW = G * NWAVES; const int gt = bx * (NWAVES * 64) + tid, NT = G * NWAVES * 64; \
    (void)lane; (void)wave; (void)gw; (void)NGW; (void)gt; (void)NT;
    {
    THREAD_IDS();
    for (int u = tid; u < (LDS_BYTES - LDSCTL_OFF) / 4; u += NWAVES * 64) ((LAS unsigned*)(lds + LDSCTL_OFF))[u] = 0u;
    __syncthreads();
    }
#if MK_ONE_LAUNCH
    XcdBarrier bar = xcd_barrier_post(WSP(unsigned, WS_CTL) + CW_BAR, MISC + 8);
#define GRID_BAR() xcd_barrier(bar)
#else
    (void)MISC;
#define GRID_BAR() do { } while (0)
#endif
    const int lo = args.ph_lo, hi = args.ph_hi;
#define IN(k) (lo <= (k) && (k) < hi)
#define SEAM(k) do { if (IN(k) && IN((k) + 1)) GRID_BAR(); } while (0)

    if (IN(0)) {
        THREAD_IDS();
        const float* x_in = ARG(0); const float* c_in = ARG(1); const float* ctx_in = ARG(2); const float* cctx_in = ARG(3); const float* ada_w = ARG(4);
        const float* w_in = ARG(8); const float* w_out = ARG(9); const float* mlp_w1 = ARG(19); const float* mlp_w2 = ARG(20);
        const float* lq1 = ARG(14); const float* lk1 = ARG(15); const float* lq2 = ARG(16); const float* lk2 = ARG(17);
        float* ADAP = WSP(float, WS_ADAP); float* LAM = WSP(float, WS_LAM); float* X = WSP(float, WS_X);
        bf16* WIN_T = WSP(bf16, WS_WIN); bf16* WOUT_T = WSP(bf16, WS_WOUT); bf16* W1_T = WSP(bf16, WS_W1); bf16* W2_T = WSP(bf16, WS_W2);
        LAS float* s_lds = (LAS float*)(lds + RING_OFF);
        for (int it = bx; it < DEPTH * 8 * 24; it += G) {
            const int l = it / 192, rem = it % 192, kc = rem / 24, cb = rem % 24;
            __syncthreads();
            for (int i = tid; i < 5 * 256; i += NWAVES * 64) { const int r = i >> 8, k = i & 255; const float cv = r < 4 ? c_in[r * DM + kc * 256 + k] : cctx_in[kc * 256 + k]; s_lds[i] = cv / (1.0f + expf(-cv)); }
            __syncthreads();
            const int col = cb * 512 + tid; float a0 = 0.f, a1 = 0.f, a2 = 0.f, a3 = 0.f, a4 = 0.f;
            const float* wp = ada_w + ((size_t)l * DM + kc * 256) * ADA + col;
#pragma unroll 8
            for (int k = 0; k < 256; ++k) { const float w = wp[(size_t)k * ADA]; a0 += s_lds[k] * w; a1 += s_lds[256 + k] * w; a2 += s_lds[512 + k] * w; a3 += s_lds[768 + k] * w; a4 += s_lds[1024 + k] * w; }
            float* pp = ADAP + ((size_t)(l * 8 + kc) * 5) * ADA + col;
            pp[0] = a0; pp[ADA] = a1; pp[2 * ADA] = a2; pp[3 * ADA] = a3; pp[4 * ADA] = a4;
        }
        __syncthreads();
        LAS float* scr = (LAS float*)(lds + RING_OFF + wave * 16384);
        constexpr int I_IN = (DM / 64) * (INW / 32), I_OUT = (DM / 64) * (DM / 32), I_1 = (DM / 64) * (DFF / 32), I_2 = (DFF / 64) * (DM / 32), I_L = I_IN + I_OUT + I_1 + I_2;
        for (int it = gw; it < DEPTH * I_L; it += NGW) {
            const int l = it / I_L; int r = it % I_L;
            if (r < I_IN) { p0_transpose_item(w_in + (size_t)l * DM * INW, DM, INW, WIN_T + (size_t)l * INW * DM, scr, r, lane); continue; } r -= I_IN;
            if (r < I_OUT) { p0_transpose_item(w_out + (size_t)l * DM * DM, DM, DM, WOUT_T + (size_t)l * DM * DM, scr, r, lane); continue; } r -= I_OUT;
            if (r < I_1) { p0_transpose_item(mlp_w1 + (size_t)l * DM * DFF, DM, DFF, W1_T + (size_t)l * DFF * DM, scr, r, lane); continue; } r -= I_1;
            p0_transpose_item(mlp_w2 + (size_t)l * DFF * DM, DFF, DM, W2_T + (size_t)l * DM * DFF, scr, r, lane);
        }
        for (size_t i = gt; i < (size_t)MALL * DM / 4; i += NT) { const f32x4 v = i < (size_t)MLAT * DM / 4 ? ((const GAS f32x4*)x_in)[i] : ((const GAS f32x4*)ctx_in)[i - (size_t)MLAT * DM / 4]; ((GAS f32x4*)X)[i] = v; }
        if (bx == 0 && tid < 2) { float d1 = 0.f, d2 = 0.f; for (int j = 0; j < 64; ++j) { d1 += lq1[tid * 64 + j] * lk1[tid * 64 + j]; d2 += lq2[tid * 64 + j] * lk2[tid * 64 + j]; }
            LAM[tid] = expf(d1) - expf(d2) + (tid == 0 ? LAM_INIT1 : LAM_INIT3); }
    }
    SEAM(0);
    if (IN(1)) {
        THREAD_IDS();
        const float* ada_b = ARG(5); const float* ADAP = WSP(float, WS_ADAP); float* MOD = WSP(float, WS_MOD);
        for (int i = gt; i < DEPTH * 5 * ADA; i += NT) { const int l = i / (5 * ADA), rc = i % (5 * ADA), col = rc % ADA; float s = ada_b[l * ADA + col];
#pragma unroll
            for (int kc = 0; kc < 8; ++kc) s += ADAP[(size_t)(l * 8 + kc) * 5 * ADA + rc];
            MOD[i] = s; }
    }
    SEAM(1);

    for (int l = 0; l < DEPTH; ++l) {
        const int pb = 2 + 9 * l; const bool odd = (l & 1) != 0, need_ctx = l < DEPTH - 1; const int li = l >> 1;
        const int MR = need_ctx ? MALL : MLAT;
#define MODL() (WSP(float, WS_MOD) + (size_t)l * 5 * ADA)
        if (IN(pb + 0)) { THREAD_IDS(); norm_rows<0>(WSP(float, WS_X), WSP(bf16, WS_H), nullptr, ARG(6) + l * DM, MODL(), 0, MALL, gw, NGW, lane); }
        SEAM(pb + 0);
        if (IN(pb + 1)) {
            THREAD_IDS();
            pg8::Gemm g{WSP(bf16, WS_H), WSP(bf16, WS_WIN) + (size_t)l * INW * DM, MALL, INW, DM}; pg8::StaticOrder S; S.init(MALL, INW, G, bx);
            pg8::EpiBf16<0> E{WSP(bf16, WS_P), INW};
            pg8::gemm_phase<pg8::EpiBf16<0>, pg8::StaticOrder, true, true>(lds + RING_OFF, g, S, E, tid);
        }
        SEAM(pb + 1);
        if (IN(pb + 2)) {
            THREAD_IDS();
            bf16* P = WSP(bf16, WS_P); float* VN = WSP(float, WS_VN); float* FA = WSP(float, WS_FA); float* FB = WSP(float, WS_FB); const float* sgu_g = ARG(10);
            if (!odd) {
                const int g8 = lane >> 3, c0 = (lane & 7) * 16;
                for (int row = gw; row < MALL; row += NGW) {
                    const bf16* vp = P + (size_t)row * INW + 1024 + g8 * 128 + c0; float v[16];
                    load_q<16>(vp, 1.0f, v);
                    float s = 0.f;
#pragma unroll
                    for (int j = 0; j < 16; ++j) s += v[j];
                    s += __shfl_xor(s, 1); s += __shfl_xor(s, 2); s += __shfl_xor(s, 4);
                    const float mu = s * (1.0f / 128.0f); float q = 0.f;
#pragma unroll
                    for (int j = 0; j < 16; ++j) { v[j] -= mu; q += v[j] * v[j]; }
                    q += __shfl_xor(q, 1); q += __shfl_xor(q, 2); q += __shfl_xor(q, 4);
                    const float rstd = 1.0f / sqrtf(q * (1.0f / 128.0f) + 1e-5f);
                    const float* gp = sgu_g + li * 1024 + g8 * 128 + c0; float* op = VN + (size_t)row * 1024 + g8 * 128 + c0;
#pragma unroll
                    for (int j = 0; j < 16; j += 4) { f32x4 o; o.x = v[j] * rstd * gp[j]; o.y = v[j + 1] * rstd * gp[j + 1]; o.z = v[j + 2] * rstd * gp[j + 2]; o.w = v[j + 3] * rstd * gp[j + 3]; *(GAS f32x4*)(op + j) = o; }
                }
            } else {
                for (int idx = gt; idx < MLAT * 12 * 2 * 2 * 32; idx += NT) {
                    const int pi = idx & 31, mp = (idx >> 5) & 1, qk = (idx >> 6) & 1, rest = idx >> 7, hh = rest % 12, row = rest / 12;
                    const int axis = pi >> 4, i = pi & 15, n = row & (SEQ - 1); const float pos = (float)(axis == 0 ? (n >> 6) : (n & 63));
                    const float inv = exp2f(-(float)i * (13.287712379549449f / 16.0f)); const float ang = pos * inv; float sn, cs; sincosf(ang, &sn, &cs);
                    bf16* zp = P + (size_t)row * INW + qk * 1536 + hh * 128 + mp * 64 + axis * 32 + i;
                    const float z1 = bf2f(zp[0]), z2 = bf2f(zp[16]);
                    zp[0] = (bf16)f2bf(z1 * cs - z2 * sn); zp[16] = (bf16)f2bf(z2 * cs + z1 * sn);
                }
                LAS f32x2* tw = (LAS f32x2*)(lds + RING_OFF);
                if (tid < 128) { float sn, cs; sincospif(2.0f * (float)tid / 128.0f, &sn, &cs); tw[tid] = (f32x2){cs, sn}; }
                __syncthreads();
                for (int idx = gt; idx < MALL * 512; idx += NT) {
                    const int row = idx >> 9, gj = idx & 511, g4 = gj >> 7, j = gj & 127; const bf16* xp = P + (size_t)row * INW + 4608 + g4 * 128; float fa = 0.f, fb = 0.f;
                    for (int c8 = 0; c8 < 16; ++c8) { const v4u w = ((const GAS v4u*)xp)[c8]; const float xv[8] = {bflo(w.x), bfhi(w.x), bflo(w.y), bfhi(w.y), bflo(w.z), bfhi(w.z), bflo(w.w), bfhi(w.w)};
#pragma unroll
                        for (int e = 0; e < 8; ++e) { const f32x2 t = tw[(j * (c8 * 8 + e)) & 127]; fa += xv[e] * t.x; fb += xv[e] * t.y; } }
                    FA[idx] = fa; FB[idx] = fb;
                }
                __syncthreads();
            }
        }
        SEAM(pb + 2);
        if (IN(pb + 3)) {
            THREAD_IDS();
            const bf16* P = WSP(bf16, WS_P); bf16* MIX = WSP(bf16, WS_MIX); const float* VN = WSP(float, WS_VN); const float* FA = WSP(float, WS_FA); const float* FB = WSP(float, WS_FB); float* O12 = WSP(float, WS_O12);
            const float* sgu_w = ARG(11); const float* sgu_b = ARG(12); const float* na_rpb = ARG(13);
            if (!odd) {
                for (int idx = gt; idx < MR * 1024; idx += NT) {
                    const int row = idx >> 10, col = idx & 1023, g8 = col >> 7, p = row & 127, cb = row - p;
                    const float* wrow = sgu_w + ((size_t)(li * 8 + g8) * 128 + p) * 128; float acc = sgu_b[(li * 8 + g8) * 128 + p];
                    const float* vp = VN + (size_t)cb * 1024 + col;
#pragma unroll 8
                    for (int q = 0; q < 128; ++q) acc += wrow[q] * vp[(size_t)q * 1024];
                    MIX[(size_t)row * DM + col] = (bf16)f2bf(bf2f(P[(size_t)row * INW + col]) * acc);
                }
                const float* rpb = na_rpb + (size_t)li * 8 * 15 * 31;
                for (int idx = gt; idx < MLAT * 8 * 4; idx += NT) {
                    const int vq = idx & 3, hh = (idx >> 2) & 7, n = (idx >> 5) & (SEQ - 1), b = idx >> 17;
                    const int r = n >> 6, c = n & 63, rs = min(max(r - 4, 0), 56), cs = min(max(c - 8, 0), 48);
                    const size_t qrow = (size_t)b * SEQ + n; float q[128], o[32];
                    load_q<128>(P + qrow * INW + 2048 + hh * 128, 0.08838834764831845f, q);
                    const float* rp = rpb + hh * 15 * 31;
                    auto keyf = [&](int i, size_t& koff, size_t& voff, float& bias) {
                        size_t krow;
                        if (i < 128) { const int a = i >> 4, w = i & 15; krow = (size_t)b * SEQ + (rs + a) * 64 + cs + w; bias = rp[(rs + a - r + 7) * 31 + (cs + w - c + 15)]; }
                        else { krow = (size_t)MLAT + b * NCTX + (i - 128); bias = 0.f; }
                        koff = krow * INW + 3072 + hh * 128; voff = krow * INW + 4096 + hh * 128 + vq * 32; };
                    naive_attn<128, 32>(P, q, 128 + NCTX, keyf, o);
                    store_bf<32>(MIX + qrow * DM + 1024 + hh * 128 + vq * 32, o);
                }
                if (need_ctx) for (int idx = gt; idx < MCTX * 8 * 4; idx += NT) {
                    const int vq = idx & 3, hh = (idx >> 2) & 7, cq = (idx >> 5) & (NCTX - 1), b = idx >> 13;
                    const size_t qrow = (size_t)MLAT + b * NCTX + cq; float q[128], o[32];
                    load_q<128>(P + qrow * INW + 2048 + hh * 128, 0.08838834764831845f, q);
                    auto keyf = [&](int i, size_t& koff, size_t& voff, float& bias) { const size_t krow = (size_t)MLAT + b * NCTX + i; bias = 0.f; koff = krow * INW + 3072 + hh * 128; voff = krow * INW + 4096 + hh * 128 + vq * 32; };
                    naive_attn<128, 32>(P, q, NCTX, keyf, o);
                    store_bf<32>(MIX + qrow * DM + 1024 + hh * 128 + vq * 32, o);
                }
            } else {
                for (int w = gw; w < NB * 12 * 2 * 2 * 64; w += NGW) {
                    const int qb = w & 63, vh = (w >> 6) & 1, mp = (w >> 7) & 1, rest = w >> 8, hh = rest % 12, b = rest / 12;
                    const size_t qrow = (size_t)b * SEQ + qb * 64 + lane; float q[64], o[64];
                    load_q<64>(P + qrow * INW + hh * 128 + mp * 64, 0.125f, q);
                    auto keyf = [&](int i, size_t& koff, size_t& voff, float& bias) { const size_t krow = i < SEQ ? (size_t)b * SEQ + i : (size_t)MLAT + b * NCTX + (i - SEQ); bias = 0.f;
                        koff = krow * INW + 1536 + hh * 128 + mp * 64; voff = krow * INW + 3072 + hh * 128 + vh * 64; };
                    naive_attn<64, 64>(P, q, SEQ + NCTX, keyf, o);
                    float* op = O12 + ((size_t)mp * MALL + qrow) * 1536 + hh * 128 + vh * 64;
#pragma unroll
                    for (int j = 0; j < 64; j += 4) *(GAS f32x4*)(op + j) = (f32x4){o[j], o[j + 1], o[j + 2], o[j + 3]};
                }
                if (need_ctx) for (int w = gw; w < NB * 12 * 2 * 2 * 4; w += NGW) {
                    const int qb = w & 3, vh = (w >> 2) & 1, mp = (w >> 3) & 1, rest = w >> 4, hh = rest % 12, b = rest / 12;
                    const size_t qrow = (size_t)MLAT + b * NCTX + qb * 64 + lane; float q[64], o[64];
                    load_q<64>(P + qrow * INW + hh * 128 + mp * 64, 0.125f, q);
                    auto keyf = [&](int i, size_t& koff, size_t& voff, float& bias) { const size_t krow = (size_t)MLAT + b * NCTX + i; bias = 0.f;
                        koff = krow * INW + 1536 + hh * 128 + mp * 64; voff = krow * INW + 3072 + hh * 128 + vh * 64; };
                    naive_attn<64, 64>(P, q, NCTX, keyf, o);
                    float* op = O12 + ((size_t)mp * MALL + qrow) * 1536 + hh * 128 + vh * 64;
#pragma unroll
                    for (int j = 0; j < 64; j += 4) *(GAS f32x4*)(op + j) = (f32x4){o[j], o[j + 1], o[j + 2], o[j + 3]};
                }
                LAS f32x2* tw = (LAS f32x2*)(lds + RING_OFF);
                for (int t = tid; t < SEQ; t += NWAVES * 64) { float sn, cs; sincospif(2.0f * (float)t / (float)SEQ, &sn, &cs); tw[t] = (f32x2){cs, sn}; }
                __syncthreads();
                for (int idx = gt; idx < NB * 512 * 512; idx += NT) {
                    const int gj = idx & 511, kg = (idx >> 9) & 511, b = idx >> 18; float acc[8];
#pragma unroll
                    for (int e = 0; e < 8; ++e) acc[e] = 0.f;
                    const float* fa = FA + (size_t)b * SEQ * 512 + gj; const float* fb = FB + (size_t)b * SEQ * 512 + gj;
                    for (int n = 0; n < SEQ; ++n) { const float a = fa[(size_t)n * 512], bb = fb[(size_t)n * 512];
#pragma unroll
                        for (int e = 0; e < 8; ++e) { const f32x2 t = tw[((kg + 512 * e) * n) & (SEQ - 1)]; acc[e] += a * t.x - bb * t.y; } }
#pragma unroll
                    for (int e = 0; e < 8; ++e) MIX[((size_t)b * SEQ + kg + 512 * e) * DM + 1536 + gj] = (bf16)f2bf(acc[e] * 0.0013810679320049757f);
                }
                if (need_ctx) for (int idx = gt; idx < NB * NCTX * 512; idx += NT) {
                    const int gj = idx & 511, k = (idx >> 9) & (NCTX - 1), b = idx >> 17; float acc = 0.f;
                    const float* fa = FA + ((size_t)MLAT + b * NCTX) * 512 + gj; const float* fb = FB + ((size_t)MLAT + b * NCTX) * 512 + gj;
                    for (int n = 0; n < NCTX; ++n) { const f32x2 t = tw[((k * n) & (NCTX - 1)) * 16]; acc += fa[(size_t)n * 512] * t.x - fb[(size_t)n * 512] * t.y; }
                    MIX[((size_t)MLAT + b * NCTX + k) * DM + 1536 + gj] = (bf16)f2bf(acc * 0.005524271728019903f);
                }
                __syncthreads();
            }
        }
        SEAM(pb + 3);
        if (IN(pb + 4) && odd) {
            THREAD_IDS();
            const float* O12 = WSP(float, WS_O12); bf16* MIX = WSP(bf16, WS_MIX); const float* subln_g = ARG(18);
            const float lam = WSP(float, WS_LAM)[li], post = 1.0f - (li == 0 ? LAM_INIT1 : LAM_INIT3);
            for (int w = gw; w < MR * 12; w += NGW) {
                const int row = w / 12, hh = w % 12; const size_t off = (size_t)row * 1536 + hh * 128 + 2 * lane;
                const f32x2 a = *(const GAS f32x2*)(O12 + off), b2 = *(const GAS f32x2*)(O12 + (size_t)MALL * 1536 + off);
                const float o0 = a.x - lam * b2.x, o1 = a.y - lam * b2.y; const float ss = wave_sum(o0 * o0 + o1 * o1);
                const float rstd = 1.0f / sqrtf(ss * (1.0f / 128.0f) + 1e-6f); const float* gp = subln_g + li * 128 + 2 * lane;
                *(GAS unsigned*)(MIX + (size_t)row * DM + hh * 128 + 2 * lane) = pk2(o0 * rstd * gp[0] * post, o1 * rstd * gp[1] * post);
            }
        }
        if (odd) SEAM(pb + 4);
        if (IN(pb + 5)) {
            THREAD_IDS();
            pg8::Gemm g{WSP(bf16, WS_MIX), WSP(bf16, WS_WOUT) + (size_t)l * DM * DM, MR, DM, DM}; pg8::StaticOrder S; S.init(MR, DM, G, bx);
            pg8::EpiResid E{WSP(float, WS_X), DM, MODL() + 2 * DM, ADA};
            pg8::gemm_phase<pg8::EpiResid, pg8::StaticOrder, true, true>(lds + RING_OFF, g, S, E, tid);
        }
        SEAM(pb + 5);
        if (IN(pb + 6)) { THREAD_IDS(); norm_rows<0>(WSP(float, WS_X), WSP(bf16, WS_H), nullptr, ARG(7) + l * DM, MODL(), 3, MR, gw, NGW, lane); }
        SEAM(pb + 6);
        if (IN(pb + 7)) {
            THREAD_IDS();
            pg8::Gemm g{WSP(bf16, WS_H), WSP(bf16, WS_W1) + (size_t)l * DFF * DM, MR, DFF, DM}; pg8::StaticOrder S; S.init(MR, DFF, G, bx);
            pg8::EpiBf16<1> E{WSP(bf16, WS_HID), DFF};
            pg8::gemm_phase<pg8::EpiBf16<1>, pg8::StaticOrder, true, true>(lds + RING_OFF, g, S, E, tid);
        }
        SEAM(pb + 7);
        if (IN(pb + 8)) {
            THREAD_IDS();
            pg8::Gemm g{WSP(bf16, WS_HID), WSP(bf16, WS_W2) + (size_t)l * DM * DFF, MR, DM, DFF}; pg8::StaticOrder S; S.init(MR, DM, G, bx);
            pg8::EpiResid E{WSP(float, WS_X), DM, MODL() + 5 * DM, ADA};
            pg8::gemm_phase<pg8::EpiResid, pg8::StaticOrder, true, true>(lds + RING_OFF, g, S, E, tid);
        }
        SEAM(pb + 8);
    }
    if (IN(NPH - 1)) { THREAD_IDS(); norm_rows<1>(WSP(float, WS_X), nullptr, KA()->out, ARG(21), nullptr, 0, MLAT, gw, NGW, lane); }
#undef IN
#undef SEAM
#undef GRID_BAR
}

extern "C" void kernel_launch(void* const* d_in, const int* in_sizes, int n_in, void* d_out, int out_size, void* d_ws, size_t ws_size, hipStream_t stream) {
    static int grid = 0;
    if (grid == 0) {
        if (n_in != 22 || in_sizes[0] != MLAT * DM || out_size != MLAT * DM || ws_size < WS_END) { fprintf(stderr, "kernel_launch: unexpected shapes (n_in %d, in0 %d, out %d, ws %zu); nothing launched\n", n_in, n_in > 0 ? in_sizes[0] : -1, out_size, ws_size); grid = -1; return; }
        int dev = 0, cus = 0, per_cu = 0;
        if (hipGetDevice(&dev) != hipSuccess || hipDeviceGetAttribute(&cus, hipDeviceAttributeMultiprocessorCount, dev) != hipSuccess) { grid = -1; return; }
        if (hipFuncSetAttribute((const void*)fwd, hipFuncAttributeMaxDynamicSharedMemorySize, LDS_BYTES) != hipSuccess) { fprintf(stderr, "kernel_launch: hipFuncSetAttribute failed\n"); grid = -1; return; }
        if (hipOccupancyMaxActiveBlocksPerMultiprocessor(&per_cu, (const void*)fwd, NWAVES * 64, LDS_BYTES) != hipSuccess || per_cu < 1) fprintf(stderr, "kernel_launch: occupancy query reports %d workgroups per CU\n", per_cu);
        (void)hipGetLastError();
        grid = cus;
    }
    if (grid < 0) return;
    if (hipMemsetAsync((char*)d_ws + WS_CTL, 0, CTL_ZERO_BYTES, stream) != hipSuccess) return;
    Args a{};
    for (int i = 0; i < 22; ++i) a.in[i] = (const float*)d_in[i];
    a.out = (float*)d_out; a.ws = (unsigned char*)d_ws;
#if MK_ONE_LAUNCH
    a.ph_lo = 0; a.ph_hi = NPH;
    hipLaunchKernelGGL(fwd, dim3(grid), dim3(NWAVES * 64), LDS_BYTES, stream, a);
#else
    for (int ph = 0; ph < NPH; ++ph) {
        if (ph >= 2 && ph < NPH - 1) { const int l = (ph - 2) / 9, k = (ph - 2) % 9; if (k == 4 && !(l & 1)) continue; }
        a.ph_lo = ph; a.ph_hi = ph + 1;
        hipLaunchKernelGGL(fwd, dim3(grid), dim3(NWAVES * 64), LDS_BYTES, stream, a);
    }
#endif
    const hipError_t le = hipPeekAtLastError();
    if (le != hipSuccess) fprintf(stderr, "kernel_launch: launch failed: %s\n", hipGetErrorName(le));
}
```

```cpp
#include <hip/hip_runtime.h>
#include <cstdio>
#include <cstdint>
namespace pg8 {
#define PG8_LAS __attribute__((address_space(3)))
typedef unsigned short bf16_t;
typedef short bf16x8 __attribute__((ext_vector_type(8)));
typedef float f32x4 __attribute__((ext_vector_type(4)));
typedef unsigned u32x4 __attribute__((ext_vector_type(4)));
constexpr int BM = 256, BK = 64, HALF = 128, HTB = HALF * BK * 2  , STAGE_BYTES = 8 * HTB, NXCD = 8, WGM = 8;

__host__ __device__ __forceinline__ int lds_byte(int r, int c) { const int st = (r >> 4) * 2 + (c >> 5), rr = r & 15, cc = c & 31, ob = rr * 64 + cc * 2; return st * 1024 + (ob ^ (((ob >> 9) & 1) << 5)); }
__host__ __device__ __forceinline__ void stage_rc(int b, int& R, int& C) { const int st = b / 1024, sb = b % 1024, swz = sb ^ (((sb >> 9) & 1) << 5); R = (st >> 1) * 16 + swz / 64; C = (st & 1) * 32 + (swz % 64) / 2; }
__host__ __device__ __forceinline__ int perm32(int rho) { const int n = rho >> 4, i = rho & 15; return 8 * (i >> 2) + 4 * n + (i & 3); }

struct Unit { int pm, pn; };
struct Gemm { const bf16_t* A; const bf16_t* Bt; int M, N, K; };

struct StaticOrder {
    int nM, nN, nwg, G, c;
    __host__ __device__ void init(int M, int N, int G_, int c_) { nM = M / BM; nN = N / BM; nwg = nM * nN; G = G_; c = c_; }
    __host__ __device__ bool next(int i, Unit& u) const {
        const long L = (long)i * G + c; if (L >= nwg) return false;
        int wgid = (int)L; { const int q = nwg / NXCD, r = nwg % NXCD, xcd = wgid % NXCD, off = wgid / NXCD; wgid = (xcd < r ? xcd * (q + 1) : r * (q + 1) + (xcd - r) * q) + off; }
        const int nig = WGM * nN, gid = wgid / nig, fm = gid * WGM, gsz = (nM - fm) < WGM ? (nM - fm) : WGM;
        u.pm = fm + ((wgid % nig) % gsz); u.pn = (wgid % nig) / gsz; return true;
    }
    __device__ __forceinline__ void a_ready(const Unit&) const {}
    __device__ __forceinline__ void done(const Unit&) const {}
};

__device__ __forceinline__ unsigned cvt_pk_bf16(float lo, float hi) { unsigned r; asm volatile("v_cvt_pk_bf16_f32 %0, %1, %2" : "=v"(r) : "v"(lo), "v"(hi)); return r; }

template <int ACT  > struct EpiBf16 {
    static constexpr bool PERM = true, AFTER_DRAIN = false;
    bf16_t* O; int ldc;
    __device__ __forceinline__ void operator()(const f32x4 (&acc)[2][2][4][2], const Unit& u, int wr, int wc, int fr, int fq) const {
        const int row0 = u.pm * BM + wr * 64 + fr; const int col0 = u.pn * BM + wc * 32 + 8 * fq;
#pragma unroll
        for (int ai = 0; ai < 2; ++ai)
#pragma unroll
            for (int m = 0; m < 4; ++m) { bf16_t* rowp = O + (size_t)(row0 + ai * HALF + m * 16) * ldc + col0;
#pragma unroll
                for (int bj = 0; bj < 2; ++bj) { f32x4 v0 = acc[ai][bj][m][0], v1 = acc[ai][bj][m][1];
                    if (ACT == 1) {
#pragma unroll
                        for (int j = 0; j < 4; ++j) { const float a = fmaxf(v0[j], 0.f), b = fmaxf(v1[j], 0.f); v0[j] = a * a; v1[j] = b * b; } }
                    u32x4 w; w.x = cvt_pk_bf16(v0[0], v0[1]); w.y = cvt_pk_bf16(v0[2], v0[3]); w.z = cvt_pk_bf16(v1[0], v1[1]); w.w = cvt_pk_bf16(v1[2], v1[3]);
                    *(u32x4*)(rowp + bj * HALF) = w; } }
    }
};
struct EpiResid {
    static constexpr bool PERM = false, AFTER_DRAIN = false;
    float* X; int ldc; const float* gate; int gate_stride;
    __device__ __forceinline__ void operator()(const f32x4 (&acc)[2][2][4][2], const Unit& u, int wr, int wc, int fr, int fq) const {
        const int row0 = u.pm * BM + wr * 64 + fr, col0 = u.pn * BM + wc * 32 + 4 * fq;
        const float* g = gate + (size_t)(u.pm < 64 ? (u.pm >> 4) : 4) * gate_stride;
        f32x4 gv[2][2];
#pragma unroll
        for (int bj = 0; bj < 2; ++bj)
#pragma unroll
            for (int n = 0; n < 2; ++n) gv[bj][n] = *(const f32x4*)(g + col0 + bj * HALF + n * 16);
#pragma unroll
        for (int ai = 0; ai < 2; ++ai)
#pragma unroll
            for (int m = 0; m < 4; ++m) { float* rowp = X + (size_t)(row0 + ai * HALF + m * 16) * ldc + col0;
#pragma unroll
                for (int bj = 0; bj < 2; ++bj)
#pragma unroll
                    for (int n = 0; n < 2; ++n) { const f32x4 xo = *(const f32x4*)(rowp + bj * HALF + n * 16); *(f32x4*)(rowp + bj * HALF + n * 16) = xo + gv[bj][n] * acc[ai][bj][m][n]; } }
    }
};

template <class Epi, class Sched, bool ALIGN_EPI = false, bool SP2 = false>
__device__ __forceinline__ void gemm_phase(PG8_LAS unsigned char* lds, const Gemm g, const Sched& S, const Epi& E, const int tid) {
    const int wid = __builtin_amdgcn_readfirstlane(tid >> 6), lane = tid & 63, wr = wid >> 2, wc = wid & 3, fr = lane & 15, fq = lane >> 4;
    const int K = g.K, nt = K / BK;
    unsigned voffA[2], voffB[2];
#pragma unroll
    for (int i = 0; i < 2; ++i) { int R, C; stage_rc(tid * 16 + i * 8192, R, C); const int Rb = Epi::PERM ? ((R & ~31) + perm32(R & 31)) : R;
        voffA[i] = (unsigned)(R * K + C) * 2u; voffB[i] = (unsigned)(Rb * K + C) * 2u; }
    const size_t kstep = (size_t)(BK * 2);
    const size_t hstep = (size_t)HALF * K * 2;
    const size_t tstep = 2 * hstep;
    const unsigned ldsw = (unsigned)wid * 1024u;
    const int aoff = lds_byte(wr * 64 + fr, fq * 8), boff = lds_byte(wc * 32 + fr, fq * 8);
#define PG8_SA(b, h) (((b) * 2 + (h)) * HTB)
#define PG8_SB(b, h) ((4 + (b) * 2 + (h)) * HTB)
#define PG8_STAGE(bufoff, gbase, voff) do { _Pragma("unroll") for (int _i = 0; _i < 2; ++_i) \
        __builtin_amdgcn_global_load_lds((const unsigned*)((const char*)(gbase) + (voff)[_i]), (PG8_LAS unsigned*)(lds + (bufoff) + ldsw + _i * 8192), 16, 0, 0); } while (0)
#define PG8_LDA(dst, b, h) do { _Pragma("unroll") for (int m = 0; m < 4; ++m) _Pragma("unroll") for (int k = 0; k < 2; ++k) dst[m][k] = *(const PG8_LAS bf16x8*)(lds + PG8_SA(b, h) + aoff + m * 2048 + k * 1024); } while (0)
#define PG8_LDB(dst, b, h) do { _Pragma("unroll") for (int n = 0; n < 2; ++n) _Pragma("unroll") for (int k = 0; k < 2; ++k) dst[n][k] = *(const PG8_LAS bf16x8*)(lds + PG8_SB(b, h) + boff + n * 2048 + k * 1024); } while (0)
#define PG8_MMA(ai, bj, At, Bt) do { __builtin_amdgcn_s_setprio(1); _Pragma("unroll") for (int m = 0; m < 4; ++m) _Pragma("unroll") for (int n = 0; n < 2; ++n) _Pragma("unroll") for (int k = 0; k < 2; ++k) \
        acc[ai][bj][m][n] = __builtin_amdgcn_mfma_f32_16x16x32_bf16(Bt[n][k], At[m][k], acc[ai][bj][m][n], 0, 0, 0); __builtin_amdgcn_s_setprio(0); } while (0)
#define PG8_WAIT_V(n) asm volatile("s_waitcnt vmcnt(" #n ")" ::: "memory")
#define PG8_WAIT_L(n) asm volatile("s_waitcnt lgkmcnt(" #n ")" ::: "memory")
#define PG8_BAR __builtin_amdgcn_s_barrier()
#define PG8_SCHED __builtin_amdgcn_sched_barrier(0)
    Unit cur, nxt; int ui = 0;
    if (!S.next(0, cur)) return;
    f32x4 acc[2][2][4][2];
#pragma unroll
    for (int a = 0; a < 2; ++a)
#pragma unroll
        for (int b = 0; b < 2; ++b)
#pragma unroll
            for (int m = 0; m < 4; ++m)
#pragma unroll
                for (int n = 0; n < 2; ++n) acc[a][b][m][n] = (f32x4){0.f, 0.f, 0.f, 0.f};
    bf16x8 At[4][2], B0[2][2], B1[2][2];
    const char* cA = (const char*)g.A + (size_t)cur.pm * tstep; const char* cB = (const char*)g.Bt + (size_t)cur.pn * tstep;
    S.a_ready(cur);
    if constexpr (SP2) {
        PG8_STAGE(PG8_SB(0, 0), cB, voffB); PG8_STAGE(PG8_SB(0, 1), cB + hstep, voffB); PG8_STAGE(PG8_SA(0, 0), cA, voffA); PG8_STAGE(PG8_SA(0, 1), cA + hstep, voffA);
        if (wr == 1) PG8_BAR;
        PG8_WAIT_V(2); PG8_BAR;
        PG8_STAGE(PG8_SB(1, 0), cB + kstep, voffB); PG8_STAGE(PG8_SA(1, 0), cA + kstep, voffA); PG8_STAGE(PG8_SB(1, 1), cB + hstep + kstep, voffB);
        PG8_WAIT_V(6); PG8_BAR;
    } else {
        PG8_STAGE(PG8_SB(0, 0), cB, voffB); PG8_STAGE(PG8_SA(0, 0), cA, voffA); PG8_STAGE(PG8_SB(0, 1), cB + hstep, voffB); PG8_STAGE(PG8_SA(0, 1), cA + hstep, voffA);
        if (wr == 1) PG8_BAR;
        PG8_WAIT_V(4); PG8_BAR;
        PG8_STAGE(PG8_SB(1, 0), cB + kstep, voffB); PG8_STAGE(PG8_SA(1, 0), cA + kstep, voffA); PG8_STAGE(PG8_SB(1, 1), cB + hstep + kstep, voffB);
        PG8_WAIT_V(6); PG8_BAR;
    }
    for (;;) {
        const bool has_next = S.next(ui + 1, nxt);
        const char* nA = has_next ? (const char*)g.A + (size_t)nxt.pm * tstep : cA; const char* nB = has_next ? (const char*)g.Bt + (size_t)nxt.pn * tstep : cB;
        for (int t = 0; t < nt; t += 2) {
            const bool last = (t == nt - 2);
            const char* a1 = cA + (size_t)(t + 1) * kstep;
            const char* a2 = last ? nA : cA + (size_t)(t + 2) * kstep; const char* b2 = last ? nB : cB + (size_t)(t + 2) * kstep;
            const char* a3 = a2 + kstep; const char* b3 = b2 + kstep;
            if (last && has_next) S.a_ready(nxt);
            if constexpr (SP2) {
            PG8_LDB(B0, 0, 0); PG8_LDB(B1, 0, 1); PG8_SCHED; PG8_LDA(At, 0, 0); PG8_STAGE(PG8_SA(1, 1), a1 + hstep, voffA);
            PG8_WAIT_V(8); PG8_WAIT_L(0); PG8_BAR; PG8_MMA(0, 0, At, B0); PG8_MMA(0, 1, At, B1); PG8_BAR; PG8_SCHED;
            PG8_LDA(At, 0, 1); PG8_STAGE(PG8_SB(0, 0), b2, voffB); PG8_STAGE(PG8_SB(0, 1), b2 + hstep, voffB); PG8_STAGE(PG8_SA(0, 0), a2, voffA);
            PG8_WAIT_V(8); PG8_WAIT_L(0); PG8_BAR; PG8_MMA(1, 0, At, B0); PG8_MMA(1, 1, At, B1); PG8_BAR; PG8_SCHED;
            PG8_LDB(B0, 1, 0); PG8_LDB(B1, 1, 1); PG8_SCHED; PG8_LDA(At, 1, 0); PG8_STAGE(PG8_SA(0, 1), a2 + hstep, voffA);
            PG8_WAIT_V(8); PG8_WAIT_L(0); PG8_BAR; PG8_MMA(0, 0, At, B0); PG8_MMA(0, 1, At, B1); PG8_BAR; PG8_SCHED;
            PG8_LDA(At, 1, 1); PG8_STAGE(PG8_SB(1, 0), b3, voffB); PG8_STAGE(PG8_SB(1, 1), b3 + hstep, voffB); PG8_STAGE(PG8_SA(1, 0), a3, voffA);
            PG8_WAIT_V(8); PG8_WAIT_L(0); PG8_BAR; PG8_MMA(1, 0, At, B0); PG8_MMA(1, 1, At, B1); PG8_BAR; PG8_SCHED;
            } else {
            PG8_LDB(B0, 0, 0); PG8_SCHED; PG8_LDA(At, 0, 0); PG8_STAGE(PG8_SA(1, 1), a1 + hstep, voffA);
            PG8_WAIT_L(8); PG8_BAR; PG8_WAIT_L(0); PG8_MMA(0, 0, At, B0); PG8_BAR; PG8_SCHED;
            PG8_LDB(B1, 0, 1); PG8_STAGE(PG8_SB(0, 0), b2, voffB);
            PG8_BAR; PG8_WAIT_L(0); PG8_MMA(0, 1, At, B1); PG8_BAR;
            PG8_LDA(At, 0, 1); PG8_STAGE(PG8_SA(0, 0), a2, voffA);
            PG8_BAR; PG8_WAIT_L(0); PG8_MMA(1, 0, At, B0); PG8_BAR; PG8_SCHED;
            PG8_STAGE(PG8_SB(0, 1), b2 + hstep, voffB);
            PG8_WAIT_V(6); PG8_BAR; PG8_MMA(1, 1, At, B1); PG8_BAR;
            PG8_LDB(B0, 1, 0); PG8_SCHED; PG8_LDA(At, 1, 0); PG8_STAGE(PG8_SA(0, 1), a2 + hstep, voffA);
            PG8_WAIT_L(8); PG8_BAR; PG8_WAIT_L(0); PG8_MMA(0, 0, At, B0); PG8_BAR; PG8_SCHED;
            PG8_LDB(B1, 1, 1); PG8_STAGE(PG8_SB(1, 0), b3, voffB);
            PG8_BAR; PG8_WAIT_L(0); PG8_MMA(0, 1, At, B1); PG8_BAR;
            PG8_LDA(At, 1, 1); PG8_STAGE(PG8_SA(1, 0), a3, voffA);
            PG8_BAR; PG8_WAIT_L(0); PG8_MMA(1, 0, At, B0); PG8_BAR; PG8_SCHED;
            PG8_STAGE(PG8_SB(1, 1), b3 + hstep, voffB);
            PG8_WAIT_V(6); PG8_BAR; PG8_MMA(1, 1, At, B1); PG8_BAR;
            }
        }
        if constexpr (ALIGN_EPI) { if (wr == 0) PG8_BAR; }
        if constexpr (!Epi::AFTER_DRAIN) { E(acc, cur, wr, wc, fr, fq); S.done(cur); }
        if (!has_next) break;
#pragma unroll
        for (int a = 0; a < 2; ++a)
#pragma unroll
            for (int b = 0; b < 2; ++b)
#pragma unroll
                for (int m = 0; m < 4; ++m)
#pragma unroll
                    for (int n = 0; n < 2; ++n) acc[a][b][m][n] = (f32x4){0.f, 0.f, 0.f, 0.f};
        cur = nxt; cA = nA; cB = nB; ++ui;
        if constexpr (ALIGN_EPI) { if (wr == 1) PG8_BAR; }
    }
    PG8_WAIT_V(0);
    if constexpr (!ALIGN_EPI) { if (wr == 0) PG8_BAR; }
    PG8_BAR;
    if constexpr (Epi::AFTER_DRAIN) { E.fused(acc, cur, wr, wc, fr, fq, lds, wid, lane); S.done(cur); }
#undef PG8_SA
#undef PG8_SB
#undef PG8_STAGE
#undef PG8_LDA
#undef PG8_LDB
#undef PG8_MMA
#undef PG8_WAIT_V
#undef PG8_WAIT_L
#undef PG8_BAR
#undef PG8_SCHED
}
}

constexpr int NWAVES = 8;
#ifndef MK_ONE_LAUNCH
#define MK_ONE_LAUNCH 1
#endif

constexpr int DM = 2048, NB = 4, SEQ = 4096, DEPTH = 4, NCTX = 256, INW = 5120, DFF = 8192, ADA = 6 * DM;
constexpr int MLAT = NB * SEQ, MCTX = NB * NCTX, MALL = MLAT + MCTX;
constexpr float LAM_INIT1 = 0.35550906759096926f, LAM_INIT3 = 0.5560582041556405f;

constexpr size_t MiB = 1u << 20;
constexpr size_t WS_CTL = 0, CTL_ZERO_BYTES = 1 * MiB;
constexpr size_t WS_MOD = 1 * MiB;
constexpr size_t WS_LAM = 2 * MiB;
constexpr size_t WS_ADAP = 3 * MiB;
constexpr size_t WS_WIN = 16 * MiB, WS_WOUT = 96 * MiB, WS_W1 = 128 * MiB, WS_W2 = 256 * MiB;
constexpr size_t WS_X = 384 * MiB;
constexpr size_t WS_H = 520 * MiB;
constexpr size_t WS_P = 588 * MiB;
constexpr size_t WS_MIX = 758 * MiB;
constexpr size_t WS_HID = 826 * MiB;
constexpr size_t WS_VN = 826 * MiB;
constexpr size_t WS_O12 = 826 * MiB;
constexpr size_t WS_FA = 1030 * MiB, WS_FB = 1064 * MiB;
constexpr size_t WS_END = 1098 * MiB;
constexpr int CW_BAR = 4096;

constexpr int RING_OFF = 0, RING_BYTES = 131072;
constexpr int LDSCTL_OFF = RING_BYTES, MISC_OFF = LDSCTL_OFF + 320;
constexpr int LDS_BYTES = 147456;

#define GAS __attribute__((address_space(1)))
#define LAS __attribute__((address_space(3)))
typedef unsigned short bf16;
typedef unsigned v4u __attribute__((ext_vector_type(4)));
typedef unsigned v2u __attribute__((ext_vector_type(2)));
typedef float f32x4 __attribute__((ext_vector_type(4)));
typedef float f32x2 __attribute__((ext_vector_type(2)));
#define LDS_WAIT() asm volatile("s_waitcnt lgkmcnt(0)" ::: "memory")
__device__ __forceinline__ unsigned f2bf(float f) { unsigned u = __builtin_bit_cast(unsigned, f); return (u + 0x7fffu + ((u >> 16) & 1u)) >> 16; }
__device__ __forceinline__ unsigned pk2(float lo, float hi) { return f2bf(lo) | (f2bf(hi) << 16); }
__device__ __forceinline__ float bf2f(bf16 v) { return __builtin_bit_cast(float, (unsigned)v << 16); }
__device__ __forceinline__ float bflo(unsigned w) { return __builtin_bit_cast(float, w << 16); }
__device__ __forceinline__ float bfhi(unsigned w) { return __builtin_bit_cast(float, w & 0xffff0000u); }
#define XB_TMO      128
#define XB_XCNT(j)  (256  + 64 * (j))
#define XB_XSUB(j)  (1280 + 64 * (j))
#define XB_XGEN(j)  (2304 + 64 * (j))
#define XB_TOP      3328
#define XB_TOPGEN   3392
#define XCD_BAR_WORDS 3456
#define XB_SPIN_CAP (1u << 20)

__device__ __forceinline__ unsigned xb_ld(unsigned* p)              { return __hip_atomic_load(p, __ATOMIC_RELAXED, __HIP_MEMORY_SCOPE_AGENT); }
__device__ __forceinline__ unsigned xb_add(unsigned* p, unsigned v) { return __hip_atomic_fetch_add(p, v, __ATOMIC_RELAXED, __HIP_MEMORY_SCOPE_AGENT); }
__device__ __forceinline__ unsigned xb_xcc_id() { return (unsigned)__builtin_amdgcn_s_getreg((3 << 11) | 20) & 0xFu; }
#define XB_SPIN(cond, bar) do { unsigned _sp = 0; while (cond) { __builtin_amdgcn_s_sleep(1); \
    if ((++_sp & 255u) == 0u) { if (xb_ld(&(bar)[XB_TMO])) break; if (_sp > XB_SPIN_CAP) { atomicAdd(&(bar)[XB_TMO], 1u); break; } } } } while (0)

struct XcdBarrier {
    unsigned* bar; unsigned x;
    volatile LAS unsigned* st;
};

__device__ __forceinline__ XcdBarrier xcd_barrier_post(unsigned* bar, volatile LAS unsigned* st) {
    XcdBarrier b; b.bar = bar; b.x = xb_xcc_id(); b.st = st;
    if (threadIdx.x == 0) (void)xb_add(&bar[XB_XCNT(b.x)], 1u);
    return b;
}
__device__ __forceinline__ void xcd_barrier_complete(unsigned* bar, unsigned x, unsigned& nloc, unsigned& nx) {
    const unsigned G = gridDim.x * gridDim.y * gridDim.z;
    unsigned sum, cnt, mine, sp = 0u;
    for (;;) {
        sum = 0u; cnt = 0u; mine = 0u;
#pragma unroll
        for (unsigned j = 0; j < 16; ++j) { const unsigned c = xb_ld(&bar[XB_XCNT(j)]); sum += c; cnt += (c > 0u) ? 1u : 0u; mine = (j == x) ? c : mine; }
        if (sum == G) break;
        __builtin_amdgcn_s_sleep(1);
        if ((++sp & 255u) == 0u) { if (xb_ld(&bar[XB_TMO])) break; if (sp > XB_SPIN_CAP) { atomicAdd(&bar[XB_TMO], 1u); break; } }
    }
    nloc = mine > 0u ? mine : 1u; nx = cnt > 0u ? cnt : 1u;
}

__device__ __forceinline__ void xcd_barrier(const XcdBarrier& b) {
    asm volatile("s_waitcnt vmcnt(0)" ::: "memory");
    __syncthreads();
    if (threadIdx.x == 0) {
        unsigned* bar = b.bar;
        __builtin_amdgcn_s_waitcnt(0);
        unsigned nloc = b.st[0], nx = b.st[1];
        if (nloc == 0u) { xcd_barrier_complete(bar, b.x, nloc, nx); b.st[0] = nloc; b.st[1] = nx; }
        const unsigned old = xb_add(&bar[XB_XSUB(b.x)], 1u);
        const unsigned gen = old / nloc;
        if (old + 1u == (gen + 1u) * nloc) {
            __builtin_amdgcn_fence(__ATOMIC_RELEASE, "agent");
            asm volatile("s_waitcnt vmcnt(0)" ::: "memory");
            const unsigned og = xb_add(&bar[XB_TOP], 1u);
            const unsigned tg = og / nx;
            if (og + 1u == (tg + 1u) * nx) xb_add(&bar[XB_TOPGEN], 1u);
            else XB_SPIN(xb_ld(&bar[XB_TOPGEN]) == tg, bar);
            __builtin_amdgcn_fence(__ATOMIC_ACQUIRE, "agent");
            xb_add(&bar[XB_XGEN(b.x)], 1u);
            asm volatile("s_waitcnt vmcnt(0)" ::: "memory");
        } else {
            XB_SPIN(xb_ld(&bar[XB_XGEN(b.x)]) == gen, bar);
            __builtin_amdgcn_fence(__ATOMIC_ACQUIRE, "agent");
            asm volatile("s_waitcnt vmcnt(0)" ::: "memory");
        }
    }
    __syncthreads();
}

__device__ __forceinline__ float wave_sum(float v) {
#pragma unroll
    for (int o = 1; o < 64; o <<= 1) v += __shfl_xor(v, o);
    return v;
}
__device__ __forceinline__ void p0_transpose_item(const float* W, int K, int N, bf16* WT, LAS float* scr, int item, int lane) {
    const int nblk = N / 32, kb = item / nblk, nb = item % nblk, k0 = 64 * kb, n0 = 32 * nb;
#pragma unroll 8
    for (int i = 0; i < 32; ++i) { const int kk = 2 * i + (lane >> 5); scr[kk * 33 + (lane & 31)] = W[(size_t)(k0 + kk) * N + n0 + (lane & 31)]; }
    LDS_WAIT(); asm volatile("" ::: "memory");
    const int c = lane & 7;
#pragma unroll
    for (int j = 0; j < 4; ++j) { const int n = (lane >> 3) + 8 * j; const LAS float* s = scr + (8 * c) * 33 + n;
        v4u o; o.x = pk2(s[0 * 33], s[1 * 33]); o.y = pk2(s[2 * 33], s[3 * 33]); o.z = pk2(s[4 * 33], s[5 * 33]); o.w = pk2(s[6 * 33], s[7 * 33]);
        *(GAS v4u*)(WT + (size_t)(n0 + n) * K + k0 + 8 * c) = o; }
    LDS_WAIT(); asm volatile("" ::: "memory");
}

template <int MODE>
__device__ __forceinline__ void norm_rows(const float* X, bf16* H, float* OUT, const float* gain, const float* modl, int sh_chunk, int M, int gw, int NGW, int lane) {
    for (int row = gw; row < M; row += NGW) {
        const GAS f32x4* xr = (const GAS f32x4*)(X + (size_t)row * DM) + lane;
        f32x4 v[8]; float ss = 0.f;
#pragma unroll
        for (int j = 0; j < 8; ++j) { v[j] = xr[64 * j]; ss += (v[j].x * v[j].x + v[j].y * v[j].y) + (v[j].z * v[j].z + v[j].w * v[j].w); }
        const float rstd = 1.0f / sqrtf(wave_sum(ss) * (1.0f / DM) + 1e-6f);
        if (MODE == 0) {
            const float* mr = modl + (size_t)(row < MLAT ? (row >> 12) : 4) * ADA;
            const GAS f32x4* sh = (const GAS f32x4*)(mr + sh_chunk * DM) + lane; const GAS f32x4* sc = (const GAS f32x4*)(mr + (sh_chunk + 1) * DM) + lane;
            const GAS f32x4* gg = (const GAS f32x4*)gain + lane;
            GAS v2u* o8 = (GAS v2u*)(H + (size_t)row * DM) + lane;
#pragma unroll
            for (int j = 0; j < 8; ++j) { const f32x4 g4 = gg[64 * j], s4 = sc[64 * j], h4 = sh[64 * j]; const f32x4 y = v[j] * rstd * g4 * (s4 + 1.0f) + h4;
                v2u w; w.x = pk2(y.x, y.y); w.y = pk2(y.z, y.w); o8[64 * j] = w; }
        } else {
            const GAS f32x4* gg = (const GAS f32x4*)gain + lane; GAS f32x4* o = (GAS f32x4*)(OUT + (size_t)row * DM) + lane;
#pragma unroll
            for (int j = 0; j < 8; ++j) o[64 * j] = v[j] * rstd * gg[64 * j];
        }
    }
}

template <int N> __device__ __forceinline__ float dot_bf(const bf16* kp, const float (&q)[N]) {
    float s = 0.f;
#pragma unroll
    for (int c = 0; c < N / 8; ++c) { const v4u w = ((const GAS v4u*)kp)[c];
        s += q[8 * c + 0] * bflo(w.x) + q[8 * c + 1] * bfhi(w.x) + q[8 * c + 2] * bflo(w.y) + q[8 * c + 3] * bfhi(w.y)
           + q[8 * c + 4] * bflo(w.z) + q[8 * c + 5] * bfhi(w.z) + q[8 * c + 6] * bflo(w.w) + q[8 * c + 7] * bfhi(w.w); }
    return s;
}
template <int DQK, int DVS, class KeyF>
__device__ __forceinline__ void naive_attn(const bf16* P, const float (&q)[DQK], int nkeys, const KeyF& keyf, float (&o)[DVS]) {
    float m = -1e30f, l = 0.f;
    for (int i = 0; i < nkeys; ++i) { size_t koff, voff; float bias; keyf(i, koff, voff, bias);
        const float s = dot_bf<DQK>(P + koff, q) + bias; const float mn = fmaxf(m, s); l = l * __expf(m - mn) + __expf(s - mn); m = mn; }
    const float il = 1.0f / l;
#pragma unroll
    for (int j = 0; j < DVS; ++j) o[j] = 0.f;
    for (int i = 0; i < nkeys; ++i) { size_t koff, voff; float bias; keyf(i, koff, voff, bias);
        const float s = dot_bf<DQK>(P + koff, q) + bias; const float p = __expf(s - m) * il;
#pragma unroll
        for (int c = 0; c < DVS / 8; ++c) { const v4u w = ((const GAS v4u*)(P + voff))[c];
            o[8 * c + 0] += p * bflo(w.x); o[8 * c + 1] += p * bfhi(w.x); o[8 * c + 2] += p * bflo(w.y); o[8 * c + 3] += p * bfhi(w.y);
            o[8 * c + 4] += p * bflo(w.z); o[8 * c + 5] += p * bfhi(w.z); o[8 * c + 6] += p * bflo(w.w); o[8 * c + 7] += p * bfhi(w.w); } }
}
template <int N> __device__ __forceinline__ void load_q(const bf16* qp, float scale, float (&q)[N]) {
#pragma unroll
    for (int c = 0; c < N / 8; ++c) { const v4u w = ((const GAS v4u*)qp)[c];
        q[8 * c + 0] = scale * bflo(w.x); q[8 * c + 1] = scale * bfhi(w.x); q[8 * c + 2] = scale * bflo(w.y); q[8 * c + 3] = scale * bfhi(w.y);
        q[8 * c + 4] = scale * bflo(w.z); q[8 * c + 5] = scale * bfhi(w.z); q[8 * c + 6] = scale * bflo(w.w); q[8 * c + 7] = scale * bfhi(w.w); }
}
template <int N> __device__ __forceinline__ void store_bf(bf16* op, const float (&o)[N]) {
#pragma unroll
    for (int c = 0; c < N / 8; ++c) { v4u w; w.x = pk2(o[8 * c], o[8 * c + 1]); w.y = pk2(o[8 * c + 2], o[8 * c + 3]); w.z = pk2(o[8 * c + 4], o[8 * c + 5]); w.w = pk2(o[8 * c + 6], o[8 * c + 7]); ((GAS v4u*)op)[c] = w; }
}

constexpr int NPH = 39;
struct Args { const float* in[22]; float* out; unsigned char* ws; int ph_lo, ph_hi; };
__global__ void __launch_bounds__(NWAVES * 64, 2) fwd(Args args) {
    extern __shared__ __attribute__((aligned(16))) unsigned char lds_raw[];
    LAS unsigned char* lds = (LAS unsigned char*)lds_raw;
    volatile LAS unsigned* MISC = (volatile LAS unsigned*)(lds + MISC_OFF);
    const int G = gridDim.x;
    typedef const __attribute__((address_space(4))) Args* KArgs;
    const KArgs ka0 = (KArgs)__builtin_amdgcn_kernarg_segment_ptr();
#define KA() ({ KArgs _p = ka0; asm volatile("" : "+s"(_p)); _p; })
#define ARG(i) (KA()->in[i])
#define WSP(T, off) ((T*)(KA()->ws + (off)))
#define THREAD_IDS() int tid = threadIdx.x; asm volatile("" : "+v"(tid)); int bx = blockIdx.x; asm volatile("" : "+s"(bx)); \
    const int lane = tid & 63, wave = __builtin_amdgcn_readfirstlane(tid >> 6); const int gw = bx * NWAVES + wave, NGW = G * NWAVES; const int gt = bx * (NWAVES * 64) + tid, NT = G * NWAVES * 64; \
    (void)lane; (void)wave; (void)gw; (void)NGW; (void)gt; (void)NT;
    {
    THREAD_IDS();
    for (int u = tid; u < (LDS_BYTES - LDSCTL_OFF) / 4; u += NWAVES * 64) ((LAS unsigned*)(lds + LDSCTL_OFF))[u] = 0u;
    __syncthreads();
    }
#if MK_ONE_LAUNCH
    XcdBarrier bar = xcd_barrier_post(WSP(unsigned, WS_CTL) + CW_BAR, MISC + 8);
#define GRID_BAR() xcd_barrier(bar)
#else
    (void)MISC;
#define GRID_BAR() do { } while (0)
#endif
    const int lo = args.ph_lo, hi = args.ph_hi;
#define IN(k) (lo <= (k) && (k) < hi)
#define SEAM(k) do { if (IN(k) && IN((k) + 1)) GRID_BAR(); } while (0)

    if (IN(0)) {
        THREAD_IDS();
        const float* x_in = ARG(0); const float* c_in = ARG(1); const float* ctx_in = ARG(2); const float* cctx_in = ARG(3); const float* ada_w = ARG(4);
        const float* w_in = ARG(8); const float* w_out = ARG(9); const float* mlp_w1 = ARG(19); const float* mlp_w2 = ARG(20);
        const float* lq1 = ARG(14); const float* lk1 = ARG(15); const float* lq2 = ARG(16); const float* lk2 = ARG(17);
        float* ADAP = WSP(float, WS_ADAP); float* LAM = WSP(float, WS_LAM); float* X = WSP(float, WS_X);
        bf16* WIN_T = WSP(bf16, WS_WIN); bf16* WOUT_T = WSP(bf16, WS_WOUT); bf16* W1_T = WSP(bf16, WS_W1); bf16* W2_T = WSP(bf16, WS_W2);
        LAS float* s_lds = (LAS float*)(lds + RING_OFF);
        for (int it = bx; it < DEPTH * 8 * 24; it += G) {
            const int l = it / 192, rem = it % 192, kc = rem / 24, cb = rem % 24;
            __syncthreads();
            for (int i = tid; i < 5 * 256; i += NWAVES * 64) { const int r = i >> 8, k = i & 255; const float cv = r < 4 ? c_in[r * DM + kc * 256 + k] : cctx_in[kc * 256 + k]; s_lds[i] = cv / (1.0f + expf(-cv)); }
            __syncthreads();
            const int col = cb * 512 + tid; float a0 = 0.f, a1 = 0.f, a2 = 0.f, a3 = 0.f, a4 = 0.f;
            const float* wp = ada_w + ((size_t)l * DM + kc * 256) * ADA + col;
#pragma unroll 8
            for (int k = 0; k < 256; ++k) { const float w = wp[(size_t)k * ADA]; a0 += s_lds[k] * w; a1 += s_lds[256 + k] * w; a2 += s_lds[512 + k] * w; a3 += s_lds[768 + k] * w; a4 += s_lds[1024 + k] * w; }
            float* pp = ADAP + ((size_t)(l * 8 + kc) * 5) * ADA + col;
            pp[0] = a0; pp[ADA] = a1; pp[2 * ADA] = a2; pp[3 * ADA] = a3; pp[4 * ADA] = a4;
        }
        __syncthreads();
        LAS float* scr = (LAS float*)(lds + RING_OFF + wave * 16384);
        constexpr int I_IN = (DM / 64) * (INW / 32), I_OUT = (DM / 64) * (DM / 32), I_1 = (DM / 64) * (DFF / 32), I_2 = (DFF / 64) * (DM / 32), I_L = I_IN + I_OUT + I_1 + I_2;
        for (int it = gw; it < DEPTH * I_L; it += NGW) {
            const int l = it / I_L; int r = it % I_L;
            if (r < I_IN) { p0_transpose_item(w_in + (size_t)l * DM * INW, DM, INW, WIN_T + (size_t)l * INW * DM, scr, r, lane); continue; } r -= I_IN;
            if (r < I_OUT) { p0_transpose_item(w_out + (size_t)l * DM * DM, DM, DM, WOUT_T + (size_t)l * DM * DM, scr, r, lane); continue; } r -= I_OUT;
            if (r < I_1) { p0_transpose_item(mlp_w1 + (size_t)l * DM * DFF, DM, DFF, W1_T + (size_t)l * DFF * DM, scr, r, lane); continue; } r -= I_1;
            p0_transpose_item(mlp_w2 + (size_t)l * DFF * DM, DFF, DM, W2_T + (size_t)l * DM * DFF, scr, r, lane);
        }
        for (size_t i = gt; i < (size_t)MALL * DM / 4; i += NT) { const f32x4 v = i < (size_t)MLAT * DM / 4 ? ((const GAS f32x4*)x_in)[i] : ((const GAS f32x4*)ctx_in)[i - (size_t)MLAT * DM / 4]; ((GAS f32x4*)X)[i] = v; }
        if (bx == 0 && tid < 2) { float d1 = 0.f, d2 = 0.f; for (int j = 0; j < 64; ++j) { d1 += lq1[tid * 64 + j] * lk1[tid * 64 + j]; d2 += lq2[tid * 64 + j] * lk2[tid * 64 + j]; }
            LAM[tid] = expf(d1) - expf(d2) + (tid == 0 ? LAM_INIT1 : LAM_INIT3); }
    }
    SEAM(0);
    if (IN(1)) {
        THREAD_IDS();
        const float* ada_b = ARG(5); const float* ADAP = WSP(float, WS_ADAP); float* MOD = WSP(float, WS_MOD);
        for (int i = gt; i < DEPTH * 5 * ADA; i += NT) { const int l = i / (5 * ADA), rc = i % (5 * ADA), col = rc % ADA; float s = ada_b[l * ADA + col];
#pragma unroll
            for (int kc = 0; kc < 8; ++kc) s += ADAP[(size_t)(l * 8 + kc) * 5 * ADA + rc];
            MOD[i] = s; }
    }
    SEAM(1);

    for (int l = 0; l < DEPTH; ++l) {
        const int pb = 2 + 9 * l; const bool odd = (l & 1) != 0, need_ctx = l < DEPTH - 1; const int li = l >> 1;
        const int MR = need_ctx ? MALL : MLAT;
#define MODL() (WSP(float, WS_MOD) + (size_t)l * 5 * ADA)
        if (IN(pb + 0)) { THREAD_IDS(); norm_rows<0>(WSP(float, WS_X), WSP(bf16, WS_H), nullptr, ARG(6) + l * DM, MODL(), 0, MALL, gw, NGW, lane); }
        SEAM(pb + 0);
        if (IN(pb + 1)) {
            THREAD_IDS();
            pg8::Gemm g{WSP(bf16, WS_H), WSP(bf16, WS_WIN) + (size_t)l * INW * DM, MALL, INW, DM}; pg8::StaticOrder S; S.init(MALL, INW, G, bx);
            pg8::EpiBf16<0> E{WSP(bf16, WS_P), INW};
            pg8::gemm_phase<pg8::EpiBf16<0>, pg8::StaticOrder, true, true>(lds + RING_OFF, g, S, E, tid);
        }
        SEAM(pb + 1);
        if (IN(pb + 2)) {
            THREAD_IDS();
            bf16* P = WSP(bf16, WS_P); float* VN = WSP(float, WS_VN); float* FA = WSP(float, WS_FA); float* FB = WSP(float, WS_FB); const float* sgu_g = ARG(10);
            if (!odd) {
                const int g8 = lane >> 3, c0 = (lane & 7) * 16;
                for (int row = gw; row < MALL; row += NGW) {
                    const bf16* vp = P + (size_t)row * INW + 1024 + g8 * 128 + c0; float v[16];
                    load_q<16>(vp, 1.0f, v);
                    float s = 0.f;
#pragma unroll
                    for (int j = 0; j < 16; ++j) s += v[j];
                    s += __shfl_xor(s, 1); s += __shfl_xor(s, 2); s += __shfl_xor(s, 4);
                    const float mu = s * (1.0f / 128.0f); float q = 0.f;
#pragma unroll
                    for (int j = 0; j < 16; ++j) { v[j] -= mu; q += v[j] * v[j]; }
                    q += __shfl_xor(q, 1); q += __shfl_xor(q, 2); q += __shfl_xor(q, 4);
                    const float rstd = 1.0f / sqrtf(q * (1.0f / 128.0f) + 1e-5f);
                    const float* gp = sgu_g + li * 1024 + g8 * 128 + c0; float* op = VN + (size_t)row * 1024 + g8 * 128 + c0;
#pragma unroll
                    for (int j = 0; j < 16; j += 4) { f32x4 o; o.x = v[j] * rstd * gp[j]; o.y = v[j + 1] * rstd * gp[j + 1]; o.z = v[j + 2] * rstd * gp[j + 2]; o.w = v[j + 3] * rstd * gp[j + 3]; *(GAS f32x4*)(op + j) = o; }
                }
            } else {
                for (int idx = gt; idx < MLAT * 12 * 2 * 2 * 32; idx += NT) {
                    const int pi = idx & 31, mp = (idx >> 5) & 1, qk = (idx >> 6) & 1, rest = idx >> 7, hh = rest % 12, row = rest / 12;
                    const int axis = pi >> 4, i = pi & 15, n = row & (SEQ - 1); const float pos = (float)(axis == 0 ? (n >> 6) : (n & 63));
                    const float inv = exp2f(-(float)i * (13.287712379549449f / 16.0f)); const float ang = pos * inv; float sn, cs; sincosf(ang, &sn, &cs);
                    bf16* zp = P + (size_t)row * INW + qk * 1536 + hh * 128 + mp * 64 + axis * 32 + i;
                    const float z1 = bf2f(zp[0]), z2 = bf2f(zp[16]);
                    zp[0] = (bf16)f2bf(z1 * cs - z2 * sn); zp[16] = (bf16)f2bf(z2 * cs + z1 * sn);
                }
                LAS f32x2* tw = (LAS f32x2*)(lds + RING_OFF);
                if (tid < 128) { float sn, cs; sincospif(2.0f * (float)tid / 128.0f, &sn, &cs); tw[tid] = (f32x2){cs, sn}; }
                __syncthreads();
                for (int idx = gt; idx < MALL * 512; idx += NT) {
                    const int row = idx >> 9, gj = idx & 511, g4 = gj >> 7, j = gj & 127; const bf16* xp = P + (size_t)row * INW + 4608 + g4 * 128; float fa = 0.f, fb = 0.f;
                    for (int c8 = 0; c8 < 16; ++c8) { const v4u w = ((const GAS v4u*)xp)[c8]; const float xv[8] = {bflo(w.x), bfhi(w.x), bflo(w.y), bfhi(w.y), bflo(w.z), bfhi(w.z), bflo(w.w), bfhi(w.w)};
#pragma unroll
                        for (int e = 0; e < 8; ++e) { const f32x2 t = tw[(j * (c8 * 8 + e)) & 127]; fa += xv[e] * t.x; fb += xv[e] * t.y; } }
                    FA[idx] = fa; FB[idx] = fb;
                }
                __syncthreads();
            }
        }
        SEAM(pb + 2);
        if (IN(pb + 3)) {
            THREAD_IDS();
            const bf16* P = WSP(bf16, WS_P); bf16* MIX = WSP(bf16, WS_MIX); const float* VN = WSP(float, WS_VN); const float* FA = WSP(float, WS_FA); const float* FB = WSP(float, WS_FB); float* O12 = WSP(float, WS_O12);
            const float* sgu_w = ARG(11); const float* sgu_b = ARG(12); const float* na_rpb = ARG(13);
            if (!odd) {
                for (int idx = gt; idx < MR * 1024; idx += NT) {
                    const int row = idx >> 10, col = idx & 1023, g8 = col >> 7, p = row & 127, cb = row - p;
                    const float* wrow = sgu_w + ((size_t)(li * 8 + g8) * 128 + p) * 128; float acc = sgu_b[(li * 8 + g8) * 128 + p];
                    const float* vp = VN + (size_t)cb * 1024 + col;
#pragma unroll 8
                    for (int q = 0; q < 128; ++q) acc += wrow[q] * vp[(size_t)q * 1024];
                    MIX[(size_t)row * DM + col] = (bf16)f2bf(bf2f(P[(size_t)row * INW + col]) * acc);
                }
                const float* rpb = na_rpb + (size_t)li * 8 * 15 * 31;
                for (int idx = gt; idx < MLAT * 8 * 4; idx += NT) {
                    const int vq = idx & 3, hh = (idx >> 2) & 7, n = (idx >> 5) & (SEQ - 1), b = idx >> 17;
                    const int r = n >> 6, c = n & 63, rs = min(max(r - 4, 0), 56), cs = min(max(c - 8, 0), 48);
                    const size_t qrow = (size_t)b * SEQ + n; float q[128], o[32];
                    load_q<128>(P + qrow * INW + 2048 + hh * 128, 0.08838834764831845f, q);
                    const float* rp = rpb + hh * 15 * 31;
                    auto keyf = [&](int i, size_t& koff, size_t& voff, float& bias) {
                        size_t krow;
                        if (i < 128) { const int a = i >> 4, w = i & 15; krow = (size_t)b * SEQ + (rs + a) * 64 + cs + w; bias = rp[(rs + a - r + 7) * 31 + (cs + w - c + 15)]; }
                        else { krow = (size_t)MLAT + b * NCTX + (i - 128); bias = 0.f; }
                        koff = krow * INW + 3072 + hh * 128; voff = krow * INW + 4096 + hh * 128 + vq * 32; };
                    naive_attn<128, 32>(P, q, 128 + NCTX, keyf, o);
                    store_bf<32>(MIX + qrow * DM + 1024 + hh * 128 + vq * 32, o);
                }
                if (need_ctx) for (int idx = gt; idx < MCTX * 8 * 4; idx += NT) {
                    const int vq = idx & 3, hh = (idx >> 2) & 7, cq = (idx >> 5) & (NCTX - 1), b = idx >> 13;
                    const size_t qrow = (size_t)MLAT + b * NCTX + cq; float q[128], o[32];
                    load_q<128>(P + qrow * INW + 2048 + hh * 128, 0.08838834764831845f, q);
                    auto keyf = [&](int i, size_t& koff, size_t& voff, float& bias) { const size_t krow = (size_t)MLAT + b * NCTX + i; bias = 0.f; koff = krow * INW + 3072 + hh * 128; voff = krow * INW + 4096 + hh * 128 + vq * 32; };
                    naive_attn<128, 32>(P, q, NCTX, keyf, o);
                    store_bf<32>(MIX + qrow * DM + 1024 + hh * 128 + vq * 32, o);
                }
            } else {
                for (int w = gw; w < NB * 12 * 2 * 2 * 64; w += NGW) {
                    const int qb = w & 63, vh = (w >> 6) & 1, mp = (w >> 7) & 1, rest = w >> 8, hh = rest % 12, b = rest / 12;
                    const size_t qrow = (size_t)b * SEQ + qb * 64 + lane; float q[64], o[64];
                    load_q<64>(P + qrow * INW + hh * 128 + mp * 64, 0.125f, q);
                    auto keyf = [&](int i, size_t& koff, size_t& voff, float& bias) { const size_t krow = i < SEQ ? (size_t)b * SEQ + i : (size_t)MLAT + b * NCTX + (i - SEQ); bias = 0.f;
                        koff = krow * INW + 1536 + hh * 128 + mp * 64; voff = krow * INW + 3072 + hh * 128 + vh * 64; };
                    naive_attn<64, 64>(P, q, SEQ + NCTX, keyf, o);
                    float* op = O12 + ((size_t)mp * MALL + qrow) * 1536 + hh * 128 + vh * 64;
#pragma unroll
                    for (int j = 0; j < 64; j += 4) *(GAS f32x4*)(op + j) = (f32x4){o[j], o[j + 1], o[j + 2], o[j + 3]};
                }
                if (need_ctx) for (int w = gw; w < NB * 12 * 2 * 2 * 4; w += NGW) {
                    const int qb = w & 3, vh = (w >> 2) & 1, mp = (w >> 3) & 1, rest = w >> 4, hh = rest % 12, b = rest / 12;
                    const size_t qrow = (size_t)MLAT + b * NCTX + qb * 64 + lane; float q[64], o[64];
                    load_q<64>(P + qrow * INW + hh * 128 + mp * 64, 0.125f, q);
                    auto keyf = [&](int i, size_t& koff, size_t& voff, float& bias) { const size_t krow = (size_t)MLAT + b * NCTX + i; bias = 0.f;
                        koff = krow * INW + 1536 + hh * 128 + mp * 64; voff = krow * INW + 3072 + hh * 128 + vh * 64; };
                    naive_attn<64, 64>(P, q, NCTX, keyf, o);
                    float* op = O12 + ((size_t)mp * MALL + qrow) * 1536 + hh * 128 + vh * 64;
#pragma unroll
                    for (int j = 0; j < 64; j += 4) *(GAS f32x4*)(op + j) = (f32x4){o[j], o[j + 1], o[j + 2], o[j + 3]};
                }
                LAS f32x2* tw = (LAS f32x2*)(lds + RING_OFF);
                for (int t = tid; t < SEQ; t += NWAVES * 64) { float sn, cs; sincospif(2.0f * (float)t / (float)SEQ, &sn, &cs); tw[t] = (f32x2){cs, sn}; }
                __syncthreads();
                for (int idx = gt; idx < NB * 512 * 512; idx += NT) {
                    const int gj = idx & 511, kg = (idx >> 9) & 511, b = idx >> 18; float acc[8];
#pragma unroll
                    for (int e = 0; e < 8; ++e) acc[e] = 0.f;
                    const float* fa = FA + (size_t)b * SEQ * 512 + gj; const float* fb = FB + (size_t)b * SEQ * 512 + gj;
                    for (int n = 0; n < SEQ; ++n) { const float a = fa[(size_t)n * 512], bb = fb[(size_t)n * 512];
#pragma unroll
                        for (int e = 0; e < 8; ++e) { const f32x2 t = tw[((kg + 512 * e) * n) & (SEQ - 1)]; acc[e] += a * t.x - bb * t.y; } }
#pragma unroll
                    for (int e = 0; e < 8; ++e) MIX[((size_t)b * SEQ + kg + 512 * e) * DM + 1536 + gj] = (bf16)f2bf(acc[e] * 0.0013810679320049757f);
                }
                if (need_ctx) for (int idx = gt; idx < NB * NCTX * 512; idx += NT) {
                    const int gj = idx & 511, k = (idx >> 9) & (NCTX - 1), b = idx >> 17; float acc = 0.f;
                    const float* fa = FA + ((size_t)MLAT + b * NCTX) * 512 + gj; const float* fb = FB + ((size_t)MLAT + b * NCTX) * 512 + gj;
                    for (int n = 0; n < NCTX; ++n) { const f32x2 t = tw[((k * n) & (NCTX - 1)) * 16]; acc += fa[(size_t)n * 512] * t.x - fb[(size_t)n * 512] * t.y; }
                    MIX[((size_t)MLAT + b * NCTX + k) * DM + 1536 + gj] = (bf16)f2bf(acc * 0.005524271728019903f);
                }
                __syncthreads();
            }
        }
        SEAM(pb + 3);
        if (IN(pb + 4) && odd) {
            THREAD_IDS();
            const float* O12 = WSP(float, WS_O12); bf16* MIX = WSP(bf16, WS_MIX); const float* subln_g = ARG(18);
            const float lam = WSP(float, WS_LAM)[li], post = 1.0f - (li == 0 ? LAM_INIT1 : LAM_INIT3);
            for (int w = gw; w < MR * 12; w += NGW) {
                const int row = w / 12, hh = w % 12; const size_t off = (size_t)row * 1536 + hh * 128 + 2 * lane;
                const f32x2 a = *(const GAS f32x2*)(O12 + off), b2 = *(const GAS f32x2*)(O12 + (size_t)MALL * 1536 + off);
                const float o0 = a.x - lam * b2.x, o1 = a.y - lam * b2.y; const float ss = wave_sum(o0 * o0 + o1 * o1);
                const float rstd = 1.0f / sqrtf(ss * (1.0f / 128.0f) + 1e-6f); const float* gp = subln_g + li * 128 + 2 * lane;
                *(GAS unsigned*)(MIX + (size_t)row * DM + hh * 128 + 2 * lane) = pk2(o0 * rstd * gp[0] * post, o1 * rstd * gp[1] * post);
            }
        }
        if (odd) SEAM(pb + 4);
        if (IN(pb + 5)) {
            THREAD_IDS();
            pg8::Gemm g{WSP(bf16, WS_MIX), WSP(bf16, WS_WOUT) + (size_t)l * DM * DM, MR, DM, DM}; pg8::StaticOrder S; S.init(MR, DM, G, bx);
            pg8::EpiResid E{WSP(float, WS_X), DM, MODL() + 2 * DM, ADA};
            pg8::gemm_phase<pg8::EpiResid, pg8::StaticOrder, true, true>(lds + RING_OFF, g, S, E, tid);
        }
        SEAM(pb + 5);
        if (IN(pb + 6)) { THREAD_IDS(); norm_rows<0>(WSP(float, WS_X), WSP(bf16, WS_H), nullptr, ARG(7) + l * DM, MODL(), 3, MR, gw, NGW, lane); }
        SEAM(pb + 6);
        if (IN(pb + 7)) {
            THREAD_IDS();
            pg8::Gemm g{WSP(bf16, WS_H), WSP(bf16, WS_W1) + (size_t)l * DFF * DM, MR, DFF, DM}; pg8::StaticOrder S; S.init(MR, DFF, G, bx);
            pg8::EpiBf16<1> E{WSP(bf16, WS_HID), DFF};
            pg8::gemm_phase<pg8::EpiBf16<1>, pg8::StaticOrder, true, true>(lds + RING_OFF, g, S, E, tid);
        }
        SEAM(pb + 7);
        if (IN(pb + 8)) {
            THREAD_IDS();
            pg8::Gemm g{WSP(bf16, WS_HID), WSP(bf16, WS_W2) + (size_t)l * DM * DFF, MR, DM, DFF}; pg8::StaticOrder S; S.init(MR, DM, G, bx);
            pg8::EpiResid E{WSP(float, WS_X), DM, MODL() + 5 * DM, ADA};
            pg8::gemm_phase<pg8::EpiResid, pg8::StaticOrder, true, true>(lds + RING_OFF, g, S, E, tid);
        }
        SEAM(pb + 8);
    }
    if (IN(NPH - 1)) { THREAD_IDS(); norm_rows<1>(WSP(float, WS_X), nullptr, KA()->out, ARG(21), nullptr, 0, MLAT, gw, NGW, lane); }
#undef IN
#undef SEAM
#undef GRID_BAR
}

extern "C" void kernel_launch(void* const* d_in, const int* in_sizes, int n_in, void* d_out, int out_size, void* d_ws, size_t ws_size, hipStream_t stream) {
    static int grid = 0;
    if (grid == 0) {
        if (n_in != 22 || in_sizes[0] != MLAT * DM || out_size != MLAT * DM || ws_size < WS_END) { fprintf(stderr, "kernel_launch: unexpected shapes (n_in %d, in0 %d, out %d, ws %zu); nothing launched\n", n_in, n_in > 0 ? in_sizes[0] : -1, out_size, ws_size); grid = -1; return; }
        int dev = 0, cus = 0, per_cu = 0;
        if (hipGetDevice(&dev) != hipSuccess || hipDeviceGetAttribute(&cus, hipDeviceAttributeMultiprocessorCount, dev) != hipSuccess) { grid = -1; return; }
        if (hipFuncSetAttribute((const void*)fwd, hipFuncAttributeMaxDynamicSharedMemorySize, LDS_BYTES) != hipSuccess) { fprintf(stderr, "kernel_launch: hipFuncSetAttribute failed\n"); grid = -1; return; }
        if (hipOccupancyMaxActiveBlocksPerMultiprocessor(&per_cu, (const void*)fwd, NWAVES * 64, LDS_BYTES) != hipSuccess || per_cu < 1) fprintf(stderr, "kernel_launch: occupancy query reports %d workgroups per CU\n", per_cu);
        (void)hipGetLastError();
        grid = cus;
    }
    if (grid < 0) return;
    if (hipMemsetAsync((char*)d_ws + WS_CTL, 0, CTL_ZERO_BYTES, stream) != hipSuccess) return;
    Args a{};
    for (int i = 0; i < 22; ++i) a.in[i] = (const float*)d_in[i];
    a.out = (float*)d_out; a.ws = (unsigned char*)d_ws;
#if MK_ONE_LAUNCH
    a.ph_lo = 0; a.ph_hi = NPH;
    hipLaunchKernelGGL(fwd, dim3(grid), dim3(NWAVES * 64), LDS_BYTES, stream, a);
#else
    for (int ph = 0; ph < NPH; ++ph) {
        if (ph >= 2 && ph < NPH - 1) { const int l = (ph - 2) / 9, k = (ph - 2) % 9; if (k == 4 && !(l & 1)) continue; }
        a.ph_lo = ph; a.ph_hi = ph + 1;
        hipLaunchKernelGGL(fwd, dim3(grid), dim3(NWAVES * 64), LDS_BYTES, stream, a);
    }
#endif
    const hipError_t le = hipPeekAtLastError();
    if (le != hipSuccess) fprintf(stderr, "kernel_launch: launch failed: %s\n", hipGetErrorName(le));
}
```

```cpp
#include <hip/hip_runtime.h>
#include <cstdio>
#include <cstdint>
namespace pg8 {
#define PG8_LAS __attribute__((address_space(3)))
typedef unsigned short bf16_t;
typedef short bf16x8 __attribute__((ext_vector_type(8)));
typedef float f32x4 __attribute__((ext_vector_type(4)));
typedef unsigned u32x4 __attribute__((ext_vector_type(4)));
constexpr int BM = 256, BK = 64, HALF = 128, HTB = HALF * BK * 2  , STAGE_BYTES = 8 * HTB, NXCD = 8, WGM = 8;

__host__ __device__ __forceinline__ int lds_byte(int r, int c) { const int st = (r >> 4) * 2 + (c >> 5), rr = r & 15, cc = c & 31, ob = rr * 64 + cc * 2; return st * 1024 + (ob ^ (((ob >> 9) & 1) << 5)); }
__host__ __device__ __forceinline__ void stage_rc(int b, int& R, int& C) { const int st = b / 1024, sb = b % 1024, swz = sb ^ (((sb >> 9) & 1) << 5); R = (st >> 1) * 16 + swz / 64; C = (st & 1) * 32 + (swz % 64) / 2; }
__host__ __device__ __forceinline__ int perm32(int rho) { const int n = rho >> 4, i = rho & 15; return 8 * (i >> 2) + 4 * n + (i & 3); }

struct Unit { int pm, pn; };
struct Gemm { const bf16_t* A; const bf16_t* Bt; int M, N, K; };

struct StaticOrder {
    int nM, nN, nwg, G, c;
    __host__ __device__ void init(int M, int N, int G_, int c_) { nM = M / BM; nN = N / BM; nwg = nM * nN; G = G_; c = c_; }
    __host__ __device__ bool next(int i, Unit& u) const {
        const long L = (long)i * G + c; if (L >= nwg) return false;
        int wgid = (int)L; { const int q = nwg / NXCD, r = nwg % NXCD, xcd = wgid % NXCD, off = wgid / NXCD; wgid = (xcd < r ? xcd * (q + 1) : r * (q + 1) + (xcd - r) * q) + off; }
        const int nig = WGM * nN, gid = wgid / nig, fm = gid * WGM, gsz = (nM - fm) < WGM ? (nM - fm) : WGM;
        u.pm = fm + ((wgid % nig) % gsz); u.pn = (wgid % nig) / gsz; return true;
    }
    __device__ __forceinline__ void a_ready(const Unit&) const {}
    __device__ __forceinline__ void done(const Unit&) const {}
};

__device__ __forceinline__ unsigned cvt_pk_bf16(float lo, float hi) { unsigned r; asm volatile("v_cvt_pk_bf16_f32 %0, %1, %2" : "=v"(r) : "v"(lo), "v"(hi)); return r; }

template <int ACT  > struct EpiBf16 {
    static constexpr bool PERM = true, AFTER_DRAIN = false;
    bf16_t* O; int ldc;
    __device__ __forceinline__ void operator()(const f32x4 (&acc)[2][2][4][2], const Unit& u, int wr, int wc, int fr, int fq) const {
        const int row0 = u.pm * BM + wr * 64 + fr; const int col0 = u.pn * BM + wc * 32 + 8 * fq;
#pragma unroll
        for (int ai = 0; ai < 2; ++ai)
#pragma unroll
            for (int m = 0; m < 4; ++m) { bf16_t* rowp = O + (size_t)(row0 + ai * HALF + m * 16) * ldc + col0;
#pragma unroll
                for (int bj = 0; bj < 2; ++bj) { f32x4 v0 = acc[ai][bj][m][0], v1 = acc[ai][bj][m][1];
                    if (ACT == 1) {
#pragma unroll
                        for (int j = 0; j < 4; ++j) { const float a = fmaxf(v0[j], 0.f), b = fmaxf(v1[j], 0.f); v0[j] = a * a; v1[j] = b * b; } }
                    u32x4 w; w.x = cvt_pk_bf16(v0[0], v0[1]); w.y = cvt_pk_bf16(v0[2], v0[3]); w.z = cvt_pk_bf16(v1[0], v1[1]); w.w = cvt_pk_bf16(v1[2], v1[3]);
                    *(u32x4*)(rowp + bj * HALF) = w; } }
    }
};
struct EpiResid {
    static constexpr bool PERM = false, AFTER_DRAIN = false;
    float* X; int ldc; const float* gate; int gate_stride;
    __device__ __forceinline__ void operator()(const f32x4 (&acc)[2][2][4][2], const Unit& u, int wr, int wc, int fr, int fq) const {
        const int row0 = u.pm * BM + wr * 64 + fr, col0 = u.pn * BM + wc * 32 + 4 * fq;
        const float* g = gate + (size_t)(u.pm < 64 ? (u.pm >> 4) : 4) * gate_stride;
        f32x4 gv[2][2];
#pragma unroll
        for (int bj = 0; bj < 2; ++bj)
#pragma unroll
            for (int n = 0; n < 2; ++n) gv[bj][n] = *(const f32x4*)(g + col0 + bj * HALF + n * 16);
#pragma unroll
        for (int ai = 0; ai < 2; ++ai)
#pragma unroll
            for (int m = 0; m < 4; ++m) { float* rowp = X + (size_t)(row0 + ai * HALF + m * 16) * ldc + col0;
#pragma unroll
                for (int bj = 0; bj < 2; ++bj)
#pragma unroll
                    for (int n = 0; n < 2; ++n) { const f32x4 xo = *(const f32x4*)(rowp + bj * HALF + n * 16); *(f32x4*)(rowp + bj * HALF + n * 16) = xo + gv[bj][n] * acc[ai][bj][m][n]; } }
    }
};

template <class Epi, class Sched, bool ALIGN_EPI = false, bool SP2 = false>
__device__ __forceinline__ void gemm_phase(PG8_LAS unsigned char* lds, const Gemm g, const Sched& S, const Epi& E, const int tid) {
    const int wid = __builtin_amdgcn_readfirstlane(tid >> 6), lane = tid & 63, wr = wid >> 2, wc = wid & 3, fr = lane & 15, fq = lane >> 4;
    const int K = g.K, nt = K / BK;
    unsigned voffA[2], voffB[2];
#pragma unroll
    for (int i = 0; i < 2; ++i) { int R, C; stage_rc(tid * 16 + i * 8192, R, C); const int Rb = Epi::PERM ? ((R & ~31) + perm32(R & 31)) : R;
        voffA[i] = (unsigned)(R * K + C) * 2u; voffB[i] = (unsigned)(Rb * K + C) * 2u; }
    const size_t kstep = (size_t)(BK * 2);
    const size_t hstep = (size_t)HALF * K * 2;
    const size_t tstep = 2 * hstep;
    const unsigned ldsw = (unsigned)wid * 1024u;
    const int aoff = lds_byte(wr * 64 + fr, fq * 8), boff = lds_byte(wc * 32 + fr, fq * 8);
#define PG8_SA(b, h) (((b) * 2 + (h)) * HTB)
#define PG8_SB(b, h) ((4 + (b) * 2 + (h)) * HTB)
#define PG8_STAGE(bufoff, gbase, voff) do { _Pragma("unroll") for (int _i = 0; _i < 2; ++_i) \
        __builtin_amdgcn_global_load_lds((const unsigned*)((const char*)(gbase) + (voff)[_i]), (PG8_LAS unsigned*)(lds + (bufoff) + ldsw + _i * 8192), 16, 0, 0); } while (0)
#define PG8_LDA(dst, b, h) do { _Pragma("unroll") for (int m = 0; m < 4; ++m) _Pragma("unroll") for (int k = 0; k < 2; ++k) dst[m][k] = *(const PG8_LAS bf16x8*)(lds + PG8_SA(b, h) + aoff + m * 2048 + k * 1024); } while (0)
#define PG8_LDB(dst, b, h) do { _Pragma("unroll") for (int n = 0; n < 2; ++n) _Pragma("unroll") for (int k = 0; k < 2; ++k) dst[n][k] = *(const PG8_LAS bf16x8*)(lds + PG8_SB(b, h) + boff + n * 2048 + k * 1024); } while (0)
#define PG8_MMA(ai, bj, At, Bt) do { __builtin_amdgcn_s_setprio(1); _Pragma("unroll") for (int m = 0; m < 4; ++m) _Pragma("unroll") for (int n = 0; n < 2; ++n) _Pragma("unroll") for (int k = 0; k < 2; ++k) \
        acc[ai][bj][m][n] = __builtin_amdgcn_mfma_f32_16x16x32_bf16(Bt[n][k], At[m][k], acc[ai][bj][m][n], 0, 0, 0); __builtin_amdgcn_s_setprio(0); } while (0)
#define PG8_WAIT_V(n) asm volatile("s_waitcnt vmcnt(" #n ")" ::: "memory")
#define PG8_WAIT_L(n) asm volatile("s_waitcnt lgkmcnt(" #n ")" ::: "memory")
#define PG8_BAR __builtin_amdgcn_s_barrier()
#define PG8_SCHED __builtin_amdgcn_sched_barrier(0)
    Unit cur, nxt; int ui = 0;
    if (!S.next(0, cur)) return;
    f32x4 acc[2][2][4][2];
#pragma unroll
    for (int a = 0; a < 2; ++a)
#pragma unroll
        for (int b = 0; b < 2; ++b)
#pragma unroll
            for (int m = 0; m < 4; ++m)
#pragma unroll
                for (int n = 0; n < 2; ++n) acc[a][b][m][n] = (f32x4){0.f, 0.f, 0.f, 0.f};
    bf16x8 At[4][2], B0[2][2], B1[2][2];
    const char* cA = (const char*)g.A + (size_t)cur.pm * tstep; const char* cB = (const char*)g.Bt + (size_t)cur.pn * tstep;
    S.a_ready(cur);
    if constexpr (SP2) {
        PG8_STAGE(PG8_SB(0, 0), cB, voffB); PG8_STAGE(PG8_SB(0, 1), cB + hstep, voffB); PG8_STAGE(PG8_SA(0, 0), cA, voffA); PG8_STAGE(PG8_SA(0, 1), cA + hstep, voffA);
        if (wr == 1) PG8_BAR;
        PG8_WAIT_V(2); PG8_BAR;
        PG8_STAGE(PG8_SB(1, 0), cB + kstep, voffB); PG8_STAGE(PG8_SA(1, 0), cA + kstep, voffA); PG8_STAGE(PG8_SB(1, 1), cB + hstep + kstep, voffB);
        PG8_WAIT_V(6); PG8_BAR;
    } else {
        PG8_STAGE(PG8_SB(0, 0), cB, voffB); PG8_STAGE(PG8_SA(0, 0), cA, voffA); PG8_STAGE(PG8_SB(0, 1), cB + hstep, voffB); PG8_STAGE(PG8_SA(0, 1), cA + hstep, voffA);
        if (wr == 1) PG8_BAR;
        PG8_WAIT_V(4); PG8_BAR;
        PG8_STAGE(PG8_SB(1, 0), cB + kstep, voffB); PG8_STAGE(PG8_SA(1, 0), cA + kstep, voffA); PG8_STAGE(PG8_SB(1, 1), cB + hstep + kstep, voffB);
        PG8_WAIT_V(6); PG8_BAR;
    }
    for (;;) {
        const bool has_next = S.next(ui + 1, nxt);
        const char* nA = has_next ? (const char*)g.A + (size_t)nxt.pm * tstep : cA; const char* nB = has_next ? (const char*)g.Bt + (size_t)nxt.pn * tstep : cB;
        for (int t = 0; t < nt; t += 2) {
            const bool last = (t == nt - 2);
            const char* a1 = cA + (size_t)(t + 1) * kstep;
            const char* a2 = last ? nA : cA + (size_t)(t + 2) * kstep; const char* b2 = last ? nB : cB + (size_t)(t + 2) * kstep;
            const char* a3 = a2 + kstep; const char* b3 = b2 + kstep;
            if (last && has_next) S.a_ready(nxt);
            if constexpr (SP2) {
            PG8_LDB(B0, 0, 0); PG8_LDB(B1, 0, 1); PG8_SCHED; PG8_LDA(At, 0, 0); PG8_STAGE(PG8_SA(1, 1), a1 + hstep, voffA);
            PG8_WAIT_V(8); PG8_WAIT_L(0); PG8_BAR; PG8_MMA(0, 0, At, B0); PG8_MMA(0, 1, At, B1); PG8_BAR; PG8_SCHED;
            PG8_LDA(At, 0, 1); PG8_STAGE(PG8_SB(0, 0), b2, voffB); PG8_STAGE(PG8_SB(0, 1), b2 + hstep, voffB); PG8_STAGE(PG8_SA(0, 0), a2, voffA);
            PG8_WAIT_V(8); PG8_WAIT_L(0); PG8_BAR; PG8_MMA(1, 0, At, B0); PG8_MMA(1, 1, At, B1); PG8_BAR; PG8_SCHED;
            PG8_LDB(B0, 1, 0); PG8_LDB(B1, 1, 1); PG8_SCHED; PG8_LDA(At, 1, 0); PG8_STAGE(PG8_SA(0, 1), a2 + hstep, voffA);
            PG8_WAIT_V(8); PG8_WAIT_L(0); PG8_BAR; PG8_MMA(0, 0, At, B0); PG8_MMA(0, 1, At, B1); PG8_BAR; PG8_SCHED;
            PG8_LDA(At, 1, 1); PG8_STAGE(PG8_SB(1, 0), b3, voffB); PG8_STAGE(PG8_SB(1, 1), b3 + hstep, voffB); PG8_STAGE(PG8_SA(1, 0), a3, voffA);
            PG8_WAIT_V(8); PG8_WAIT_L(0); PG8_BAR; PG8_MMA(1, 0, At, B0); PG8_MMA(1, 1, At, B1); PG8_BAR; PG8_SCHED;
            } else {
            PG8_LDB(B0, 0, 0); PG8_SCHED; PG8_LDA(At, 0, 0); PG8_STAGE(PG8_SA(1, 1), a1 + hstep, voffA);
            PG8_WAIT_L(8); PG8_BAR; PG8_WAIT_L(0); PG8_MMA(0, 0, At, B0); PG8_BAR; PG8_SCHED;
            PG8_LDB(B1, 0, 1); PG8_STAGE(PG8_SB(0, 0), b2, voffB);
            PG8_BAR; PG8_WAIT_L(0); PG8_MMA(0, 1, At, B1); PG8_BAR;
            PG8_LDA(At, 0, 1); PG8_STAGE(PG8_SA(0, 0), a2, voffA);
            PG8_BAR; PG8_WAIT_L(0); PG8_MMA(1, 0, At, B0); PG8_BAR; PG8_SCHED;
            PG8_STAGE(PG8_SB(0, 1), b2 + hstep, voffB);
            PG8_WAIT_V(6); PG8_BAR; PG8_MMA(1, 1, At, B1); PG8_BAR;
            PG8_LDB(B0, 1, 0); PG8_SCHED; PG8_LDA(At, 1, 0); PG8_STAGE(PG8_SA(0, 1), a2 + hstep, voffA);
            PG8_WAIT_L(8); PG8_BAR; PG8_WAIT_L(0); PG8_MMA(0, 0, At, B0); PG8_BAR; PG8_SCHED;
            PG8_LDB(B1, 1, 1); PG8_STAGE(PG8_SB(1, 0), b3, voffB);
            PG8_BAR; PG8_WAIT_L(0); PG8_MMA(0, 1, At, B1); PG8_BAR;
            PG8_LDA(At, 1, 1); PG8_STAGE(PG8_SA(1, 0), a3, voffA);
            PG8_BAR; PG8_WAIT_L(0); PG8_MMA(1, 0, At, B0); PG8_BAR; PG8_SCHED;
            PG8_STAGE(PG8_SB(1, 1), b3 + hstep, voffB);
            PG8_WAIT_V(6); PG8_BAR; PG8_MMA(1, 1, At, B1); PG8_BAR;
            }
        }
        if constexpr (ALIGN_EPI) { if (wr == 0) PG8_BAR; }
        if constexpr (!Epi::AFTER_DRAIN) { E(acc, cur, wr, wc, fr, fq); S.done(cur); }
        if (!has_next) break;
#pragma unroll
        for (int a = 0; a < 2; ++a)
#pragma unroll
            for (int b = 0; b < 2; ++b)
#pragma unroll
                for (int m = 0; m < 4; ++m)
#pragma unroll
                    for (int n = 0; n < 2; ++n) acc[a][b][m][n] = (f32x4){0.f, 0.f, 0.f, 0.f};
        cur = nxt; cA = nA; cB = nB; ++ui;
        if constexpr (ALIGN_EPI) { if (wr == 1) PG8_BAR; }
    }
    PG8_WAIT_V(0);
    if constexpr (!ALIGN_EPI) { if (wr == 0) PG8_BAR; }
    PG8_BAR;
    if constexpr (Epi::AFTER_DRAIN) { E.fused(acc, cur, wr, wc, fr, fq, lds, wid, lane); S.done(cur); }
#undef PG8_SA
#undef PG8_SB
#undef PG8_STAGE
#undef PG8_LDA
#undef PG8_LDB
#undef PG8_MMA
#undef PG8_WAIT_V
#undef PG8_WAIT_L
#undef PG8_BAR
#undef PG8_SCHED
}
}

constexpr int NWAVES = 8;
#ifndef MK_ONE_LAUNCH
#define MK_ONE_LAUNCH 1
#endif

constexpr int DM = 2048, NB = 4, SEQ = 4096, DEPTH = 4, NCTX = 256, INW = 5120, DFF = 8192, ADA = 6 * DM;
constexpr int MLAT = NB * SEQ, MCTX = NB * NCTX, MALL = MLAT + MCTX;
constexpr float LAM_INIT1 = 0.35550906759096926f, LAM_INIT3 = 0.5560582041556405f;

constexpr size_t MiB = 1u << 20;
constexpr size_t WS_CTL = 0, CTL_ZERO_BYTES = 1 * MiB;
constexpr size_t WS_MOD = 1 * MiB;
constexpr size_t WS_LAM = 2 * MiB;
constexpr size_t WS_ADAP = 3 * MiB;
constexpr size_t WS_WIN = 16 * MiB, WS_WOUT = 96 * MiB, WS_W1 = 128 * MiB, WS_W2 = 256 * MiB;
constexpr size_t WS_X = 384 * MiB;
constexpr size_t WS_H = 520 * MiB;
constexpr size_t WS_P = 588 * MiB;
constexpr size_t WS_MIX = 758 * MiB;
constexpr size_t WS_HID = 826 * MiB;
constexpr size_t WS_VN = 826 * MiB;
constexpr size_t WS_O12 = 826 * MiB;
constexpr size_t WS_FA = 1030 * MiB, WS_FB = 1064 * MiB;
constexpr size_t WS_END = 1098 * MiB;
constexpr int CW_BAR = 4096;

constexpr int RING_OFF = 0, RING_BYTES = 131072;
constexpr int LDSCTL_OFF = RING_BYTES, MISC_OFF = LDSCTL_OFF + 320;
constexpr int LDS_BYTES = 147456;

#define GAS __attribute__((address_space(1)))
#define LAS __attribute__((address_space(3)))
typedef unsigned short bf16;
typedef unsigned v4u __attribute__((ext_vector_type(4)));
typedef unsigned v2u __attribute__((ext_vector_type(2)));
typedef float f32x4 __attribute__((ext_vector_type(4)));
typedef float f32x2 __attribute__((ext_vector_type(2)));
#define LDS_WAIT() asm volatile("s_waitcnt lgkmcnt(0)" ::: "memory")
__device__ __forceinline__ unsigned f2bf(float f) { unsigned u = __builtin_bit_cast(unsigned, f); return (u + 0x7fffu + ((u >> 16) & 1u)) >> 16; }
__device__ __forceinline__ unsigned pk2(float lo, float hi) { return f2bf(lo) | (f2bf(hi) << 16); }
__device__ __forceinline__ float bf2f(bf16 v) { return __builtin_bit_cast(float, (unsigned)v << 16); }
__device__ __forceinline__ float bflo(unsigned w) { return __builtin_bit_cast(float, w << 16); }
__device__ __forceinline__ float bfhi(unsigned w) { return __builtin_bit_cast(float, w & 0xffff0000u); }
#define XB_TMO      128
#define XB_XCNT(j)  (256  + 64 * (j))
#define XB_XSUB(j)  (1280 + 64 * (j))
#define XB_XGEN(j)  (2304 + 64 * (j))
#define XB_TOP      3328
#define XB_TOPGEN   3392
#define XCD_BAR_WORDS 3456
#define XB_SPIN_CAP (1u << 20)

__device__ __forceinline__ unsigned xb_ld(unsigned* p)              { return __hip_atomic_load(p, __ATOMIC_RELAXED, __HIP_MEMORY_SCOPE_AGENT); }
__device__ __forceinline__ unsigned xb_add(unsigned* p, unsigned v) { return __hip_atomic_fetch_add(p, v, __ATOMIC_RELAXED, __HIP_MEMORY_SCOPE_AGENT); }
__device__ __forceinline__ unsigned xb_xcc_id() { return (unsigned)__builtin_amdgcn_s_getreg((3 << 11) | 20) & 0xFu; }
#define XB_SPIN(cond, bar) do { unsigned _sp = 0; while (cond) { __builtin_amdgcn_s_sleep(1); \
    if ((++_sp & 255u) == 0u) { if (xb_ld(&(bar)[XB_TMO])) break; if (_sp > XB_SPIN_CAP) { atomicAdd(&(bar)[XB_TMO], 1u); break; } } } } while (0)

struct XcdBarrier {
    unsigned* bar; unsigned x;
    volatile LAS unsigned* st;
};

__device__ __forceinline__ XcdBarrier xcd_barrier_post(unsigned* bar, volatile LAS unsigned* st) {
    XcdBarrier b; b.bar = bar; b.x = xb_xcc_id(); b.st = st;
    if (threadIdx.x == 0) (void)xb_add(&bar[XB_XCNT(b.x)], 1u);
    return b;
}
__device__ __forceinline__ void xcd_barrier_complete(unsigned* bar, unsigned x, unsigned& nloc, unsigned& nx) {
    const unsigned G = gridDim.x * gridDim.y * gridDim.z;
    unsigned sum, cnt, mine, sp = 0u;
    for (;;) {
        sum = 0u; cnt = 0u; mine = 0u;
#pragma unroll
        for (unsigned j = 0; j < 16; ++j) { const unsigned c = xb_ld(&bar[XB_XCNT(j)]); sum += c; cnt += (c > 0u) ? 1u : 0u; mine = (j == x) ? c : mine; }
        if (sum == G) break;
        __builtin_amdgcn_s_sleep(1);
        if ((++sp & 255u) == 0u) { if (xb_ld(&bar[XB_TMO])) break; if (sp > XB_SPIN_CAP) { atomicAdd(&bar[XB_TMO], 1u); break; } }
    }
    nloc = mine > 0u ? mine : 1u; nx = cnt > 0u ? cnt : 1u;
}

__device__ __forceinline__ void xcd_barrier(const XcdBarrier& b) {
    asm volatile("s_waitcnt vmcnt(0)" ::: "memory");
    __syncthreads();
    if (threadIdx.x == 0) {
        unsigned* bar = b.bar;
        __builtin_amdgcn_s_waitcnt(0);
        unsigned nloc = b.st[0], nx = b.st[1];
        if (nloc == 0u) { xcd_barrier_complete(bar, b.x, nloc, nx); b.st[0] = nloc; b.st[1] = nx; }
        const unsigned old = xb_add(&bar[XB_XSUB(b.x)], 1u);
        const unsigned gen = old / nloc;
        if (old + 1u == (gen + 1u) * nloc) {
            __builtin_amdgcn_fence(__ATOMIC_RELEASE, "agent");
            asm volatile("s_waitcnt vmcnt(0)" ::: "memory");
            const unsigned og = xb_add(&bar[XB_TOP], 1u);
            const unsigned tg = og / nx;
            if (og + 1u == (tg + 1u) * nx) xb_add(&bar[XB_TOPGEN], 1u);
            else XB_SPIN(xb_ld(&bar[XB_TOPGEN]) == tg, bar);
            __builtin_amdgcn_fence(__ATOMIC_ACQUIRE, "agent");
            xb_add(&bar[XB_XGEN(b.x)], 1u);
            asm volatile("s_waitcnt vmcnt(0)" ::: "memory");
        } else {
            XB_SPIN(xb_ld(&bar[XB_XGEN(b.x)]) == gen, bar);
            __builtin_amdgcn_fence(__ATOMIC_ACQUIRE, "agent");
            asm volatile("s_waitcnt vmcnt(0)" ::: "memory");
        }
    }
    __syncthreads();
}

__device__ __forceinline__ float wave_sum(float v) {
#pragma unroll
    for (int o = 1; o < 64; o <<= 1) v += __shfl_xor(v, o);
    return v;
}
__device__ __forceinline__ void p0_transpose_item(const float* W, int K, int N, bf16* WT, LAS float* scr, int item, int lane) {
    const int nblk = N / 32, kb = item / nblk, nb = item % nblk, k0 = 64 * kb, n0 = 32 * nb;
#pragma unroll 8
    for (int i = 0; i < 32; ++i) { const int kk = 2 * i + (lane >> 5); scr[kk * 33 + (lane & 31)] = W[(size_t)(k0 + kk) * N + n0 + (lane & 31)]; }
    LDS_WAIT(); asm volatile("" ::: "memory");
    const int c = lane & 7;
#pragma unroll
    for (int j = 0; j < 4; ++j) { const int n = (lane >> 3) + 8 * j; const LAS float* s = scr + (8 * c) * 33 + n;
        v4u o; o.x = pk2(s[0 * 33], s[1 * 33]); o.y = pk2(s[2 * 33], s[3 * 33]); o.z = pk2(s[4 * 33], s[5 * 33]); o.w = pk2(s[6 * 33], s[7 * 33]);
        *(GAS v4u*)(WT + (size_t)(n0 + n) * K + k0 + 8 * c) = o; }
    LDS_WAIT(); asm volatile("" ::: "memory");
}

template <int MODE>
__device__ __forceinline__ void norm_rows(const float* X, bf16* H, float* OUT, const float* gain, const float* modl, int sh_chunk, int M, int gw, int NGW, int lane) {
    for (int row = gw; row < M; row += NGW) {
        const GAS f32x4* xr = (const GAS f32x4*)(X + (size_t)row * DM) + lane;
        f32x4 v[8]; float ss = 0.f;
#pragma unroll
        for (int j = 0; j < 8; ++j) { v[j] = xr[64 * j]; ss += (v[j].x * v[j].x + v[j].y * v[j].y) + (v[j].z * v[j].z + v[j].w * v[j].w); }
        const float rstd = 1.0f / sqrtf(wave_sum(ss) * (1.0f / DM) + 1e-6f);
        if (MODE == 0) {
            const float* mr = modl + (size_t)(row < MLAT ? (row >> 12) : 4) * ADA;
            const GAS f32x4* sh = (const GAS f32x4*)(mr + sh_chunk * DM) + lane; const GAS f32x4* sc = (const GAS f32x4*)(mr + (sh_chunk + 1) * DM) + lane;
            const GAS f32x4* gg = (const GAS f32x4*)gain + lane;
            GAS v2u* o8 = (GAS v2u*)(H + (size_t)row * DM) + lane;
#pragma unroll
            for (int j = 0; j < 8; ++j) { const f32x4 g4 = gg[64 * j], s4 = sc[64 * j], h4 = sh[64 * j]; const f32x4 y = v[j] * rstd * g4 * (s4 + 1.0f) + h4;
                v2u w; w.x = pk2(y.x, y.y); w.y = pk2(y.z, y.w); o8[64 * j] = w; }
        } else {
            const GAS f32x4* gg = (const GAS f32x4*)gain + lane; GAS f32x4* o = (GAS f32x4*)(OUT + (size_t)row * DM) + lane;
#pragma unroll
            for (int j = 0; j < 8; ++j) o[64 * j] = v[j] * rstd * gg[64 * j];
        }
    }
}

template <int N> __device__ __forceinline__ float dot_bf(const bf16* kp, const float (&q)[N]) {
    float s = 0.f;
#pragma unroll
    for (int c = 0; c < N / 8; ++c) { const v4u w = ((const GAS v4u*)kp)[c];
        s += q[8 * c + 0] * bflo(w.x) + q[8 * c + 1] * bfhi(w.x) + q[8 * c + 2] * bflo(w.y) + q[8 * c + 3] * bfhi(w.y)
           + q[8 * c + 4] * bflo(w.z) + q[8 * c + 5] * bfhi(w.z) + q[8 * c + 6] * bflo(w.w) + q[8 * c + 7] * bfhi(w.w); }
    return s;
}
template <int DQK, int DVS, class KeyF>
__device__ __forceinline__ void naive_attn(const bf16* P, const float (&q)[DQK], int nkeys, const KeyF& keyf, float (&o)[DVS]) {
    float m = -1e30f, l = 0.f;
    for (int i = 0; i < nkeys; ++i) { size_t koff, voff; float bias; keyf(i, koff, voff, bias);
        const float s = dot_bf<DQK>(P + koff, q) + bias; const float mn = fmaxf(m, s); l = l * __expf(m - mn) + __expf(s - mn); m = mn; }
    const float il = 1.0f / l;
#pragma unroll
    for (int j = 0; j < DVS; ++j) o[j] = 0.f;
    for (int i = 0; i < nkeys; ++i) { size_t koff, voff; float bias; keyf(i, koff, voff, bias);
        const float s = dot_bf<DQK>(P + koff, q) + bias; const float p = __expf(s - m) * il;
#pragma unroll
        for (int c = 0; c < DVS / 8; ++c) { const v4u w = ((const GAS v4u*)(P + voff))[c];
            o[8 * c + 0] += p * bflo(w.x); o[8 * c + 1] += p * bfhi(w.x); o[8 * c + 2] += p * bflo(w.y); o[8 * c + 3] += p * bfhi(w.y);
            o[8 * c + 4] += p * bflo(w.z); o[8 * c + 5] += p * bfhi(w.z); o[8 * c + 6] += p * bflo(w.w); o[8 * c + 7] += p * bfhi(w.w); } }
}
template <int N> __device__ __forceinline__ void load_q(const bf16* qp, float scale, float (&q)[N]) {
#pragma unroll
    for (int c = 0; c < N / 8; ++c) { const v4u w = ((const GAS v4u*)qp)[c];
        q[8 * c + 0] = scale * bflo(w.x); q[8 * c + 1] = scale * bfhi(w.x); q[8 * c + 2] = scale * bflo(w.y); q[8 * c + 3] = scale * bfhi(w.y);
        q[8 * c + 4] = scale * bflo(w.z); q[8 * c + 5] = scale * bfhi(w.z); q[8 * c + 6] = scale * bflo(w.w); q[8 * c + 7] = scale * bfhi(w.w); }
}
template <int N> __device__ __forceinline__ void store_bf(bf16* op, const float (&o)[N]) {
#pragma unroll
    for (int c = 0; c < N / 8; ++c) { v4u w; w.x = pk2(o[8 * c], o[8 * c + 1]); w.y = pk2(o[8 * c + 2], o[8 * c + 3]); w.z = pk2(o[8 * c + 4], o[8 * c + 5]); w.w = pk2(o[8 * c + 6], o[8 * c + 7]); ((GAS v4u*)op)[c] = w; }
}

namespace da {
using bf16x8 = __attribute__((ext_vector_type(8))) short;
using s16x4  = __attribute__((ext_vector_type(4))) short;
using f32x16 = __attribute__((ext_vector_type(16))) float;
using u32x4  = __attribute__((ext_vector_type(4))) unsigned;
constexpr int KVBLK = 64;
constexpr int SHM_V = KVBLK * 128 * 2, SHM_K = KVBLK * 128 * 2;
constexpr int LDS_X2 = 0;
constexpr int LDS_WS = 2 * SHM_V + 2 * SHM_K;
constexpr float SCALE = 0.125f;
constexpr float THR = 8.f;
#define DA_KSWZ(row, colB) ((row) * 256 + ((colB) ^ (((row) & 7) << 4)))
#define DA_SBAR() __builtin_amdgcn_sched_barrier(0)
__device__ __forceinline__ int crow(int r, int hi) { return (r & 3) + 8 * (r >> 2) + 4 * hi; }
__device__ __forceinline__ unsigned cvtpk(float lo, float hi) { unsigned r; asm volatile("v_cvt_pk_bf16_f32 %0, %1, %2" : "=v"(r) : "v"(lo), "v"(hi)); return r; }

__device__ __forceinline__ void partialSM(f32x16& p0, f32x16& p1, float& m_reg, float& mn, float& alpha) {
  constexpr float C = SCALE * 1.4426950408889634f;
  float pmax = p0[0];
#pragma unroll
  for (int r = 1; r < 16; ++r) pmax = fmaxf(pmax, p0[r]);
#pragma unroll
  for (int r = 0; r < 16; ++r) pmax = fmaxf(pmax, p1[r]);
  { auto rr = __builtin_amdgcn_permlane32_swap(__float_as_uint(pmax), __float_as_uint(pmax), false, false);
    pmax = fmaxf(__uint_as_float(rr[0]), __uint_as_float(rr[1])); }
  if (__builtin_expect(__all(pmax - m_reg <= THR / SCALE), 1)) { mn = m_reg; alpha = 1.f; }
  else { mn = fmaxf(m_reg, pmax); alpha = __builtin_amdgcn_exp2f((m_reg - mn) * C); m_reg = mn; }
  const float mnC = -mn * C;
#pragma unroll
  for (int r = 0; r < 16; ++r) p0[r] = fmaf(p0[r], C, mnC);
#pragma unroll
  for (int r = 0; r < 16; ++r) p1[r] = fmaf(p1[r], C, mnC);
#pragma unroll
  for (int r = 0; r < 16; ++r) p0[r] = __builtin_amdgcn_exp2f(p0[r]);
}
__device__ __forceinline__ void finishSM(f32x16& p0, f32x16& p1, float alpha, float& l_reg, bf16x8& pa0, bf16x8& pa1, bf16x8& pa2, bf16x8& pa3) {
#pragma unroll
  for (int r = 0; r < 16; ++r) p1[r] = __builtin_amdgcn_exp2f(p1[r]);
  float ps = 0;
#pragma unroll
  for (int r = 0; r < 16; ++r) ps += p0[r];
#pragma unroll
  for (int r = 0; r < 16; ++r) ps += p1[r];
  { auto rr = __builtin_amdgcn_permlane32_swap(__float_as_uint(ps), __float_as_uint(ps), false, false);
    ps = __uint_as_float(rr[0]) + __uint_as_float(rr[1]); }
  l_reg = l_reg * alpha + ps;
#define DA_PK4(P, BASE, OUT) do { unsigned a0 = cvtpk(P[BASE + 0], P[BASE + 1]), a1 = cvtpk(P[BASE + 2], P[BASE + 3]);   \
    unsigned b0 = cvtpk(P[BASE + 4], P[BASE + 5]), b1 = cvtpk(P[BASE + 6], P[BASE + 7]);                              \
    auto r0 = __builtin_amdgcn_permlane32_swap(a0, b0, false, false); auto r1 = __builtin_amdgcn_permlane32_swap(a1, b1, false, false); \
    u32x4 w = {r0[0], r1[0], r0[1], r1[1]}; OUT = *reinterpret_cast<bf16x8*>(&w); } while (0)
  DA_PK4(p0, 0, pa0); DA_PK4(p0, 8, pa1); DA_PK4(p1, 0, pa2); DA_PK4(p1, 8, pa3);
#undef DA_PK4
}
__device__ __forceinline__ void qkt(f32x16& p0, f32x16& p1, const LAS char* Ks, const bf16x8 (&qr)[4], int r32, int hi, int mapcolB) {
  p0 = f32x16{}; p1 = f32x16{};
#pragma unroll
  for (int d0 = 0; d0 < 4; ++d0) { const int cb = mapcolB + (d0 * 16 + hi * 8) * 2;
    const bf16x8 b0 = *reinterpret_cast<const LAS bf16x8*>(Ks + DA_KSWZ(r32, cb));
    const bf16x8 b1 = *reinterpret_cast<const LAS bf16x8*>(Ks + DA_KSWZ(32 + r32, cb));
    p0 = __builtin_amdgcn_mfma_f32_32x32x16_bf16(b0, qr[d0], p0, 0, 0, 0);
    p1 = __builtin_amdgcn_mfma_f32_32x32x16_bf16(b1, qr[d0], p1, 0, 0, 0); }
}
__device__ __forceinline__ int v_st(int k, int c) { const int kk = (k & ~0xC) | ((k & 4) << 1) | ((k & 8) >> 1); return ((kk >> 3) * 4 + (c >> 5)) * 512 + ((kk & 7) * 32 + (c & 31)) * 2; }
__device__ __forceinline__ int v_rd_base(int lane) { return ((lane & 3) << 3) | (((lane >> 2) & 3) << 6) | (((lane >> 4) & 1) << 5) | (((lane >> 5) & 1) << 8); }
constexpr int v_rd_off(int d0, int ks, int half) { return d0 * 512 + ks * 4096 + half * 2048; }
template <int OFF> __device__ __forceinline__ s16x4 tr_read(int vb) {
  s16x4 r; asm volatile("ds_read_b64_tr_b16 %0, %1 offset:%2" : "=&v"(r) : "v"(vb), "i"(OFF) : "memory"); return r;
}
template <int D0> __device__ __forceinline__ void pv_one(f32x16& od, int vb, bf16x8 pa0, bf16x8 pa1, bf16x8 pa2, bf16x8 pa3) {
  const s16x4 l0 = tr_read<v_rd_off(D0, 0, 0)>(vb), h0 = tr_read<v_rd_off(D0, 0, 1)>(vb), l1 = tr_read<v_rd_off(D0, 1, 0)>(vb), h1 = tr_read<v_rd_off(D0, 1, 1)>(vb);
  const s16x4 l2 = tr_read<v_rd_off(D0, 2, 0)>(vb), h2 = tr_read<v_rd_off(D0, 2, 1)>(vb), l3 = tr_read<v_rd_off(D0, 3, 0)>(vb), h3 = tr_read<v_rd_off(D0, 3, 1)>(vb);
  asm volatile("s_waitcnt lgkmcnt(0)" ::: "memory"); DA_SBAR();
#define DA_PK(L, H) (bf16x8){L[0], L[1], L[2], L[3], H[0], H[1], H[2], H[3]}
  od = __builtin_amdgcn_mfma_f32_32x32x16_bf16(pa0, DA_PK(l0, h0), od, 0, 0, 0);
  od = __builtin_amdgcn_mfma_f32_32x32x16_bf16(pa1, DA_PK(l1, h1), od, 0, 0, 0);
  od = __builtin_amdgcn_mfma_f32_32x32x16_bf16(pa2, DA_PK(l2, h2), od, 0, 0, 0);
  od = __builtin_amdgcn_mfma_f32_32x32x16_bf16(pa3, DA_PK(l3, h3), od, 0, 0, 0);
#undef DA_PK
}
__device__ __forceinline__ void pv_d0(f32x16 (&o)[4], int vb, bf16x8 pa0, bf16x8 pa1, bf16x8 pa2, bf16x8 pa3) {
  pv_one<0>(o[0], vb, pa0, pa1, pa2, pa3); pv_one<1>(o[1], vb, pa0, pa1, pa2, pa3); pv_one<2>(o[2], vb, pa0, pa1, pa2, pa3); pv_one<3>(o[3], vb, pa0, pa1, pa2, pa3);
}

__device__ __forceinline__ void unit(const bf16* __restrict__ P, bf16* __restrict__ MIX, int qrow0, int hh, int lat_row0, int n_lat_tiles, int ctx_row0,
                                     float lam, float post, const float* __restrict__ sub_g, LAS char* lds, int tid) {
  const int wid = __builtin_amdgcn_readfirstlane(tid >> 6), lane = tid & 63, r32 = lane & 31, hi = lane >> 5, mp = wid >> 2, wq = wid & 3;
  LAS char* V_lds = lds; LAS char* K_lds = lds + 2 * SHM_V;
  LAS float* wsl = (LAS float*)(lds + LDS_WS) + wid * 64; LAS float* li_l = wsl; LAS float* al_l = wsl + 32;
  float m_reg = -1e30f, l_reg = 0; f32x16 o[4] = {}; bf16x8 qr[4];
  { const bf16* Qw = P + (size_t)(qrow0 + wq * 32 + r32) * INW + hh * 128 + mp * 64 + hi * 8;
#pragma unroll
    for (int d0 = 0; d0 < 4; ++d0) qr[d0] = *reinterpret_cast<const bf16x8*>(Qw + d0 * 16); }
  const int mapcolB = mp * 128;
  const int sr = tid >> 4, sc = (tid & 15) * 8, vst0 = v_st(sr, sc), vst1 = v_st(32 + sr, sc);
  const int vb0 = (int)(uintptr_t)V_lds + v_rd_base(lane);
  const bf16* Kc = P + 1536 + hh * 128 + sc; const bf16* Vc = P + 3072 + hh * 128 + sc;
  const int NT = n_lat_tiles + 4;
  struct { bf16x8 vs0, vs1, ks0, ks1; } st_[2];
#define DA_TROW(j) ((j) < n_lat_tiles ? lat_row0 + (j) * KVBLK : ctx_row0 + ((j) - n_lat_tiles) * KVBLK)
#define DA_SLOAD(i, j) do { const size_t _r0 = (size_t)(DA_TROW(j) + sr) * INW, _r1 = _r0 + (size_t)32 * INW; \
    st_[i].vs0 = *reinterpret_cast<const bf16x8*>(Vc + _r0); st_[i].vs1 = *reinterpret_cast<const bf16x8*>(Vc + _r1); \
    st_[i].ks0 = *reinterpret_cast<const bf16x8*>(Kc + _r0); st_[i].ks1 = *reinterpret_cast<const bf16x8*>(Kc + _r1); } while (0)
#define DA_SWRITE(b, i) do { *(LAS bf16x8*)(V_lds + (b) * SHM_V + vst0) = st_[i].vs0; *(LAS bf16x8*)(V_lds + (b) * SHM_V + vst1) = st_[i].vs1; const int kc = sc * 2; \
    *(LAS bf16x8*)(K_lds + (b) * SHM_K + DA_KSWZ(sr, kc)) = st_[i].ks0; *(LAS bf16x8*)(K_lds + (b) * SHM_K + DA_KSWZ(32 + sr, kc)) = st_[i].ks1; } while (0)
#define DA_SWAIT() asm volatile("s_waitcnt vmcnt(4)" ::: "memory")
#define DA_RESC(a) do { if (__any((a) < 1.f)) { if (hi == 0) al_l[r32] = (a); asm volatile("s_waitcnt lgkmcnt(0)" ::: "memory"); \
    _Pragma("unroll") for (int d = 0; d < 4; ++d) _Pragma("unroll") for (int r = 0; r < 16; ++r) o[d][r] *= al_l[crow(r, hi)]; } } while (0)
  f32x16 pA0, pA1, pB0, pB1; float mnA, mnB, alA, alB; bf16x8 pa0, pa1, pa2, pa3;
  constexpr int SE = 0, SO = 1;
  DA_SLOAD(SE, 0); asm volatile("s_waitcnt vmcnt(0)" ::: "memory"); DA_SWRITE(0, SE); __syncthreads();
  qkt(pA0, pA1, K_lds, qr, r32, hi, mapcolB); partialSM(pA0, pA1, m_reg, mnA, alA);
  DA_SLOAD(SO, 1); if (2 < NT) DA_SLOAD(SE, 2);
  DA_SWAIT(); DA_SWRITE(1, SO); __syncthreads();
  for (int j = 1; j + 1 < NT; j += 2) {
    DA_SBAR(); qkt(pB0, pB1, K_lds + SHM_K, qr, r32, hi, mapcolB);
    finishSM(pA0, pA1, alA, l_reg, pa0, pa1, pa2, pa3); DA_SBAR();
    DA_SLOAD(SO, j + 2); DA_SBAR();
    pv_d0(o, vb0, pa0, pa1, pa2, pa3); partialSM(pB0, pB1, m_reg, mnB, alB);
    __syncthreads(); DA_SWAIT(); DA_SWRITE(0, SE);
    DA_RESC(alB); __syncthreads();
    DA_SBAR(); qkt(pA0, pA1, K_lds, qr, r32, hi, mapcolB);
    finishSM(pB0, pB1, alB, l_reg, pa0, pa1, pa2, pa3); DA_SBAR();
    if (j + 3 < NT) DA_SLOAD(SE, j + 3); DA_SBAR();
    pv_d0(o, vb0 + SHM_V, pa0, pa1, pa2, pa3); partialSM(pA0, pA1, m_reg, mnA, alA);
    __syncthreads(); DA_SWAIT(); DA_SWRITE(1, SO);
    DA_RESC(alA); __syncthreads();
  }
  DA_SBAR(); qkt(pB0, pB1, K_lds + SHM_K, qr, r32, hi, mapcolB);
  finishSM(pA0, pA1, alA, l_reg, pa0, pa1, pa2, pa3); DA_SBAR();
  pv_d0(o, vb0, pa0, pa1, pa2, pa3); partialSM(pB0, pB1, m_reg, mnB, alB);
  __syncthreads(); DA_RESC(alB);
  finishSM(pB0, pB1, alB, l_reg, pa0, pa1, pa2, pa3); DA_SBAR();
  pv_d0(o, vb0 + SHM_V, pa0, pa1, pa2, pa3);
  if (hi == 0) li_l[r32] = l_reg; asm volatile("s_waitcnt lgkmcnt(0)" ::: "memory");
  float rli[16];
#pragma unroll
  for (int r = 0; r < 16; ++r) rli[r] = 1.0f / li_l[crow(r, hi)];
  __syncthreads();
  LAS float* X2 = (LAS float*)(lds + LDS_X2);
  if (mp == 1) {
#pragma unroll
    for (int r = 0; r < 16; ++r) { const int row = wq * 32 + crow(r, hi);
#pragma unroll
      for (int d0 = 0; d0 < 4; ++d0) X2[row * 128 + d0 * 32 + r32] = lam * o[d0][r] * rli[r]; }
  }
  __syncthreads();
  if (mp == 0) {
    float ss[16];
#pragma unroll
    for (int r = 0; r < 16; ++r) { const int row = wq * 32 + crow(r, hi); float s = 0.f;
#pragma unroll
      for (int d0 = 0; d0 < 4; ++d0) { const float v = o[d0][r] * rli[r] - X2[row * 128 + d0 * 32 + r32]; o[d0][r] = v; s += v * v; }
      ss[r] = s; }
#pragma unroll
    for (int r = 0; r < 16; ++r) { float s = ss[r];
      s += __shfl_xor(s, 1); s += __shfl_xor(s, 2); s += __shfl_xor(s, 4); s += __shfl_xor(s, 8); s += __shfl_xor(s, 16);
      ss[r] = post / sqrtf(s * (1.0f / 128.0f) + 1e-6f); }
    float gsub[4];
#pragma unroll
    for (int d0 = 0; d0 < 4; ++d0) gsub[d0] = sub_g[d0 * 32 + r32];
#pragma unroll
    for (int r = 0; r < 16; ++r) { bf16* op = MIX + (size_t)(qrow0 + wq * 32 + crow(r, hi)) * DM + hh * 128 + r32;
#pragma unroll
      for (int d0 = 0; d0 < 4; ++d0) op[d0 * 32] = (bf16)f2bf(o[d0][r] * ss[r] * gsub[d0]); }
  }
  __syncthreads();
#undef DA_TROW
#undef DA_SLOAD
#undef DA_SWRITE
#undef DA_SWAIT
#undef DA_RESC
}
}

constexpr int NPH = 39;
struct Args { const float* in[22]; float* out; unsigned char* ws; int ph_lo, ph_hi; };
__global__ void __launch_bounds__(NWAVES * 64, 2) fwd(Args args) {
    extern __shared__ __attribute__((aligned(16))) unsigned char lds_raw[];
    LAS unsigned char* lds = (LAS unsigned char*)lds_raw;
    volatile LAS unsigned* MISC = (volatile LAS unsigned*)(lds + MISC_OFF);
    const int G = gridDim.x;
    typedef const __attribute__((address_space(4))) Args* KArgs;
    const KArgs ka0 = (KArgs)__builtin_amdgcn_kernarg_segment_ptr();
#define KA() ({ KArgs _p = ka0; asm volatile("" : "+s"(_p)); _p; })
#define ARG(i) (KA()->in[i])
#define WSP(T, off) ((T*)(KA()->ws + (off)))
#define THREAD_IDS() int tid = threadIdx.x; asm volatile("" : "+v"(tid)); int bx = blockIdx.x; asm volatile("" : "+s"(bx)); \
    const int lane = tid & 63, wave = __builtin_amdgcn_readfirstlane(tid >> 6); const int gw = bx * NWAVES + wave, NGW = G * NWAVES; const int gt = bx * (NWAVES * 64) + tid, NT = G * NWAVES * 64; \
    (void)lane; (void)wave; (void)gw; (void)NGW; (void)gt; (void)NT;
    {
    THREAD_IDS();
    for (int u = tid; u < (LDS_BYTES - LDSCTL_OFF) / 4; u += NWAVES * 64) ((LAS unsigned*)(lds + LDSCTL_OFF))[u] = 0u;
    __syncthreads();
    }
#if MK_ONE_LAUNCH
    XcdBarrier bar = xcd_barrier_post(WSP(unsigned, WS_CTL) + CW_BAR, MISC + 8);
#define GRID_BAR() xcd_barrier(bar)
#else
    (void)MISC;
#define GRID_BAR() do { } while (0)
#endif
    const int lo = args.ph_lo, hi = args.ph_hi;
#define IN(k) (lo <= (k) && (k) < hi)
#define SEAM(k) do { if (IN(k) && IN((k) + 1)) GRID_BAR(); } while (0)

    if (IN(0)) {
        THREAD_IDS();
        const float* x_in = ARG(0); const float* c_in = ARG(1); const float* ctx_in = ARG(2); const float* cctx_in = ARG(3); const float* ada_w = ARG(4);
        const float* w_in = ARG(8); const float* w_out = ARG(9); const float* mlp_w1 = ARG(19); const float* mlp_w2 = ARG(20);
        const float* lq1 = ARG(14); const float* lk1 = ARG(15); const float* lq2 = ARG(16); const float* lk2 = ARG(17);
        float* ADAP = WSP(float, WS_ADAP); float* LAM = WSP(float, WS_LAM); float* X = WSP(float, WS_X);
        bf16* WIN_T = WSP(bf16, WS_WIN); bf16* WOUT_T = WSP(bf16, WS_WOUT); bf16* W1_T = WSP(bf16, WS_W1); bf16* W2_T = WSP(bf16, WS_W2);
        LAS float* s_lds = (LAS float*)(lds + RING_OFF);
        for (int it = bx; it < DEPTH * 8 * 24; it += G) {
            const int l = it / 192, rem = it % 192, kc = rem / 24, cb = rem % 24;
            __syncthreads();
            for (int i = tid; i < 5 * 256; i += NWAVES * 64) { const int r = i >> 8, k = i & 255; const float cv = r < 4 ? c_in[r * DM + kc * 256 + k] : cctx_in[kc * 256 + k]; s_lds[i] = cv / (1.0f + expf(-cv)); }
            __syncthreads();
            const int col = cb * 512 + tid; float a0 = 0.f, a1 = 0.f, a2 = 0.f, a3 = 0.f, a4 = 0.f;
            const float* wp = ada_w + ((size_t)l * DM + kc * 256) * ADA + col;
#pragma unroll 8
            for (int k = 0; k < 256; ++k) { const float w = wp[(size_t)k * ADA]; a0 += s_lds[k] * w; a1 += s_lds[256 + k] * w; a2 += s_lds[512 + k] * w; a3 += s_lds[768 + k] * w; a4 += s_lds[1024 + k] * w; }
            float* pp = ADAP + ((size_t)(l * 8 + kc) * 5) * ADA + col;
            pp[0] = a0; pp[ADA] = a1; pp[2 * ADA] = a2; pp[3 * ADA] = a3; pp[4 * ADA] = a4;
        }
        __syncthreads();
        LAS float* scr = (LAS float*)(lds + RING_OFF + wave * 16384);
        constexpr int I_IN = (DM / 64) * (INW / 32), I_OUT = (DM / 64) * (DM / 32), I_1 = (DM / 64) * (DFF / 32), I_2 = (DFF / 64) * (DM / 32), I_L = I_IN + I_OUT + I_1 + I_2;
        for (int it = gw; it < DEPTH * I_L; it += NGW) {
            const int l = it / I_L; int r = it % I_L;
            if (r < I_IN) { p0_transpose_item(w_in + (size_t)l * DM * INW, DM, INW, WIN_T + (size_t)l * INW * DM, scr, r, lane); continue; } r -= I_IN;
            if (r < I_OUT) { p0_transpose_item(w_out + (size_t)l * DM * DM, DM, DM, WOUT_T + (size_t)l * DM * DM, scr, r, lane); continue; } r -= I_OUT;
            if (r < I_1) { p0_transpose_item(mlp_w1 + (size_t)l * DM * DFF, DM, DFF, W1_T + (size_t)l * DFF * DM, scr, r, lane); continue; } r -= I_1;
            p0_transpose_item(mlp_w2 + (size_t)l * DFF * DM, DFF, DM, W2_T + (size_t)l * DM * DFF, scr, r, lane);
        }
        for (size_t i = gt; i < (size_t)MALL * DM / 4; i += NT) { const f32x4 v = i < (size_t)MLAT * DM / 4 ? ((const GAS f32x4*)x_in)[i] : ((const GAS f32x4*)ctx_in)[i - (size_t)MLAT * DM / 4]; ((GAS f32x4*)X)[i] = v; }
        if (bx == 0 && tid < 2) { float d1 = 0.f, d2 = 0.f; for (int j = 0; j < 64; ++j) { d1 += lq1[tid * 64 + j] * lk1[tid * 64 + j]; d2 += lq2[tid * 64 + j] * lk2[tid * 64 + j]; }
            LAM[tid] = expf(d1) - expf(d2) + (tid == 0 ? LAM_INIT1 : LAM_INIT3); }
    }
    SEAM(0);
    if (IN(1)) {
        THREAD_IDS();
        const float* ada_b = ARG(5); const float* ADAP = WSP(float, WS_ADAP); float* MOD = WSP(float, WS_MOD);
        for (int i = gt; i < DEPTH * 5 * ADA; i += NT) { const int l = i / (5 * ADA), rc = i % (5 * ADA), col = rc % ADA; float s = ada_b[l * ADA + col];
#pragma unroll
            for (int kc = 0; kc < 8; ++kc) s += ADAP[(size_t)(l * 8 + kc) * 5 * ADA + rc];
            MOD[i] = s; }
    }
    SEAM(1);

    for (int l = 0; l < DEPTH; ++l) {
        const int pb = 2 + 9 * l; const bool odd = (l & 1) != 0, need_ctx = l < DEPTH - 1; const int li = l >> 1;
        const int MR = need_ctx ? MALL : MLAT;
#define MODL() (WSP(float, WS_MOD) + (size_t)l * 5 * ADA)
        if (IN(pb + 0)) { THREAD_IDS(); norm_rows<0>(WSP(float, WS_X), WSP(bf16, WS_H), nullptr, ARG(6) + l * DM, MODL(), 0, MALL, gw, NGW, lane); }
        SEAM(pb + 0);
        if (IN(pb + 1)) {
            THREAD_IDS();
            pg8::Gemm g{WSP(bf16, WS_H), WSP(bf16, WS_WIN) + (size_t)l * INW * DM, MALL, INW, DM}; pg8::StaticOrder S; S.init(MALL, INW, G, bx);
            pg8::EpiBf16<0> E{WSP(bf16, WS_P), INW};
            pg8::gemm_phase<pg8::EpiBf16<0>, pg8::StaticOrder, true, true>(lds + RING_OFF, g, S, E, tid);
        }
        SEAM(pb + 1);
        if (IN(pb + 2)) {
            THREAD_IDS();
            bf16* P = WSP(bf16, WS_P); float* VN = WSP(float, WS_VN); float* FA = WSP(float, WS_FA); float* FB = WSP(float, WS_FB); const float* sgu_g = ARG(10);
            if (!odd) {
                const int g8 = lane >> 3, c0 = (lane & 7) * 16;
                for (int row = gw; row < MALL; row += NGW) {
                    const bf16* vp = P + (size_t)row * INW + 1024 + g8 * 128 + c0; float v[16];
                    load_q<16>(vp, 1.0f, v);
                    float s = 0.f;
#pragma unroll
                    for (int j = 0; j < 16; ++j) s += v[j];
                    s += __shfl_xor(s, 1); s += __shfl_xor(s, 2); s += __shfl_xor(s, 4);
                    const float mu = s * (1.0f / 128.0f); float q = 0.f;
#pragma unroll
                    for (int j = 0; j < 16; ++j) { v[j] -= mu; q += v[j] * v[j]; }
                    q += __shfl_xor(q, 1); q += __shfl_xor(q, 2); q += __shfl_xor(q, 4);
                    const float rstd = 1.0f / sqrtf(q * (1.0f / 128.0f) + 1e-5f);
                    const float* gp = sgu_g + li * 1024 + g8 * 128 + c0; float* op = VN + (size_t)row * 1024 + g8 * 128 + c0;
#pragma unroll
                    for (int j = 0; j < 16; j += 4) { f32x4 o; o.x = v[j] * rstd * gp[j]; o.y = v[j + 1] * rstd * gp[j + 1]; o.z = v[j + 2] * rstd * gp[j + 2]; o.w = v[j + 3] * rstd * gp[j + 3]; *(GAS f32x4*)(op + j) = o; }
                }
            } else {
                for (int idx = gt; idx < MLAT * 12 * 2 * 2 * 32; idx += NT) {
                    const int pi = idx & 31, mp = (idx >> 5) & 1, qk = (idx >> 6) & 1, rest = idx >> 7, hh = rest % 12, row = rest / 12;
                    const int axis = pi >> 4, i = pi & 15, n = row & (SEQ - 1); const float pos = (float)(axis == 0 ? (n >> 6) : (n & 63));
                    const float inv = exp2f(-(float)i * (13.287712379549449f / 16.0f)); const float ang = pos * inv; float sn, cs; sincosf(ang, &sn, &cs);
                    bf16* zp = P + (size_t)row * INW + qk * 1536 + hh * 128 + mp * 64 + axis * 32 + i;
                    const float z1 = bf2f(zp[0]), z2 = bf2f(zp[16]);
                    zp[0] = (bf16)f2bf(z1 * cs - z2 * sn); zp[16] = (bf16)f2bf(z2 * cs + z1 * sn);
                }
                LAS f32x2* tw = (LAS f32x2*)(lds + RING_OFF);
                if (tid < 128) { float sn, cs; sincospif(2.0f * (float)tid / 128.0f, &sn, &cs); tw[tid] = (f32x2){cs, sn}; }
                __syncthreads();
                for (int idx = gt; idx < MALL * 512; idx += NT) {
                    const int row = idx >> 9, gj = idx & 511, g4 = gj >> 7, j = gj & 127; const bf16* xp = P + (size_t)row * INW + 4608 + g4 * 128; float fa = 0.f, fb = 0.f;
                    for (int c8 = 0; c8 < 16; ++c8) { const v4u w = ((const GAS v4u*)xp)[c8]; const float xv[8] = {bflo(w.x), bfhi(w.x), bflo(w.y), bfhi(w.y), bflo(w.z), bfhi(w.z), bflo(w.w), bfhi(w.w)};
#pragma unroll
                        for (int e = 0; e < 8; ++e) { const f32x2 t = tw[(j * (c8 * 8 + e)) & 127]; fa += xv[e] * t.x; fb += xv[e] * t.y; } }
                    FA[idx] = fa; FB[idx] = fb;
                }
                __syncthreads();
            }
        }
        SEAM(pb + 2);
        if (IN(pb + 3)) {
            THREAD_IDS();
            const bf16* P = WSP(bf16, WS_P); bf16* MIX = WSP(bf16, WS_MIX); const float* VN = WSP(float, WS_VN); const float* FA = WSP(float, WS_FA); const float* FB = WSP(float, WS_FB);
            const float* sgu_w = ARG(11); const float* sgu_b = ARG(12); const float* na_rpb = ARG(13);
            if (!odd) {
                for (int idx = gt; idx < MR * 1024; idx += NT) {
                    const int row = idx >> 10, col = idx & 1023, g8 = col >> 7, p = row & 127, cb = row - p;
                    const float* wrow = sgu_w + ((size_t)(li * 8 + g8) * 128 + p) * 128; float acc = sgu_b[(li * 8 + g8) * 128 + p];
                    const float* vp = VN + (size_t)cb * 1024 + col;
#pragma unroll 8
                    for (int q = 0; q < 128; ++q) acc += wrow[q] * vp[(size_t)q * 1024];
                    MIX[(size_t)row * DM + col] = (bf16)f2bf(bf2f(P[(size_t)row * INW + col]) * acc);
                }
                const float* rpb = na_rpb + (size_t)li * 8 * 15 * 31;
                for (int idx = gt; idx < MLAT * 8 * 4; idx += NT) {
                    const int vq = idx & 3, hh = (idx >> 2) & 7, n = (idx >> 5) & (SEQ - 1), b = idx >> 17;
                    const int r = n >> 6, c = n & 63, rs = min(max(r - 4, 0), 56), cs = min(max(c - 8, 0), 48);
                    const size_t qrow = (size_t)b * SEQ + n; float q[128], o[32];
                    load_q<128>(P + qrow * INW + 2048 + hh * 128, 0.08838834764831845f, q);
                    const float* rp = rpb + hh * 15 * 31;
                    auto keyf = [&](int i, size_t& koff, size_t& voff, float& bias) {
                        size_t krow;
                        if (i < 128) { const int a = i >> 4, w = i & 15; krow = (size_t)b * SEQ + (rs + a) * 64 + cs + w; bias = rp[(rs + a - r + 7) * 31 + (cs + w - c + 15)]; }
                        else { krow = (size_t)MLAT + b * NCTX + (i - 128); bias = 0.f; }
                        koff = krow * INW + 3072 + hh * 128; voff = krow * INW + 4096 + hh * 128 + vq * 32; };
                    naive_attn<128, 32>(P, q, 128 + NCTX, keyf, o);
                    store_bf<32>(MIX + qrow * DM + 1024 + hh * 128 + vq * 32, o);
                }
                if (need_ctx) for (int idx = gt; idx < MCTX * 8 * 4; idx += NT) {
                    const int vq = idx & 3, hh = (idx >> 2) & 7, cq = (idx >> 5) & (NCTX - 1), b = idx >> 13;
                    const size_t qrow = (size_t)MLAT + b * NCTX + cq; float q[128], o[32];
                    load_q<128>(P + qrow * INW + 2048 + hh * 128, 0.08838834764831845f, q);
                    auto keyf = [&](int i, size_t& koff, size_t& voff, float& bias) { const size_t krow = (size_t)MLAT + b * NCTX + i; bias = 0.f; koff = krow * INW + 3072 + hh * 128; voff = krow * INW + 4096 + hh * 128 + vq * 32; };
                    naive_attn<128, 32>(P, q, NCTX, keyf, o);
                    store_bf<32>(MIX + qrow * DM + 1024 + hh * 128 + vq * 32, o);
                }
            } else {
                {
                    const int vcu = (G % 8 == 0) ? (bx % 8) * (G / 8) + bx / 8 : bx;
                    const float lam = WSP(float, WS_LAM)[li], post = 1.0f - (li == 0 ? LAM_INIT1 : LAM_INIT3); const float* sub_g = ARG(18) + li * 128;
                    const int NU = NB * 12 * 32 + (need_ctx ? NB * 12 * 2 : 0);
                    for (int u = vcu; u < NU; u += G) {
                        int bh, qrow0, nlt;
                        if (u < NB * 12 * 32) { bh = u >> 5; qrow0 = (bh / 12) * SEQ + (u & 31) * 128; nlt = SEQ / 64; }
                        else { const int v = u - NB * 12 * 32; bh = v >> 1; qrow0 = MLAT + (bh / 12) * NCTX + (v & 1) * 128; nlt = 0; }
                        const int b = bh / 12, hh = bh % 12;
                        da::unit(P, MIX, qrow0, hh, b * SEQ, nlt, MLAT + b * NCTX, lam, post, sub_g, (LAS char*)(lds + RING_OFF), tid);
                    }
                    __syncthreads();
                }
                LAS f32x2* tw = (LAS f32x2*)(lds + RING_OFF);
                for (int t = tid; t < SEQ; t += NWAVES * 64) { float sn, cs; sincospif(2.0f * (float)t / (float)SEQ, &sn, &cs); tw[t] = (f32x2){cs, sn}; }
                __syncthreads();
                for (int idx = gt; idx < NB * 512 * 512; idx += NT) {
                    const int gj = idx & 511, kg = (idx >> 9) & 511, b = idx >> 18; float acc[8];
#pragma unroll
                    for (int e = 0; e < 8; ++e) acc[e] = 0.f;
                    const float* fa = FA + (size_t)b * SEQ * 512 + gj; const float* fb = FB + (size_t)b * SEQ * 512 + gj;
                    for (int n = 0; n < SEQ; ++n) { const float a = fa[(size_t)n * 512], bb = fb[(size_t)n * 512];
#pragma unroll
                        for (int e = 0; e < 8; ++e) { const f32x2 t = tw[((kg + 512 * e) * n) & (SEQ - 1)]; acc[e] += a * t.x - bb * t.y; } }
#pragma unroll
                    for (int e = 0; e < 8; ++e) MIX[((size_t)b * SEQ + kg + 512 * e) * DM + 1536 + gj] = (bf16)f2bf(acc[e] * 0.0013810679320049757f);
                }
                if (need_ctx) for (int idx = gt; idx < NB * NCTX * 512; idx += NT) {
                    const int gj = idx & 511, k = (idx >> 9) & (NCTX - 1), b = idx >> 17; float acc = 0.f;
                    const float* fa = FA + ((size_t)MLAT + b * NCTX) * 512 + gj; const float* fb = FB + ((size_t)MLAT + b * NCTX) * 512 + gj;
                    for (int n = 0; n < NCTX; ++n) { const f32x2 t = tw[((k * n) & (NCTX - 1)) * 16]; acc += fa[(size_t)n * 512] * t.x - fb[(size_t)n * 512] * t.y; }
                    MIX[((size_t)MLAT + b * NCTX + k) * DM + 1536 + gj] = (bf16)f2bf(acc * 0.005524271728019903f);
                }
                __syncthreads();
            }
        }
        SEAM(pb + 3);
        if (IN(pb + 5)) {
            THREAD_IDS();
            pg8::Gemm g{WSP(bf16, WS_MIX), WSP(bf16, WS_WOUT) + (size_t)l * DM * DM, MR, DM, DM}; pg8::StaticOrder S; S.init(MR, DM, G, bx);
            pg8::EpiResid E{WSP(float, WS_X), DM, MODL() + 2 * DM, ADA};
            pg8::gemm_phase<pg8::EpiResid, pg8::StaticOrder, true, true>(lds + RING_OFF, g, S, E, tid);
        }
        SEAM(pb + 5);
        if (IN(pb + 6)) { THREAD_IDS(); norm_rows<0>(WSP(float, WS_X), WSP(bf16, WS_H), nullptr, ARG(7) + l * DM, MODL(), 3, MR, gw, NGW, lane); }
        SEAM(pb + 6);
        if (IN(pb + 7)) {
            THREAD_IDS();
            pg8::Gemm g{WSP(bf16, WS_H), WSP(bf16, WS_W1) + (size_t)l * DFF * DM, MR, DFF, DM}; pg8::StaticOrder S; S.init(MR, DFF, G, bx);
            pg8::EpiBf16<1> E{WSP(bf16, WS_HID), DFF};
            pg8::gemm_phase<pg8::EpiBf16<1>, pg8::StaticOrder, true, true>(lds + RING_OFF, g, S, E, tid);
        }
        SEAM(pb + 7);
        if (IN(pb + 8)) {
            THREAD_IDS();
            pg8::Gemm g{WSP(bf16, WS_HID), WSP(bf16, WS_W2) + (size_t)l * DM * DFF, MR, DM, DFF}; pg8::StaticOrder S; S.init(MR, DM, G, bx);
            pg8::EpiResid E{WSP(float, WS_X), DM, MODL() + 5 * DM, ADA};
            pg8::gemm_phase<pg8::EpiResid, pg8::StaticOrder, true, true>(lds + RING_OFF, g, S, E, tid);
        }
        SEAM(pb + 8);
    }
    if (IN(NPH - 1)) { THREAD_IDS(); norm_rows<1>(WSP(float, WS_X), nullptr, KA()->out, ARG(21), nullptr, 0, MLAT, gw, NGW, lane); }
#undef IN
#undef SEAM
#undef GRID_BAR
}

extern "C" void kernel_launch(void* const* d_in, const int* in_sizes, int n_in, void* d_out, int out_size, void* d_ws, size_t ws_size, hipStream_t stream) {
    static int grid = 0;
    if (grid == 0) {
        if (n_in != 22 || in_sizes[0] != MLAT * DM || out_size != MLAT * DM || ws_size < WS_END) { fprintf(stderr, "kernel_launch: unexpected shapes (n_in %d, in0 %d, out %d, ws %zu); nothing launched\n", n_in, n_in > 0 ? in_sizes[0] : -1, out_size, ws_size); grid = -1; return; }
        int dev = 0, cus = 0, per_cu = 0;
        if (hipGetDevice(&dev) != hipSuccess || hipDeviceGetAttribute(&cus, hipDeviceAttributeMultiprocessorCount, dev) != hipSuccess) { grid = -1; return; }
        if (hipFuncSetAttribute((const void*)fwd, hipFuncAttributeMaxDynamicSharedMemorySize, LDS_BYTES) != hipSuccess) { fprintf(stderr, "kernel_launch: hipFuncSetAttribute failed\n"); grid = -1; return; }
        if (hipOccupancyMaxActiveBlocksPerMultiprocessor(&per_cu, (const void*)fwd, NWAVES * 64, LDS_BYTES) != hipSuccess || per_cu < 1) fprintf(stderr, "kernel_launch: occupancy query reports %d workgroups per CU\n", per_cu);
        (void)hipGetLastError();
        grid = cus;
    }
    if (grid < 0) return;
    if (hipMemsetAsync((char*)d_ws + WS_CTL, 0, CTL_ZERO_BYTES, stream) != hipSuccess) return;
    Args a{};
    for (int i = 0; i < 22; ++i) a.in[i] = (const float*)d_in[i];
    a.out = (float*)d_out; a.ws = (unsigned char*)d_ws;
#if MK_ONE_LAUNCH
    a.ph_lo = 0; a.ph_hi = NPH;
    hipLaunchKernelGGL(fwd, dim3(grid), dim3(NWAVES * 64), LDS_BYTES, stream, a);
#else
    for (int ph = 0; ph < NPH; ++ph) {
        if (ph >= 2 && ph < NPH - 1) { const int l = (ph - 2) / 9, k = (ph - 2) % 9; if (k == 4) continue; (void)l; }
        a.ph_lo = ph; a.ph_hi = ph + 1;
        hipLaunchKernelGGL(fwd, dim3(grid), dim3(NWAVES * 64), LDS_BYTES, stream, a);
    }
#endif
    const hipError_t le = hipPeekAtLastError();
    if (le != hipSuccess) fprintf(stderr, "kernel_launch: launch failed: %s\n", hipGetErrorName(le));
}
```

```cpp
#include <hip/hip_runtime.h>
#include <cstdio>
#include <cstdint>
namespace pg8 {
#define PG8_LAS __attribute__((address_space(3)))
typedef unsigned short bf16_t;
typedef short bf16x8 __attribute__((ext_vector_type(8)));
typedef float f32x4 __attribute__((ext_vector_type(4)));
typedef unsigned u32x4 __attribute__((ext_vector_type(4)));
constexpr int BM = 256, BK = 64, HALF = 128, HTB = HALF * BK * 2  , STAGE_BYTES = 8 * HTB, NXCD = 8, WGM = 8;

__host__ __device__ __forceinline__ int lds_byte(int r, int c) { const int st = (r >> 4) * 2 + (c >> 5), rr = r & 15, cc = c & 31, ob = rr * 64 + cc * 2; return st * 1024 + (ob ^ (((ob >> 9) & 1) << 5)); }
__host__ __device__ __forceinline__ void stage_rc(int b, int& R, int& C) { const int st = b / 1024, sb = b % 1024, swz = sb ^ (((sb >> 9) & 1) << 5); R = (st >> 1) * 16 + swz / 64; C = (st & 1) * 32 + (swz % 64) / 2; }
__host__ __device__ __forceinline__ int perm32(int rho) { const int n = rho >> 4, i = rho & 15; return 8 * (i >> 2) + 4 * n + (i & 3); }

struct Unit { int pm, pn; };
struct Gemm { const bf16_t* A; const bf16_t* Bt; int M, N, K; };

struct StaticOrder {
    int nM, nN, nwg, G, c;
    __host__ __device__ void init(int M, int N, int G_, int c_) { nM = M / BM; nN = N / BM; nwg = nM * nN; G = G_; c = c_; }
    __host__ __device__ bool next(int i, Unit& u) const {
        const long L = (long)i * G + c; if (L >= nwg) return false;
        int wgid = (int)L; { const int q = nwg / NXCD, r = nwg % NXCD, xcd = wgid % NXCD, off = wgid / NXCD; wgid = (xcd < r ? xcd * (q + 1) : r * (q + 1) + (xcd - r) * q) + off; }
        const int nig = WGM * nN, gid = wgid / nig, fm = gid * WGM, gsz = (nM - fm) < WGM ? (nM - fm) : WGM;
        u.pm = fm + ((wgid % nig) % gsz); u.pn = (wgid % nig) / gsz; return true;
    }
    __device__ __forceinline__ void a_ready(const Unit&) const {}
    __device__ __forceinline__ void done(const Unit&) const {}
};

__device__ __forceinline__ unsigned cvt_pk_bf16(float lo, float hi) { unsigned r; asm volatile("v_cvt_pk_bf16_f32 %0, %1, %2" : "=v"(r) : "v"(lo), "v"(hi)); return r; }

template <int ACT  > struct EpiBf16 {
    static constexpr bool PERM = true, AFTER_DRAIN = false;
    bf16_t* O; int ldc;
    __device__ __forceinline__ void operator()(const f32x4 (&acc)[2][2][4][2], const Unit& u, int wr, int wc, int fr, int fq) const {
        const int row0 = u.pm * BM + wr * 64 + fr; const int col0 = u.pn * BM + wc * 32 + 8 * fq;
#pragma unroll
        for (int ai = 0; ai < 2; ++ai)
#pragma unroll
            for (int m = 0; m < 4; ++m) { bf16_t* rowp = O + (size_t)(row0 + ai * HALF + m * 16) * ldc + col0;
#pragma unroll
                for (int bj = 0; bj < 2; ++bj) { f32x4 v0 = acc[ai][bj][m][0], v1 = acc[ai][bj][m][1];
                    if (ACT == 1) {
#pragma unroll
                        for (int j = 0; j < 4; ++j) { const float a = fmaxf(v0[j], 0.f), b = fmaxf(v1[j], 0.f); v0[j] = a * a; v1[j] = b * b; } }
                    u32x4 w; w.x = cvt_pk_bf16(v0[0], v0[1]); w.y = cvt_pk_bf16(v0[2], v0[3]); w.z = cvt_pk_bf16(v1[0], v1[1]); w.w = cvt_pk_bf16(v1[2], v1[3]);
                    *(u32x4*)(rowp + bj * HALF) = w; } }
    }
};
struct EpiResid {
    static constexpr bool PERM = false, AFTER_DRAIN = false;
    float* X; int ldc; const float* gate; int gate_stride;
    __device__ __forceinline__ void operator()(const f32x4 (&acc)[2][2][4][2], const Unit& u, int wr, int wc, int fr, int fq) const {
        const int row0 = u.pm * BM + wr * 64 + fr, col0 = u.pn * BM + wc * 32 + 4 * fq;
        const float* g = gate + (size_t)(u.pm < 64 ? (u.pm >> 4) : 4) * gate_stride;
        f32x4 gv[2][2];
#pragma unroll
        for (int bj = 0; bj < 2; ++bj)
#pragma unroll
            for (int n = 0; n < 2; ++n) gv[bj][n] = *(const f32x4*)(g + col0 + bj * HALF + n * 16);
#pragma unroll
        for (int ai = 0; ai < 2; ++ai)
#pragma unroll
            for (int m = 0; m < 4; ++m) { float* rowp = X + (size_t)(row0 + ai * HALF + m * 16) * ldc + col0;
#pragma unroll
                for (int bj = 0; bj < 2; ++bj)
#pragma unroll
                    for (int n = 0; n < 2; ++n) { const f32x4 xo = *(const f32x4*)(rowp + bj * HALF + n * 16); *(f32x4*)(rowp + bj * HALF + n * 16) = xo + gv[bj][n] * acc[ai][bj][m][n]; } }
    }
};

struct EpiUV {
    static constexpr bool PERM = true, AFTER_DRAIN = false;
    bf16_t* UV2;
    __device__ __forceinline__ void operator()(const f32x4 (&acc)[2][2][4][2], const Unit& u, int wr, int wc, int fr, int fq) const {
        const int uv = u.pm >> 4, k0 = (u.pm & 15) * BM + wr * 64 + fr, cc = wc * 32 + 8 * fq;
#pragma unroll
        for (int ai = 0; ai < 2; ++ai)
#pragma unroll
            for (int m = 0; m < 4; ++m) { const int k = k0 + ai * HALF + m * 16;
#pragma unroll
                for (int bj = 0; bj < 2; ++bj) { const int bg = 2 * u.pn + bj; const f32x4 v0 = acc[ai][bj][m][0], v1 = acc[ai][bj][m][1];
                    u32x4 w; w.x = cvt_pk_bf16(v0[0], v0[1]); w.y = cvt_pk_bf16(v0[2], v0[3]); w.z = cvt_pk_bf16(v1[0], v1[1]); w.w = cvt_pk_bf16(v1[2], v1[3]);
                    *(u32x4*)(UV2 + ((size_t)k * 16 + bg) * 256 + uv * 128 + cc) = w; } }
    }
};
struct EpiChan {
    static constexpr bool PERM = true, AFTER_DRAIN = false;
    bf16_t* MIX; float scale;
    __device__ __forceinline__ void operator()(const f32x4 (&acc)[2][2][4][2], const Unit& u, int wr, int wc, int fr, int fq) const {
        const int b = fr >> 2, g = fr & 3, kq0 = u.pm * 16 + wr * 4, j0 = wc * 32 + 8 * fq;
#pragma unroll
        for (int ai = 0; ai < 2; ++ai)
#pragma unroll
            for (int m = 0; m < 4; ++m) { const int k = kq0 + ai * 8 + m; const f32x4 v0 = acc[ai][0][m][0] * scale, v1 = acc[ai][0][m][1] * scale;
                u32x4 w; w.x = cvt_pk_bf16(v0[0], v0[1]); w.y = cvt_pk_bf16(v0[2], v0[3]); w.z = cvt_pk_bf16(v1[0], v1[1]); w.w = cvt_pk_bf16(v1[2], v1[3]);
                *(u32x4*)(MIX + ((size_t)b * 4096 + k) * 2048 + 1536 + g * 128 + j0) = w; }
    }
};

template <class Epi, class Sched, bool ALIGN_EPI = false, bool SP2 = false>
__device__ __forceinline__ void gemm_phase(PG8_LAS unsigned char* lds, const Gemm g, const Sched& S, const Epi& E, const int tid) {
    const int wid = __builtin_amdgcn_readfirstlane(tid >> 6), lane = tid & 63, wr = wid >> 2, wc = wid & 3, fr = lane & 15, fq = lane >> 4;
    const int K = g.K, nt = K / BK;
    unsigned voffA[2], voffB[2];
#pragma unroll
    for (int i = 0; i < 2; ++i) { int R, C; stage_rc(tid * 16 + i * 8192, R, C); const int Rb = Epi::PERM ? ((R & ~31) + perm32(R & 31)) : R;
        voffA[i] = (unsigned)(R * K + C) * 2u; voffB[i] = (unsigned)(Rb * K + C) * 2u; }
    const size_t kstep = (size_t)(BK * 2);
    const size_t hstep = (size_t)HALF * K * 2;
    const size_t tstep = 2 * hstep;
    const unsigned ldsw = (unsigned)wid * 1024u;
    const int aoff = lds_byte(wr * 64 + fr, fq * 8), boff = lds_byte(wc * 32 + fr, fq * 8);
#define PG8_SA(b, h) (((b) * 2 + (h)) * HTB)
#define PG8_SB(b, h) ((4 + (b) * 2 + (h)) * HTB)
#define PG8_STAGE(bufoff, gbase, voff) do { _Pragma("unroll") for (int _i = 0; _i < 2; ++_i) \
        __builtin_amdgcn_global_load_lds((const unsigned*)((const char*)(gbase) + (voff)[_i]), (PG8_LAS unsigned*)(lds + (bufoff) + ldsw + _i * 8192), 16, 0, 0); } while (0)
#define PG8_LDA(dst, b, h) do { _Pragma("unroll") for (int m = 0; m < 4; ++m) _Pragma("unroll") for (int k = 0; k < 2; ++k) dst[m][k] = *(const PG8_LAS bf16x8*)(lds + PG8_SA(b, h) + aoff + m * 2048 + k * 1024); } while (0)
#define PG8_LDB(dst, b, h) do { _Pragma("unroll") for (int n = 0; n < 2; ++n) _Pragma("unroll") for (int k = 0; k < 2; ++k) dst[n][k] = *(const PG8_LAS bf16x8*)(lds + PG8_SB(b, h) + boff + n * 2048 + k * 1024); } while (0)
#define PG8_MMA(ai, bj, At, Bt) do { __builtin_amdgcn_s_setprio(1); _Pragma("unroll") for (int m = 0; m < 4; ++m) _Pragma("unroll") for (int n = 0; n < 2; ++n) _Pragma("unroll") for (int k = 0; k < 2; ++k) \
        acc[ai][bj][m][n] = __builtin_amdgcn_mfma_f32_16x16x32_bf16(Bt[n][k], At[m][k], acc[ai][bj][m][n], 0, 0, 0); __builtin_amdgcn_s_setprio(0); } while (0)
#define PG8_WAIT_V(n) asm volatile("s_waitcnt vmcnt(" #n ")" ::: "memory")
#define PG8_WAIT_L(n) asm volatile("s_waitcnt lgkmcnt(" #n ")" ::: "memory")
#define PG8_BAR __builtin_amdgcn_s_barrier()
#define PG8_SCHED __builtin_amdgcn_sched_barrier(0)
    Unit cur, nxt; int ui = 0;
    if (!S.next(0, cur)) return;
    f32x4 acc[2][2][4][2];
#pragma unroll
    for (int a = 0; a < 2; ++a)
#pragma unroll
        for (int b = 0; b < 2; ++b)
#pragma unroll
            for (int m = 0; m < 4; ++m)
#pragma unroll
                for (int n = 0; n < 2; ++n) acc[a][b][m][n] = (f32x4){0.f, 0.f, 0.f, 0.f};
    bf16x8 At[4][2], B0[2][2], B1[2][2];
    const char* cA = (const char*)g.A + (size_t)cur.pm * tstep; const char* cB = (const char*)g.Bt + (size_t)cur.pn * tstep;
    S.a_ready(cur);
    if constexpr (SP2) {
        PG8_STAGE(PG8_SB(0, 0), cB, voffB); PG8_STAGE(PG8_SB(0, 1), cB + hstep, voffB); PG8_STAGE(PG8_SA(0, 0), cA, voffA); PG8_STAGE(PG8_SA(0, 1), cA + hstep, voffA);
        if (wr == 1) PG8_BAR;
        PG8_WAIT_V(2); PG8_BAR;
        PG8_STAGE(PG8_SB(1, 0), cB + kstep, voffB); PG8_STAGE(PG8_SA(1, 0), cA + kstep, voffA); PG8_STAGE(PG8_SB(1, 1), cB + hstep + kstep, voffB);
        PG8_WAIT_V(6); PG8_BAR;
    } else {
        PG8_STAGE(PG8_SB(0, 0), cB, voffB); PG8_STAGE(PG8_SA(0, 0), cA, voffA); PG8_STAGE(PG8_SB(0, 1), cB + hstep, voffB); PG8_STAGE(PG8_SA(0, 1), cA + hstep, voffA);
        if (wr == 1) PG8_BAR;
        PG8_WAIT_V(4); PG8_BAR;
        PG8_STAGE(PG8_SB(1, 0), cB + kstep, voffB); PG8_STAGE(PG8_SA(1, 0), cA + kstep, voffA); PG8_STAGE(PG8_SB(1, 1), cB + hstep + kstep, voffB);
        PG8_WAIT_V(6); PG8_BAR;
    }
    for (;;) {
        const bool has_next = S.next(ui + 1, nxt);
        const char* nA = has_next ? (const char*)g.A + (size_t)nxt.pm * tstep : cA; const char* nB = has_next ? (const char*)g.Bt + (size_t)nxt.pn * tstep : cB;
        for (int t = 0; t < nt; t += 2) {
            const bool last = (t == nt - 2);
            const char* a1 = cA + (size_t)(t + 1) * kstep;
            const char* a2 = last ? nA : cA + (size_t)(t + 2) * kstep; const char* b2 = last ? nB : cB + (size_t)(t + 2) * kstep;
            const char* a3 = a2 + kstep; const char* b3 = b2 + kstep;
            if (last && has_next) S.a_ready(nxt);
            if constexpr (SP2) {
            PG8_LDB(B0, 0, 0); PG8_LDB(B1, 0, 1); PG8_SCHED; PG8_LDA(At, 0, 0); PG8_STAGE(PG8_SA(1, 1), a1 + hstep, voffA);
            PG8_WAIT_V(8); PG8_WAIT_L(0); PG8_BAR; PG8_MMA(0, 0, At, B0); PG8_MMA(0, 1, At, B1); PG8_BAR; PG8_SCHED;
            PG8_LDA(At, 0, 1); PG8_STAGE(PG8_SB(0, 0), b2, voffB); PG8_STAGE(PG8_SB(0, 1), b2 + hstep, voffB); PG8_STAGE(PG8_SA(0, 0), a2, voffA);
            PG8_WAIT_V(8); PG8_WAIT_L(0); PG8_BAR; PG8_MMA(1, 0, At, B0); PG8_MMA(1, 1, At, B1); PG8_BAR; PG8_SCHED;
            PG8_LDB(B0, 1, 0); PG8_LDB(B1, 1, 1); PG8_SCHED; PG8_LDA(At, 1, 0); PG8_STAGE(PG8_SA(0, 1), a2 + hstep, voffA);
            PG8_WAIT_V(8); PG8_WAIT_L(0); PG8_BAR; PG8_MMA(0, 0, At, B0); PG8_MMA(0, 1, At, B1); PG8_BAR; PG8_SCHED;
            PG8_LDA(At, 1, 1); PG8_STAGE(PG8_SB(1, 0), b3, voffB); PG8_STAGE(PG8_SB(1, 1), b3 + hstep, voffB); PG8_STAGE(PG8_SA(1, 0), a3, voffA);
            PG8_WAIT_V(8); PG8_WAIT_L(0); PG8_BAR; PG8_MMA(1, 0, At, B0); PG8_MMA(1, 1, At, B1); PG8_BAR; PG8_SCHED;
            } else {
            PG8_LDB(B0, 0, 0); PG8_SCHED; PG8_LDA(At, 0, 0); PG8_STAGE(PG8_SA(1, 1), a1 + hstep, voffA);
            PG8_WAIT_L(8); PG8_BAR; PG8_WAIT_L(0); PG8_MMA(0, 0, At, B0); PG8_BAR; PG8_SCHED;
            PG8_LDB(B1, 0, 1); PG8_STAGE(PG8_SB(0, 0), b2, voffB);
            PG8_BAR; PG8_WAIT_L(0); PG8_MMA(0, 1, At, B1); PG8_BAR;
            PG8_LDA(At, 0, 1); PG8_STAGE(PG8_SA(0, 0), a2, voffA);
            PG8_BAR; PG8_WAIT_L(0); PG8_MMA(1, 0, At, B0); PG8_BAR; PG8_SCHED;
            PG8_STAGE(PG8_SB(0, 1), b2 + hstep, voffB);
            PG8_WAIT_V(6); PG8_BAR; PG8_MMA(1, 1, At, B1); PG8_BAR;
            PG8_LDB(B0, 1, 0); PG8_SCHED; PG8_LDA(At, 1, 0); PG8_STAGE(PG8_SA(0, 1), a2 + hstep, voffA);
            PG8_WAIT_L(8); PG8_BAR; PG8_WAIT_L(0); PG8_MMA(0, 0, At, B0); PG8_BAR; PG8_SCHED;
            PG8_LDB(B1, 1, 1); PG8_STAGE(PG8_SB(1, 0), b3, voffB);
            PG8_BAR; PG8_WAIT_L(0); PG8_MMA(0, 1, At, B1); PG8_BAR;
            PG8_LDA(At, 1, 1); PG8_STAGE(PG8_SA(1, 0), a3, voffA);
            PG8_BAR; PG8_WAIT_L(0); PG8_MMA(1, 0, At, B0); PG8_BAR; PG8_SCHED;
            PG8_STAGE(PG8_SB(1, 1), b3 + hstep, voffB);
            PG8_WAIT_V(6); PG8_BAR; PG8_MMA(1, 1, At, B1); PG8_BAR;
            }
        }
        if constexpr (ALIGN_EPI) { if (wr == 0) PG8_BAR; }
        if constexpr (!Epi::AFTER_DRAIN) { E(acc, cur, wr, wc, fr, fq); S.done(cur); }
        if (!has_next) break;
#pragma unroll
        for (int a = 0; a < 2; ++a)
#pragma unroll
            for (int b = 0; b < 2; ++b)
#pragma unroll
                for (int m = 0; m < 4; ++m)
#pragma unroll
                    for (int n = 0; n < 2; ++n) acc[a][b][m][n] = (f32x4){0.f, 0.f, 0.f, 0.f};
        cur = nxt; cA = nA; cB = nB; ++ui;
        if constexpr (ALIGN_EPI) { if (wr == 1) PG8_BAR; }
    }
    PG8_WAIT_V(0);
    if constexpr (!ALIGN_EPI) { if (wr == 0) PG8_BAR; }
    PG8_BAR;
    if constexpr (Epi::AFTER_DRAIN) { E.fused(acc, cur, wr, wc, fr, fq, lds, wid, lane); S.done(cur); }
#undef PG8_SA
#undef PG8_SB
#undef PG8_STAGE
#undef PG8_LDA
#undef PG8_LDB
#undef PG8_MMA
#undef PG8_WAIT_V
#undef PG8_WAIT_L
#undef PG8_BAR
#undef PG8_SCHED
}
}

constexpr int NWAVES = 8;
#ifndef MK_ONE_LAUNCH
#define MK_ONE_LAUNCH 1
#endif

constexpr int DM = 2048, NB = 4, SEQ = 4096, DEPTH = 4, NCTX = 256, INW = 5120, DFF = 8192, ADA = 6 * DM;
constexpr int MLAT = NB * SEQ, MCTX = NB * NCTX, MALL = MLAT + MCTX;
constexpr float LAM_INIT1 = 0.35550906759096926f, LAM_INIT3 = 0.5560582041556405f;

constexpr size_t MiB = 1u << 20;
constexpr size_t WS_CTL = 0, CTL_ZERO_BYTES = 1 * MiB;
constexpr size_t WS_MOD = 1 * MiB;
constexpr size_t WS_LAM = 2 * MiB;
constexpr size_t WS_ADAP = 3 * MiB;
constexpr size_t WS_WIN = 16 * MiB, WS_WOUT = 96 * MiB, WS_W1 = 128 * MiB, WS_W2 = 256 * MiB;
constexpr size_t WS_X = 384 * MiB;
constexpr size_t WS_H = 520 * MiB;
constexpr size_t WS_P = 588 * MiB;
constexpr size_t WS_MIX = 758 * MiB;
constexpr size_t WS_HID = 826 * MiB;
constexpr size_t WS_VN = 826 * MiB;
constexpr size_t WS_O12 = 826 * MiB;
constexpr size_t WS_FA = 1030 * MiB, WS_FB = 1064 * MiB;
constexpr size_t WS_CS = 1098 * MiB;
constexpr size_t WS_CT = 1162 * MiB;
constexpr size_t WS_FT = 1163 * MiB;
constexpr size_t WS_UV = 1179 * MiB;
constexpr size_t WS_END = 1211 * MiB;
constexpr int CW_BAR = 4096;

constexpr int RING_OFF = 0, RING_BYTES = 131072;
constexpr int LDSCTL_OFF = RING_BYTES, MISC_OFF = LDSCTL_OFF + 320;
constexpr int LDS_BYTES = 147456;

#define GAS __attribute__((address_space(1)))
#define LAS __attribute__((address_space(3)))
typedef unsigned short bf16;
typedef unsigned v4u __attribute__((ext_vector_type(4)));
typedef unsigned v2u __attribute__((ext_vector_type(2)));
typedef float f32x4 __attribute__((ext_vector_type(4)));
typedef float f32x2 __attribute__((ext_vector_type(2)));
#define LDS_WAIT() asm volatile("s_waitcnt lgkmcnt(0)" ::: "memory")
__device__ __forceinline__ unsigned f2bf(float f) { unsigned u = __builtin_bit_cast(unsigned, f); return (u + 0x7fffu + ((u >> 16) & 1u)) >> 16; }
__device__ __forceinline__ unsigned pk2(float lo, float hi) { return f2bf(lo) | (f2bf(hi) << 16); }
__device__ __forceinline__ float bf2f(bf16 v) { return __builtin_bit_cast(float, (unsigned)v << 16); }
__device__ __forceinline__ float bflo(unsigned w) { return __builtin_bit_cast(float, w << 16); }
__device__ __forceinline__ float bfhi(unsigned w) { return __builtin_bit_cast(float, w & 0xffff0000u); }
#define XB_TMO      128
#define XB_XCNT(j)  (256  + 64 * (j))
#define XB_XSUB(j)  (1280 + 64 * (j))
#define XB_XGEN(j)  (2304 + 64 * (j))
#define XB_TOP      3328
#define XB_TOPGEN   3392
#define XCD_BAR_WORDS 3456
#define XB_SPIN_CAP (1u << 20)

__device__ __forceinline__ unsigned xb_ld(unsigned* p)              { return __hip_atomic_load(p, __ATOMIC_RELAXED, __HIP_MEMORY_SCOPE_AGENT); }
__device__ __forceinline__ unsigned xb_add(unsigned* p, unsigned v) { return __hip_atomic_fetch_add(p, v, __ATOMIC_RELAXED, __HIP_MEMORY_SCOPE_AGENT); }
__device__ __forceinline__ unsigned xb_xcc_id() { return (unsigned)__builtin_amdgcn_s_getreg((3 << 11) | 20) & 0xFu; }
#define XB_SPIN(cond, bar) do { unsigned _sp = 0; while (cond) { __builtin_amdgcn_s_sleep(1); \
    if ((++_sp & 255u) == 0u) { if (xb_ld(&(bar)[XB_TMO])) break; if (_sp > XB_SPIN_CAP) { atomicAdd(&(bar)[XB_TMO], 1u); break; } } } } while (0)

struct XcdBarrier {
    unsigned* bar; unsigned x;
    volatile LAS unsigned* st;
};

__device__ __forceinline__ XcdBarrier xcd_barrier_post(unsigned* bar, volatile LAS unsigned* st) {
    XcdBarrier b; b.bar = bar; b.x = xb_xcc_id(); b.st = st;
    if (threadIdx.x == 0) (void)xb_add(&bar[XB_XCNT(b.x)], 1u);
    return b;
}
__device__ __forceinline__ void xcd_barrier_complete(unsigned* bar, unsigned x, unsigned& nloc, unsigned& nx) {
    const unsigned G = gridDim.x * gridDim.y * gridDim.z;
    unsigned sum, cnt, mine, sp = 0u;
    for (;;) {
        sum = 0u; cnt = 0u; mine = 0u;
#pragma unroll
        for (unsigned j = 0; j < 16; ++j) { const unsigned c = xb_ld(&bar[XB_XCNT(j)]); sum += c; cnt += (c > 0u) ? 1u : 0u; mine = (j == x) ? c : mine; }
        if (sum == G) break;
        __builtin_amdgcn_s_sleep(1);
        if ((++sp & 255u) == 0u) { if (xb_ld(&bar[XB_TMO])) break; if (sp > XB_SPIN_CAP) { atomicAdd(&bar[XB_TMO], 1u); break; } }
    }
    nloc = mine > 0u ? mine : 1u; nx = cnt > 0u ? cnt : 1u;
}

__device__ __forceinline__ void xcd_barrier(const XcdBarrier& b) {
    asm volatile("s_waitcnt vmcnt(0)" ::: "memory");
    __syncthreads();
    if (threadIdx.x == 0) {
        unsigned* bar = b.bar;
        __builtin_amdgcn_s_waitcnt(0);
        unsigned nloc = b.st[0], nx = b.st[1];
        if (nloc == 0u) { xcd_barrier_complete(bar, b.x, nloc, nx); b.st[0] = nloc; b.st[1] = nx; }
        const unsigned old = xb_add(&bar[XB_XSUB(b.x)], 1u);
        const unsigned gen = old / nloc;
        if (old + 1u == (gen + 1u) * nloc) {
            __builtin_amdgcn_fence(__ATOMIC_RELEASE, "agent");
            asm volatile("s_waitcnt vmcnt(0)" ::: "memory");
            const unsigned og = xb_add(&bar[XB_TOP], 1u);
            const unsigned tg = og / nx;
            if (og + 1u == (tg + 1u) * nx) xb_add(&bar[XB_TOPGEN], 1u);
            else XB_SPIN(xb_ld(&bar[XB_TOPGEN]) == tg, bar);
            __builtin_amdgcn_fence(__ATOMIC_ACQUIRE, "agent");
            xb_add(&bar[XB_XGEN(b.x)], 1u);
            asm volatile("s_waitcnt vmcnt(0)" ::: "memory");
        } else {
            XB_SPIN(xb_ld(&bar[XB_XGEN(b.x)]) == gen, bar);
            __builtin_amdgcn_fence(__ATOMIC_ACQUIRE, "agent");
            asm volatile("s_waitcnt vmcnt(0)" ::: "memory");
        }
    }
    __syncthreads();
}

__device__ __forceinline__ float wave_sum(float v) {
#pragma unroll
    for (int o = 1; o < 64; o <<= 1) v += __shfl_xor(v, o);
    return v;
}
__device__ __forceinline__ void p0_transpose_item(const float* W, int K, int N, bf16* WT, LAS float* scr, int item, int lane) {
    const int nblk = N / 32, kb = item / nblk, nb = item % nblk, k0 = 64 * kb, n0 = 32 * nb;
#pragma unroll 8
    for (int i = 0; i < 32; ++i) { const int kk = 2 * i + (lane >> 5); scr[kk * 33 + (lane & 31)] = W[(size_t)(k0 + kk) * N + n0 + (lane & 31)]; }
    LDS_WAIT(); asm volatile("" ::: "memory");
    const int c = lane & 7;
#pragma unroll
    for (int j = 0; j < 4; ++j) { const int n = (lane >> 3) + 8 * j; const LAS float* s = scr + (8 * c) * 33 + n;
        v4u o; o.x = pk2(s[0 * 33], s[1 * 33]); o.y = pk2(s[2 * 33], s[3 * 33]); o.z = pk2(s[4 * 33], s[5 * 33]); o.w = pk2(s[6 * 33], s[7 * 33]);
        *(GAS v4u*)(WT + (size_t)(n0 + n) * K + k0 + 8 * c) = o; }
    LDS_WAIT(); asm volatile("" ::: "memory");
}

template <int MODE>
__device__ __forceinline__ void norm_rows(const float* X, bf16* H, float* OUT, const float* gain, const float* modl, int sh_chunk, int M, int gw, int NGW, int lane) {
    for (int row = gw; row < M; row += NGW) {
        const GAS f32x4* xr = (const GAS f32x4*)(X + (size_t)row * DM) + lane;
        f32x4 v[8]; float ss = 0.f;
#pragma unroll
        for (int j = 0; j < 8; ++j) { v[j] = xr[64 * j]; ss += (v[j].x * v[j].x + v[j].y * v[j].y) + (v[j].z * v[j].z + v[j].w * v[j].w); }
        const float rstd = 1.0f / sqrtf(wave_sum(ss) * (1.0f / DM) + 1e-6f);
        if (MODE == 0) {
            const float* mr = modl + (size_t)(row < MLAT ? (row >> 12) : 4) * ADA;
            const GAS f32x4* sh = (const GAS f32x4*)(mr + sh_chunk * DM) + lane; const GAS f32x4* sc = (const GAS f32x4*)(mr + (sh_chunk + 1) * DM) + lane;
            const GAS f32x4* gg = (const GAS f32x4*)gain + lane;
            GAS v2u* o8 = (GAS v2u*)(H + (size_t)row * DM) + lane;
#pragma unroll
            for (int j = 0; j < 8; ++j) { const f32x4 g4 = gg[64 * j], s4 = sc[64 * j], h4 = sh[64 * j]; const f32x4 y = v[j] * rstd * g4 * (s4 + 1.0f) + h4;
                v2u w; w.x = pk2(y.x, y.y); w.y = pk2(y.z, y.w); o8[64 * j] = w; }
        } else {
            const GAS f32x4* gg = (const GAS f32x4*)gain + lane; GAS f32x4* o = (GAS f32x4*)(OUT + (size_t)row * DM) + lane;
#pragma unroll
            for (int j = 0; j < 8; ++j) o[64 * j] = v[j] * rstd * gg[64 * j];
        }
    }
}

template <int N> __device__ __forceinline__ float dot_bf(const bf16* kp, const float (&q)[N]) {
    float s = 0.f;
#pragma unroll
    for (int c = 0; c < N / 8; ++c) { const v4u w = ((const GAS v4u*)kp)[c];
        s += q[8 * c + 0] * bflo(w.x) + q[8 * c + 1] * bfhi(w.x) + q[8 * c + 2] * bflo(w.y) + q[8 * c + 3] * bfhi(w.y)
           + q[8 * c + 4] * bflo(w.z) + q[8 * c + 5] * bfhi(w.z) + q[8 * c + 6] * bflo(w.w) + q[8 * c + 7] * bfhi(w.w); }
    return s;
}
template <int DQK, int DVS, class KeyF>
__device__ __forceinline__ void naive_attn(const bf16* P, const float (&q)[DQK], int nkeys, const KeyF& keyf, float (&o)[DVS]) {
    float m = -1e30f, l = 0.f;
    for (int i = 0; i < nkeys; ++i) { size_t koff, voff; float bias; keyf(i, koff, voff, bias);
        const float s = dot_bf<DQK>(P + koff, q) + bias; const float mn = fmaxf(m, s); l = l * __expf(m - mn) + __expf(s - mn); m = mn; }
    const float il = 1.0f / l;
#pragma unroll
    for (int j = 0; j < DVS; ++j) o[j] = 0.f;
    for (int i = 0; i < nkeys; ++i) { size_t koff, voff; float bias; keyf(i, koff, voff, bias);
        const float s = dot_bf<DQK>(P + koff, q) + bias; const float p = __expf(s - m) * il;
#pragma unroll
        for (int c = 0; c < DVS / 8; ++c) { const v4u w = ((const GAS v4u*)(P + voff))[c];
            o[8 * c + 0] += p * bflo(w.x); o[8 * c + 1] += p * bfhi(w.x); o[8 * c + 2] += p * bflo(w.y); o[8 * c + 3] += p * bfhi(w.y);
            o[8 * c + 4] += p * bflo(w.z); o[8 * c + 5] += p * bfhi(w.z); o[8 * c + 6] += p * bflo(w.w); o[8 * c + 7] += p * bfhi(w.w); } }
}
template <int N> __device__ __forceinline__ void load_q(const bf16* qp, float scale, float (&q)[N]) {
#pragma unroll
    for (int c = 0; c < N / 8; ++c) { const v4u w = ((const GAS v4u*)qp)[c];
        q[8 * c + 0] = scale * bflo(w.x); q[8 * c + 1] = scale * bfhi(w.x); q[8 * c + 2] = scale * bflo(w.y); q[8 * c + 3] = scale * bfhi(w.y);
        q[8 * c + 4] = scale * bflo(w.z); q[8 * c + 5] = scale * bfhi(w.z); q[8 * c + 6] = scale * bflo(w.w); q[8 * c + 7] = scale * bfhi(w.w); }
}
template <int N> __device__ __forceinline__ void store_bf(bf16* op, const float (&o)[N]) {
#pragma unroll
    for (int c = 0; c < N / 8; ++c) { v4u w; w.x = pk2(o[8 * c], o[8 * c + 1]); w.y = pk2(o[8 * c + 2], o[8 * c + 3]); w.z = pk2(o[8 * c + 4], o[8 * c + 5]); w.w = pk2(o[8 * c + 6], o[8 * c + 7]); ((GAS v4u*)op)[c] = w; }
}

namespace da {
using bf16x8 = __attribute__((ext_vector_type(8))) short;
using s16x4  = __attribute__((ext_vector_type(4))) short;
using f32x16 = __attribute__((ext_vector_type(16))) float;
using u32x4  = __attribute__((ext_vector_type(4))) unsigned;
constexpr int KVBLK = 64;
constexpr int SHM_V = KVBLK * 128 * 2, SHM_K = KVBLK * 128 * 2;
constexpr int LDS_X2 = 0;
constexpr int LDS_WS = 2 * SHM_V + 2 * SHM_K;
constexpr float SCALE = 0.125f;
constexpr float THR = 8.f;
#define DA_KSWZ(row, colB) ((row) * 256 + ((colB) ^ (((row) & 7) << 4)))
#define DA_SBAR() __builtin_amdgcn_sched_barrier(0)
__device__ __forceinline__ int crow(int r, int hi) { return (r & 3) + 8 * (r >> 2) + 4 * hi; }
__device__ __forceinline__ unsigned cvtpk(float lo, float hi) { unsigned r; asm volatile("v_cvt_pk_bf16_f32 %0, %1, %2" : "=v"(r) : "v"(lo), "v"(hi)); return r; }

__device__ __forceinline__ void partialSM(f32x16& p0, f32x16& p1, float& m_reg, float& mn, float& alpha) {
  constexpr float C = SCALE * 1.4426950408889634f;
  float pmax = p0[0];
#pragma unroll
  for (int r = 1; r < 16; ++r) pmax = fmaxf(pmax, p0[r]);
#pragma unroll
  for (int r = 0; r < 16; ++r) pmax = fmaxf(pmax, p1[r]);
  { auto rr = __builtin_amdgcn_permlane32_swap(__float_as_uint(pmax), __float_as_uint(pmax), false, false);
    pmax = fmaxf(__uint_as_float(rr[0]), __uint_as_float(rr[1])); }
  if (__builtin_expect(__all(pmax - m_reg <= THR / SCALE), 1)) { mn = m_reg; alpha = 1.f; }
  else { mn = fmaxf(m_reg, pmax); alpha = __builtin_amdgcn_exp2f((m_reg - mn) * C); m_reg = mn; }
  const float mnC = -mn * C;
#pragma unroll
  for (int r = 0; r < 16; ++r) p0[r] = fmaf(p0[r], C, mnC);
#pragma unroll
  for (int r = 0; r < 16; ++r) p1[r] = fmaf(p1[r], C, mnC);
#pragma unroll
  for (int r = 0; r < 16; ++r) p0[r] = __builtin_amdgcn_exp2f(p0[r]);
}
__device__ __forceinline__ void finishSM(f32x16& p0, f32x16& p1, float alpha, float& l_reg, bf16x8& pa0, bf16x8& pa1, bf16x8& pa2, bf16x8& pa3) {
#pragma unroll
  for (int r = 0; r < 16; ++r) p1[r] = __builtin_amdgcn_exp2f(p1[r]);
  float ps = 0;
#pragma unroll
  for (int r = 0; r < 16; ++r) ps += p0[r];
#pragma unroll
  for (int r = 0; r < 16; ++r) ps += p1[r];
  { auto rr = __builtin_amdgcn_permlane32_swap(__float_as_uint(ps), __float_as_uint(ps), false, false);
    ps = __uint_as_float(rr[0]) + __uint_as_float(rr[1]); }
  l_reg = l_reg * alpha + ps;
#define DA_PK4(P, BASE, OUT) do { unsigned a0 = cvtpk(P[BASE + 0], P[BASE + 1]), a1 = cvtpk(P[BASE + 2], P[BASE + 3]);   \
    unsigned b0 = cvtpk(P[BASE + 4], P[BASE + 5]), b1 = cvtpk(P[BASE + 6], P[BASE + 7]);                              \
    auto r0 = __builtin_amdgcn_permlane32_swap(a0, b0, false, false); auto r1 = __builtin_amdgcn_permlane32_swap(a1, b1, false, false); \
    u32x4 w = {r0[0], r1[0], r0[1], r1[1]}; OUT = *reinterpret_cast<bf16x8*>(&w); } while (0)
  DA_PK4(p0, 0, pa0); DA_PK4(p0, 8, pa1); DA_PK4(p1, 0, pa2); DA_PK4(p1, 8, pa3);
#undef DA_PK4
}
__device__ __forceinline__ void qkt(f32x16& p0, f32x16& p1, const LAS char* Ks, const bf16x8 (&qr)[4], int r32, int hi, int mapcolB) {
  p0 = f32x16{}; p1 = f32x16{};
#pragma unroll
  for (int d0 = 0; d0 < 4; ++d0) { const int cb = mapcolB + (d0 * 16 + hi * 8) * 2;
    const bf16x8 b0 = *reinterpret_cast<const LAS bf16x8*>(Ks + DA_KSWZ(r32, cb));
    const bf16x8 b1 = *reinterpret_cast<const LAS bf16x8*>(Ks + DA_KSWZ(32 + r32, cb));
    p0 = __builtin_amdgcn_mfma_f32_32x32x16_bf16(b0, qr[d0], p0, 0, 0, 0);
    p1 = __builtin_amdgcn_mfma_f32_32x32x16_bf16(b1, qr[d0], p1, 0, 0, 0); }
}
__device__ __forceinline__ int v_st(int k, int c) { const int kk = (k & ~0xC) | ((k & 4) << 1) | ((k & 8) >> 1); return ((kk >> 3) * 4 + (c >> 5)) * 512 + ((kk & 7) * 32 + (c & 31)) * 2; }
__device__ __forceinline__ int v_rd_base(int lane) { return ((lane & 3) << 3) | (((lane >> 2) & 3) << 6) | (((lane >> 4) & 1) << 5) | (((lane >> 5) & 1) << 8); }
constexpr int v_rd_off(int d0, int ks, int half) { return d0 * 512 + ks * 4096 + half * 2048; }
template <int OFF> __device__ __forceinline__ s16x4 tr_read(int vb) {
  s16x4 r; asm volatile("ds_read_b64_tr_b16 %0, %1 offset:%2" : "=&v"(r) : "v"(vb), "i"(OFF) : "memory"); return r;
}
template <int D0> __device__ __forceinline__ void pv_one(f32x16& od, int vb, bf16x8 pa0, bf16x8 pa1, bf16x8 pa2, bf16x8 pa3) {
  const s16x4 l0 = tr_read<v_rd_off(D0, 0, 0)>(vb), h0 = tr_read<v_rd_off(D0, 0, 1)>(vb), l1 = tr_read<v_rd_off(D0, 1, 0)>(vb), h1 = tr_read<v_rd_off(D0, 1, 1)>(vb);
  const s16x4 l2 = tr_read<v_rd_off(D0, 2, 0)>(vb), h2 = tr_read<v_rd_off(D0, 2, 1)>(vb), l3 = tr_read<v_rd_off(D0, 3, 0)>(vb), h3 = tr_read<v_rd_off(D0, 3, 1)>(vb);
  asm volatile("s_waitcnt lgkmcnt(0)" ::: "memory"); DA_SBAR();
#define DA_PK(L, H) (bf16x8){L[0], L[1], L[2], L[3], H[0], H[1], H[2], H[3]}
  od = __builtin_amdgcn_mfma_f32_32x32x16_bf16(pa0, DA_PK(l0, h0), od, 0, 0, 0);
  od = __builtin_amdgcn_mfma_f32_32x32x16_bf16(pa1, DA_PK(l1, h1), od, 0, 0, 0);
  od = __builtin_amdgcn_mfma_f32_32x32x16_bf16(pa2, DA_PK(l2, h2), od, 0, 0, 0);
  od = __builtin_amdgcn_mfma_f32_32x32x16_bf16(pa3, DA_PK(l3, h3), od, 0, 0, 0);
#undef DA_PK
}
__device__ __forceinline__ void pv_d0(f32x16 (&o)[4], int vb, bf16x8 pa0, bf16x8 pa1, bf16x8 pa2, bf16x8 pa3) {
  pv_one<0>(o[0], vb, pa0, pa1, pa2, pa3); pv_one<1>(o[1], vb, pa0, pa1, pa2, pa3); pv_one<2>(o[2], vb, pa0, pa1, pa2, pa3); pv_one<3>(o[3], vb, pa0, pa1, pa2, pa3);
}

__device__ __forceinline__ void unit(const bf16* __restrict__ P, bf16* __restrict__ MIX, int qrow0, int hh, int lat_row0, int n_lat_tiles, int ctx_row0,
                                     float lam, float post, const float* __restrict__ sub_g, LAS char* lds, int tid) {
  const int wid = __builtin_amdgcn_readfirstlane(tid >> 6), lane = tid & 63, r32 = lane & 31, hi = lane >> 5, mp = wid >> 2, wq = wid & 3;
  LAS char* V_lds = lds; LAS char* K_lds = lds + 2 * SHM_V;
  LAS float* wsl = (LAS float*)(lds + LDS_WS) + wid * 64; LAS float* li_l = wsl; LAS float* al_l = wsl + 32;
  float m_reg = -1e30f, l_reg = 0; f32x16 o[4] = {}; bf16x8 qr[4];
  { const bf16* Qw = P + (size_t)(qrow0 + wq * 32 + r32) * INW + hh * 128 + mp * 64 + hi * 8;
#pragma unroll
    for (int d0 = 0; d0 < 4; ++d0) qr[d0] = *reinterpret_cast<const bf16x8*>(Qw + d0 * 16); }
  const int mapcolB = mp * 128;
  const int sr = tid >> 4, sc = (tid & 15) * 8, vst0 = v_st(sr, sc), vst1 = v_st(32 + sr, sc);
  const int vb0 = (int)(uintptr_t)V_lds + v_rd_base(lane);
  const bf16* Kc = P + 1536 + hh * 128 + sc; const bf16* Vc = P + 3072 + hh * 128 + sc;
  const int NT = n_lat_tiles + 4;
  struct { bf16x8 vs0, vs1, ks0, ks1; } st_[2];
#define DA_TROW(j) ((j) < n_lat_tiles ? lat_row0 + (j) * KVBLK : ctx_row0 + ((j) - n_lat_tiles) * KVBLK)
#define DA_SLOAD(i, j) do { const size_t _r0 = (size_t)(DA_TROW(j) + sr) * INW, _r1 = _r0 + (size_t)32 * INW; \
    st_[i].vs0 = *reinterpret_cast<const bf16x8*>(Vc + _r0); st_[i].vs1 = *reinterpret_cast<const bf16x8*>(Vc + _r1); \
    st_[i].ks0 = *reinterpret_cast<const bf16x8*>(Kc + _r0); st_[i].ks1 = *reinterpret_cast<const bf16x8*>(Kc + _r1); } while (0)
#define DA_SWRITE(b, i) do { *(LAS bf16x8*)(V_lds + (b) * SHM_V + vst0) = st_[i].vs0; *(LAS bf16x8*)(V_lds + (b) * SHM_V + vst1) = st_[i].vs1; const int kc = sc * 2; \
    *(LAS bf16x8*)(K_lds + (b) * SHM_K + DA_KSWZ(sr, kc)) = st_[i].ks0; *(LAS bf16x8*)(K_lds + (b) * SHM_K + DA_KSWZ(32 + sr, kc)) = st_[i].ks1; } while (0)
#define DA_SWAIT() asm volatile("s_waitcnt vmcnt(4)" ::: "memory")
#define DA_RESC(a) do { if (__any((a) < 1.f)) { if (hi == 0) al_l[r32] = (a); asm volatile("s_waitcnt lgkmcnt(0)" ::: "memory"); \
    _Pragma("unroll") for (int d = 0; d < 4; ++d) _Pragma("unroll") for (int r = 0; r < 16; ++r) o[d][r] *= al_l[crow(r, hi)]; } } while (0)
  f32x16 pA0, pA1, pB0, pB1; float mnA, mnB, alA, alB; bf16x8 pa0, pa1, pa2, pa3;
  constexpr int SE = 0, SO = 1;
  DA_SLOAD(SE, 0); asm volatile("s_waitcnt vmcnt(0)" ::: "memory"); DA_SWRITE(0, SE); __syncthreads();
  qkt(pA0, pA1, K_lds, qr, r32, hi, mapcolB); partialSM(pA0, pA1, m_reg, mnA, alA);
  DA_SLOAD(SO, 1); if (2 < NT) DA_SLOAD(SE, 2);
  DA_SWAIT(); DA_SWRITE(1, SO); __syncthreads();
  for (int j = 1; j + 1 < NT; j += 2) {
    DA_SBAR(); qkt(pB0, pB1, K_lds + SHM_K, qr, r32, hi, mapcolB);
    finishSM(pA0, pA1, alA, l_reg, pa0, pa1, pa2, pa3); DA_SBAR();
    DA_SLOAD(SO, j + 2); DA_SBAR();
    pv_d0(o, vb0, pa0, pa1, pa2, pa3); partialSM(pB0, pB1, m_reg, mnB, alB);
    __syncthreads(); DA_SWAIT(); DA_SWRITE(0, SE);
    DA_RESC(alB); __syncthreads();
    DA_SBAR(); qkt(pA0, pA1, K_lds, qr, r32, hi, mapcolB);
    finishSM(pB0, pB1, alB, l_reg, pa0, pa1, pa2, pa3); DA_SBAR();
    if (j + 3 < NT) DA_SLOAD(SE, j + 3); DA_SBAR();
    pv_d0(o, vb0 + SHM_V, pa0, pa1, pa2, pa3); partialSM(pA0, pA1, m_reg, mnA, alA);
    __syncthreads(); DA_SWAIT(); DA_SWRITE(1, SO);
    DA_RESC(alA); __syncthreads();
  }
  DA_SBAR(); qkt(pB0, pB1, K_lds + SHM_K, qr, r32, hi, mapcolB);
  finishSM(pA0, pA1, alA, l_reg, pa0, pa1, pa2, pa3); DA_SBAR();
  pv_d0(o, vb0, pa0, pa1, pa2, pa3); partialSM(pB0, pB1, m_reg, mnB, alB);
  __syncthreads(); DA_RESC(alB);
  finishSM(pB0, pB1, alB, l_reg, pa0, pa1, pa2, pa3); DA_SBAR();
  pv_d0(o, vb0 + SHM_V, pa0, pa1, pa2, pa3);
  if (hi == 0) li_l[r32] = l_reg; asm volatile("s_waitcnt lgkmcnt(0)" ::: "memory");
  float rli[16];
#pragma unroll
  for (int r = 0; r < 16; ++r) rli[r] = 1.0f / li_l[crow(r, hi)];
  __syncthreads();
  LAS float* X2 = (LAS float*)(lds + LDS_X2);
  if (mp == 1) {
#pragma unroll
    for (int r = 0; r < 16; ++r) { const int row = wq * 32 + crow(r, hi);
#pragma unroll
      for (int d0 = 0; d0 < 4; ++d0) X2[row * 128 + d0 * 32 + r32] = lam * o[d0][r] * rli[r]; }
  }
  __syncthreads();
  if (mp == 0) {
    float ss[16];
#pragma unroll
    for (int r = 0; r < 16; ++r) { const int row = wq * 32 + crow(r, hi); float s = 0.f;
#pragma unroll
      for (int d0 = 0; d0 < 4; ++d0) { const float v = o[d0][r] * rli[r] - X2[row * 128 + d0 * 32 + r32]; o[d0][r] = v; s += v * v; }
      ss[r] = s; }
#pragma unroll
    for (int r = 0; r < 16; ++r) { float s = ss[r];
      s += __shfl_xor(s, 1); s += __shfl_xor(s, 2); s += __shfl_xor(s, 4); s += __shfl_xor(s, 8); s += __shfl_xor(s, 16);
      ss[r] = post / sqrtf(s * (1.0f / 128.0f) + 1e-6f); }
    float gsub[4];
#pragma unroll
    for (int d0 = 0; d0 < 4; ++d0) gsub[d0] = sub_g[d0 * 32 + r32];
#pragma unroll
    for (int r = 0; r < 16; ++r) { bf16* op = MIX + (size_t)(qrow0 + wq * 32 + crow(r, hi)) * DM + hh * 128 + r32;
#pragma unroll
      for (int d0 = 0; d0 < 4; ++d0) op[d0 * 32] = (bf16)f2bf(o[d0][r] * ss[r] * gsub[d0]); }
  }
  __syncthreads();
#undef DA_TROW
#undef DA_SLOAD
#undef DA_SWRITE
#undef DA_SWAIT
#undef DA_RESC
}
}

namespace na {
using da::bf16x8; using da::s16x4; using da::f32x16; using da::u32x4; using da::crow; using da::SHM_V; using da::SHM_K; using da::LDS_WS;
constexpr float QSCALE = 0.08838834764831845f, LOG2E = 1.4426950408889634f, THR2 = 8.f * LOG2E, NEG = -1e30f;
constexpr int LDS_TAB = LDS_WS + 8 * 64 * 4 + 512;
__device__ __forceinline__ void qkt(f32x16& p0, f32x16& p1, const LAS char* Ks, const bf16x8 (&qr)[8], int r32, int hi) {
  p0 = f32x16{}; p1 = f32x16{};
#pragma unroll
  for (int d0 = 0; d0 < 8; ++d0) { const int cb = (d0 * 16 + hi * 8) * 2;
    const bf16x8 b0 = *reinterpret_cast<const LAS bf16x8*>(Ks + DA_KSWZ(r32, cb));
    const bf16x8 b1 = *reinterpret_cast<const LAS bf16x8*>(Ks + DA_KSWZ(32 + r32, cb));
    p0 = __builtin_amdgcn_mfma_f32_32x32x16_bf16(b0, qr[d0], p0, 0, 0, 0);
    p1 = __builtin_amdgcn_mfma_f32_32x32x16_bf16(b1, qr[d0], p1, 0, 0, 0); }
}
__device__ __forceinline__ void bias_mask(f32x16& p0, f32x16& p1, int mode, const LAS float* lanetab, int kb) {
  constexpr float C = QSCALE * LOG2E;
  if (mode == 0) {
#pragma unroll
    for (int r = 0; r < 16; ++r) { p0[r] *= C; p1[r] *= C; }
  } else if (mode == 2) {
#pragma unroll
    for (int r = 0; r < 16; ++r) { p0[r] = NEG; p1[r] = NEG; }
  } else {
#pragma unroll
    for (int r = 0; r < 16; ++r) { const int c = (r & 3) + 8 * (r >> 2);
      const float b0 = lanetab[c], b1 = lanetab[c + 32];
      p0[r] = ((unsigned)(kb + c) < 16u) ? fmaf(p0[r], C, b0) : NEG;
      p1[r] = ((unsigned)(kb + c + 32) < 16u) ? fmaf(p1[r], C, b1) : NEG; }
  }
}
__device__ __forceinline__ void partialSM(f32x16& p0, f32x16& p1, float& m_reg, float& mn, float& alpha) {
  float pmax = p0[0];
#pragma unroll
  for (int r = 1; r < 16; ++r) pmax = fmaxf(pmax, p0[r]);
#pragma unroll
  for (int r = 0; r < 16; ++r) pmax = fmaxf(pmax, p1[r]);
  { auto rr = __builtin_amdgcn_permlane32_swap(__float_as_uint(pmax), __float_as_uint(pmax), false, false);
    pmax = fmaxf(__uint_as_float(rr[0]), __uint_as_float(rr[1])); }
  if (__builtin_expect(__all(pmax - m_reg <= THR2), 1)) { mn = m_reg; alpha = 1.f; }
  else { mn = fmaxf(m_reg, pmax); alpha = __builtin_amdgcn_exp2f(m_reg - mn); m_reg = mn; }
#pragma unroll
  for (int r = 0; r < 16; ++r) p0[r] = __builtin_amdgcn_exp2f(p0[r] - mn);
#pragma unroll
  for (int r = 0; r < 16; ++r) p1[r] = p1[r] - mn;
}

__device__ __forceinline__ void unit(const bf16* __restrict__ P, bf16* __restrict__ MIX, int qrow0, int hh, bool lat, int b, int r0, const float* __restrict__ rpb_h, LAS char* lds, int tid) {
  const int wid = __builtin_amdgcn_readfirstlane(tid >> 6), lane = tid & 63, r32 = lane & 31, hi = lane >> 5;
  LAS char* V_lds = lds; LAS char* K_lds = lds + 2 * SHM_V;
  LAS float* wsl = (LAS float*)(lds + LDS_WS) + wid * 64; LAS float* li_l = wsl; LAS float* al_l = wsl + 32;
  LAS float* tab = (LAS float*)(lds + LDS_TAB);
  if (lat) for (int i = tid; i < 15 * 31; i += 512) tab[i] = rpb_h[i] * LOG2E;
  float m_reg = -1e28f, l_reg = 0; f32x16 o[4] = {}; bf16x8 qr[8];
  { const bf16* Qw = P + (size_t)(qrow0 + wid * 32 + r32) * INW + 2048 + hh * 128 + hi * 8;
#pragma unroll
    for (int d0 = 0; d0 < 8; ++d0) qr[d0] = *reinterpret_cast<const bf16x8*>(Qw + d0 * 16); }
  const int qgr = r0 + (wid >> 1), rs = min(max(qgr - 4, 0), 56), rbase = min(max(r0 - 4, 0), 52);
  const int qc = 32 * (wid & 1) + r32, cs = min(max(qc - 8, 0), 48), lt0 = 4 * hi - qc + 15, kb0 = 4 * hi - cs;
  const int sr = tid >> 4, sc = (tid & 15) * 8, vst0 = da::v_st(sr, sc), vst1 = da::v_st(32 + sr, sc);
  const int vb0 = (int)(uintptr_t)V_lds + da::v_rd_base(lane);
  const bf16* Kc = P + 3072 + hh * 128 + sc; const bf16* Vc = P + 4096 + hh * 128 + sc;
  const int NLT = lat ? 12 : 0, NT = NLT + 4;
  const int lat_row0 = b * SEQ + rbase * 64, ctx_row0 = MLAT + b * NCTX;
  struct { bf16x8 vs0, vs1, ks0, ks1; } st_;
#define NA_TROW(j) ((j) < NLT ? lat_row0 + (j) * 64 : ctx_row0 + ((j) - NLT) * 64)
#define NA_SLOAD(j) do { const size_t _r0 = (size_t)(NA_TROW(j) + sr) * INW, _r1 = _r0 + (size_t)32 * INW; \
    st_.vs0 = *reinterpret_cast<const bf16x8*>(Vc + _r0); st_.vs1 = *reinterpret_cast<const bf16x8*>(Vc + _r1); \
    st_.ks0 = *reinterpret_cast<const bf16x8*>(Kc + _r0); st_.ks1 = *reinterpret_cast<const bf16x8*>(Kc + _r1); } while (0)
#define NA_SWRITE(bb) do { *(LAS bf16x8*)(V_lds + (bb) * SHM_V + vst0) = st_.vs0; *(LAS bf16x8*)(V_lds + (bb) * SHM_V + vst1) = st_.vs1; const int kc = sc * 2; \
    *(LAS bf16x8*)(K_lds + (bb) * SHM_K + DA_KSWZ(sr, kc)) = st_.ks0; *(LAS bf16x8*)(K_lds + (bb) * SHM_K + DA_KSWZ(32 + sr, kc)) = st_.ks1; } while (0)
#define NA_RESC(a) do { if (__any((a) < 1.f)) { if (hi == 0) al_l[r32] = (a); asm volatile("s_waitcnt lgkmcnt(0)" ::: "memory"); \
    _Pragma("unroll") for (int d = 0; d < 4; ++d) _Pragma("unroll") for (int r = 0; r < 16; ++r) o[d][r] *= al_l[crow(r, hi)]; } } while (0)
#define NA_BM(p0, p1, j) do { const int _kr = rbase + (j); const int _mode = (j) >= NLT ? 0 : ((_kr >= rs && _kr < rs + 8) ? 1 : 2); \
    int _lt = min(max(_kr - qgr + 7, 0), 14) * 31 + lt0, _kb = kb0; asm volatile("" : "+v"(_lt), "+v"(_kb)); \
    bias_mask(p0, p1, _mode, tab + _lt, _kb); } while (0)
  f32x16 p0, p1; float mn, al; bf16x8 pa0, pa1, pa2, pa3;
  NA_SLOAD(0); asm volatile("s_waitcnt vmcnt(0)" ::: "memory"); NA_SWRITE(0); __syncthreads();
  NA_SLOAD(1);
  for (int j = 0; j < NT; ++j) {
    const int bb = j & 1;
    DA_SBAR(); qkt(p0, p1, K_lds + bb * SHM_K, qr, r32, hi); NA_BM(p0, p1, j); partialSM(p0, p1, m_reg, mn, al);
    NA_RESC(al);
    da::finishSM(p0, p1, al, l_reg, pa0, pa1, pa2, pa3); DA_SBAR();
    if (j + 1 < NT) { asm volatile("s_waitcnt vmcnt(0)" ::: "memory"); NA_SWRITE(bb ^ 1); }
    if (j + 2 < NT) NA_SLOAD(j + 2);
    DA_SBAR();
    da::pv_d0(o, vb0 + bb * SHM_V, pa0, pa1, pa2, pa3);
    __syncthreads();
  }
  if (hi == 0) li_l[r32] = l_reg; asm volatile("s_waitcnt lgkmcnt(0)" ::: "memory");
  float rli[16];
#pragma unroll
  for (int r = 0; r < 16; ++r) rli[r] = 1.0f / li_l[crow(r, hi)];
#pragma unroll
  for (int r = 0; r < 16; ++r) { bf16* op = MIX + (size_t)(qrow0 + wid * 32 + crow(r, hi)) * DM + 1024 + hh * 128 + r32;
#pragma unroll
    for (int d0 = 0; d0 < 4; ++d0) op[d0 * 32] = (bf16)f2bf(o[d0][r] * rli[r]); }
  __syncthreads();
#undef NA_TROW
#undef NA_SLOAD
#undef NA_SWRITE
#undef NA_RESC
#undef NA_BM
}
}

constexpr int NPH = 39;
struct Args { const float* in[22]; float* out; unsigned char* ws; int ph_lo, ph_hi; };
__global__ void __launch_bounds__(NWAVES * 64, 2) fwd(Args args) {
    extern __shared__ __attribute__((aligned(16))) unsigned char lds_raw[];
    LAS unsigned char* lds = (LAS unsigned char*)lds_raw;
    volatile LAS unsigned* MISC = (volatile LAS unsigned*)(lds + MISC_OFF);
    const int G = gridDim.x;
    typedef const __attribute__((address_space(4))) Args* KArgs;
    const KArgs ka0 = (KArgs)__builtin_amdgcn_kernarg_segment_ptr();
#define KA() ({ KArgs _p = ka0; asm volatile("" : "+s"(_p)); _p; })
#define ARG(i) (KA()->in[i])
#define WSP(T, off) ((T*)(KA()->ws + (off)))
#define THREAD_IDS() int tid = threadIdx.x; asm volatile("" : "+v"(tid)); int bx = blockIdx.x; asm volatile("" : "+s"(bx)); \
    const int lane = tid & 63, wave = __builtin_amdgcn_readfirstlane(tid >> 6); const int gw = bx * NWAVES + wave, NGW = G * NWAVES; const int gt = bx * (NWAVES * 64) + tid, NT = G * NWAVES * 64; \
    (void)lane; (void)wave; (void)gw; (void)NGW; (void)gt; (void)NT;
    {
    THREAD_IDS();
    for (int u = tid; u < (LDS_BYTES - LDSCTL_OFF) / 4; u += NWAVES * 64) ((LAS unsigned*)(lds + LDSCTL_OFF))[u] = 0u;
    __syncthreads();
    }
#if MK_ONE_LAUNCH
    XcdBarrier bar = xcd_barrier_post(WSP(unsigned, WS_CTL) + CW_BAR, MISC + 8);
#define GRID_BAR() xcd_barrier(bar)
#else
    (void)MISC;
#define GRID_BAR() do { } while (0)
#endif
    const int lo = args.ph_lo, hi = args.ph_hi;
#define IN(k) (lo <= (k) && (k) < hi)
#define SEAM(k) do { if (IN(k) && IN((k) + 1)) GRID_BAR(); } while (0)

    if (IN(0)) {
        THREAD_IDS();
        const float* x_in = ARG(0); const float* c_in = ARG(1); const float* ctx_in = ARG(2); const float* cctx_in = ARG(3); const float* ada_w = ARG(4);
        const float* w_in = ARG(8); const float* w_out = ARG(9); const float* mlp_w1 = ARG(19); const float* mlp_w2 = ARG(20);
        const float* lq1 = ARG(14); const float* lk1 = ARG(15); const float* lq2 = ARG(16); const float* lk2 = ARG(17);
        float* ADAP = WSP(float, WS_ADAP); float* LAM = WSP(float, WS_LAM); float* X = WSP(float, WS_X);
        bf16* WIN_T = WSP(bf16, WS_WIN); bf16* WOUT_T = WSP(bf16, WS_WOUT); bf16* W1_T = WSP(bf16, WS_W1); bf16* W2_T = WSP(bf16, WS_W2);
        LAS float* s_lds = (LAS float*)(lds + RING_OFF);
        for (int it = bx; it < DEPTH * 8 * 24; it += G) {
            const int l = it / 192, rem = it % 192, kc = rem / 24, cb = rem % 24;
            __syncthreads();
            for (int i = tid; i < 5 * 256; i += NWAVES * 64) { const int r = i >> 8, k = i & 255; const float cv = r < 4 ? c_in[r * DM + kc * 256 + k] : cctx_in[kc * 256 + k]; s_lds[i] = cv / (1.0f + expf(-cv)); }
            __syncthreads();
            const int col = cb * 512 + tid; float a0 = 0.f, a1 = 0.f, a2 = 0.f, a3 = 0.f, a4 = 0.f;
            const float* wp = ada_w + ((size_t)l * DM + kc * 256) * ADA + col;
#pragma unroll 8
            for (int k = 0; k < 256; ++k) { const float w = wp[(size_t)k * ADA]; a0 += s_lds[k] * w; a1 += s_lds[256 + k] * w; a2 += s_lds[512 + k] * w; a3 += s_lds[768 + k] * w; a4 += s_lds[1024 + k] * w; }
            float* pp = ADAP + ((size_t)(l * 8 + kc) * 5) * ADA + col;
            pp[0] = a0; pp[ADA] = a1; pp[2 * ADA] = a2; pp[3 * ADA] = a3; pp[4 * ADA] = a4;
        }
        __syncthreads();
        LAS float* scr = (LAS float*)(lds + RING_OFF + wave * 16384);
        constexpr int I_IN = (DM / 64) * (INW / 32), I_OUT = (DM / 64) * (DM / 32), I_1 = (DM / 64) * (DFF / 32), I_2 = (DFF / 64) * (DM / 32), I_L = I_IN + I_OUT + I_1 + I_2;
        for (int it = gw; it < DEPTH * I_L; it += NGW) {
            const int l = it / I_L; int r = it % I_L;
            if (r < I_IN) { p0_transpose_item(w_in + (size_t)l * DM * INW, DM, INW, WIN_T + (size_t)l * INW * DM, scr, r, lane); continue; } r -= I_IN;
            if (r < I_OUT) { p0_transpose_item(w_out + (size_t)l * DM * DM, DM, DM, WOUT_T + (size_t)l * DM * DM, scr, r, lane); continue; } r -= I_OUT;
            if (r < I_1) { p0_transpose_item(mlp_w1 + (size_t)l * DM * DFF, DM, DFF, W1_T + (size_t)l * DFF * DM, scr, r, lane); continue; } r -= I_1;
            p0_transpose_item(mlp_w2 + (size_t)l * DFF * DM, DFF, DM, W2_T + (size_t)l * DM * DFF, scr, r, lane);
        }
        for (size_t i = gt; i < (size_t)MALL * DM / 4; i += NT) { const f32x4 v = i < (size_t)MLAT * DM / 4 ? ((const GAS f32x4*)x_in)[i] : ((const GAS f32x4*)ctx_in)[i - (size_t)MLAT * DM / 4]; ((GAS f32x4*)X)[i] = v; }
        { bf16* CS = WSP(bf16, WS_CS);
          for (int i = gt; i < 8192 * 4096 / 8; i += NT) { const int row = i >> 9, n0 = (i & 511) * 8, k = row & 4095; const bool sinrow = row >= 4096; unsigned w[4];
#pragma unroll
              for (int e = 0; e < 8; e += 2) { float s0, c0, s1, c1; sincospif((float)((k * (n0 + e)) & 4095) * (1.0f / 2048.0f), &s0, &c0); sincospif((float)((k * (n0 + e + 1)) & 4095) * (1.0f / 2048.0f), &s1, &c1);
                  w[e >> 1] = sinrow ? pk2(s0, s1) : pk2(c0, c1); }
              *(GAS v4u*)(CS + (size_t)i * 8) = (v4u){w[0], w[1], w[2], w[3]}; }
          bf16* CT = WSP(bf16, WS_CT);
          for (int i = gt; i < 256 * 256; i += NT) { const int j = i >> 8, cc = i & 255, c = cc & 127; float sn, cs; sincospif((float)((j * c) & 127) * (1.0f / 64.0f), &sn, &cs);
              CT[i] = j < 128 ? (bf16)f2bf(cc < 128 ? cs : -sn) : (bf16)0; } }
        if (bx == 0 && tid < 2) { float d1 = 0.f, d2 = 0.f; for (int j = 0; j < 64; ++j) { d1 += lq1[tid * 64 + j] * lk1[tid * 64 + j]; d2 += lq2[tid * 64 + j] * lk2[tid * 64 + j]; }
            LAM[tid] = expf(d1) - expf(d2) + (tid == 0 ? LAM_INIT1 : LAM_INIT3); }
    }
    SEAM(0);
    if (IN(1)) {
        THREAD_IDS();
        const float* ada_b = ARG(5); const float* ADAP = WSP(float, WS_ADAP); float* MOD = WSP(float, WS_MOD);
        for (int i = gt; i < DEPTH * 5 * ADA; i += NT) { const int l = i / (5 * ADA), rc = i % (5 * ADA), col = rc % ADA; float s = ada_b[l * ADA + col];
#pragma unroll
            for (int kc = 0; kc < 8; ++kc) s += ADAP[(size_t)(l * 8 + kc) * 5 * ADA + rc];
            MOD[i] = s; }
    }
    SEAM(1);

    for (int l = 0; l < DEPTH; ++l) {
        const int pb = 2 + 9 * l; const bool odd = (l & 1) != 0, need_ctx = l < DEPTH - 1; const int li = l >> 1;
        const int MR = need_ctx ? MALL : MLAT;
#define MODL() (WSP(float, WS_MOD) + (size_t)l * 5 * ADA)
        if (IN(pb + 0)) { THREAD_IDS(); norm_rows<0>(WSP(float, WS_X), WSP(bf16, WS_H), nullptr, ARG(6) + l * DM, MODL(), 0, MALL, gw, NGW, lane); }
        SEAM(pb + 0);
        if (IN(pb + 1)) {
            THREAD_IDS();
            pg8::Gemm g{WSP(bf16, WS_H), WSP(bf16, WS_WIN) + (size_t)l * INW * DM, MALL, INW, DM}; pg8::StaticOrder S; S.init(MALL, INW, G, bx);
            pg8::EpiBf16<0> E{WSP(bf16, WS_P), INW};
            pg8::gemm_phase<pg8::EpiBf16<0>, pg8::StaticOrder, true, true>(lds + RING_OFF, g, S, E, tid);
        }
        SEAM(pb + 1);
        if (IN(pb + 2)) {
            THREAD_IDS();
            bf16* P = WSP(bf16, WS_P); float* VN = WSP(float, WS_VN); const float* sgu_g = ARG(10);
            if (!odd) {
                const int g8 = lane >> 3, c0 = (lane & 7) * 16;
                for (int row = gw; row < MALL; row += NGW) {
                    const bf16* vp = P + (size_t)row * INW + 1024 + g8 * 128 + c0; float v[16];
                    load_q<16>(vp, 1.0f, v);
                    float s = 0.f;
#pragma unroll
                    for (int j = 0; j < 16; ++j) s += v[j];
                    s += __shfl_xor(s, 1); s += __shfl_xor(s, 2); s += __shfl_xor(s, 4);
                    const float mu = s * (1.0f / 128.0f); float q = 0.f;
#pragma unroll
                    for (int j = 0; j < 16; ++j) { v[j] -= mu; q += v[j] * v[j]; }
                    q += __shfl_xor(q, 1); q += __shfl_xor(q, 2); q += __shfl_xor(q, 4);
                    const float rstd = 1.0f / sqrtf(q * (1.0f / 128.0f) + 1e-5f);
                    const float* gp = sgu_g + li * 1024 + g8 * 128 + c0; float* op = VN + (size_t)row * 1024 + g8 * 128 + c0;
#pragma unroll
                    for (int j = 0; j < 16; j += 4) { f32x4 o; o.x = v[j] * rstd * gp[j]; o.y = v[j + 1] * rstd * gp[j + 1]; o.z = v[j + 2] * rstd * gp[j + 2]; o.w = v[j + 3] * rstd * gp[j + 3]; *(GAS f32x4*)(op + j) = o; }
                }
            } else {
                for (int idx = gt; idx < MLAT * 12 * 2 * 2 * 32; idx += NT) {
                    const int pi = idx & 31, mp = (idx >> 5) & 1, qk = (idx >> 6) & 1, rest = idx >> 7, hh = rest % 12, row = rest / 12;
                    const int axis = pi >> 4, i = pi & 15, n = row & (SEQ - 1); const float pos = (float)(axis == 0 ? (n >> 6) : (n & 63));
                    const float inv = exp2f(-(float)i * (13.287712379549449f / 16.0f)); const float ang = pos * inv; float sn, cs; sincosf(ang, &sn, &cs);
                    bf16* zp = P + (size_t)row * INW + qk * 1536 + hh * 128 + mp * 64 + axis * 32 + i;
                    const float z1 = bf2f(zp[0]), z2 = bf2f(zp[16]);
                    zp[0] = (bf16)f2bf(z1 * cs - z2 * sn); zp[16] = (bf16)f2bf(z2 * cs + z1 * sn);
                }
                { bf16* FT = WSP(bf16, WS_FT); LAS bf16* scr = (LAS bf16*)(lds + RING_OFF + wave * 16384);
                  for (int it = gw; it < NB * 64 * 8; it += NGW) { const int b = it >> 9, nb = (it >> 3) & 63, cb = it & 7;
#pragma unroll
                      for (int i = 0; i < 8; ++i) { const int r = 8 * i + (lane >> 3), ch = lane & 7; const v4u w = *(const GAS v4u*)(P + (size_t)(b * SEQ + nb * 64 + r) * INW + 4608 + cb * 64 + ch * 8);
                          LAS unsigned* d = (LAS unsigned*)(scr + r * 66 + ch * 8); d[0] = w.x; d[1] = w.y; d[2] = w.z; d[3] = w.w; }
                      LDS_WAIT(); asm volatile("" ::: "memory");
#pragma unroll
                      for (int i = 0; i < 8; ++i) { const int c = 8 * i + (lane >> 3), ch = lane & 7; unsigned short e[8];
#pragma unroll
                          for (int q = 0; q < 8; ++q) e[q] = scr[(ch * 8 + q) * 66 + c];
                          v4u w; w.x = e[0] | ((unsigned)e[1] << 16); w.y = e[2] | ((unsigned)e[3] << 16); w.z = e[4] | ((unsigned)e[5] << 16); w.w = e[6] | ((unsigned)e[7] << 16);
                          *(GAS v4u*)(FT + (size_t)(b * 512 + cb * 64 + c) * SEQ + nb * 64 + ch * 8) = w; }
                      LDS_WAIT(); asm volatile("" ::: "memory"); } }
            }
        }
        SEAM(pb + 2);
        if (IN(pb + 3)) {
            THREAD_IDS();
            const bf16* P = WSP(bf16, WS_P); bf16* MIX = WSP(bf16, WS_MIX); const float* VN = WSP(float, WS_VN);
            const float* sgu_w = ARG(11); const float* sgu_b = ARG(12); const float* na_rpb = ARG(13);
            if (!odd) {
                for (int idx = gt; idx < MR * 1024; idx += NT) {
                    const int row = idx >> 10, col = idx & 1023, g8 = col >> 7, p = row & 127, cb = row - p;
                    const float* wrow = sgu_w + ((size_t)(li * 8 + g8) * 128 + p) * 128; float acc = sgu_b[(li * 8 + g8) * 128 + p];
                    const float* vp = VN + (size_t)cb * 1024 + col;
#pragma unroll 8
                    for (int q = 0; q < 128; ++q) acc += wrow[q] * vp[(size_t)q * 1024];
                    MIX[(size_t)row * DM + col] = (bf16)f2bf(bf2f(P[(size_t)row * INW + col]) * acc);
                }
                __syncthreads();
                {
                    const int vcu = (G % 8 == 0) ? (bx % 8) * (G / 8) + bx / 8 : bx;
                    const int NU = NB * 8 * 16 + (need_ctx ? NB * 8 : 0);
                    for (int u = vcu; u < NU; u += G) {
                        const bool lat = u < NB * 8 * 16; int b, hh, r0, qrow0;
                        if (lat) { b = u >> 7; hh = (u >> 4) & 7; r0 = (u & 15) * 4; qrow0 = b * SEQ + r0 * 64; }
                        else { const int v = u - NB * 8 * 16; b = v >> 3; hh = v & 7; r0 = 0; qrow0 = MLAT + b * NCTX; }
                        na::unit(P, MIX, qrow0, hh, lat, b, r0, na_rpb + (size_t)(li * 8 + hh) * 465, (LAS char*)(lds + RING_OFF), tid);
                    }
                }
            } else {
                {
                    const int vcu = (G % 8 == 0) ? (bx % 8) * (G / 8) + bx / 8 : bx;
                    const float lam = WSP(float, WS_LAM)[li], post = 1.0f - (li == 0 ? LAM_INIT1 : LAM_INIT3); const float* sub_g = ARG(18) + li * 128;
                    const int NU = NB * 12 * 32 + (need_ctx ? NB * 12 * 2 : 0);
                    for (int u = vcu; u < NU; u += G) {
                        int bh, qrow0, nlt;
                        if (u < NB * 12 * 32) { bh = u >> 5; qrow0 = (bh / 12) * SEQ + (u & 31) * 128; nlt = SEQ / 64; }
                        else { const int v = u - NB * 12 * 32; bh = v >> 1; qrow0 = MLAT + (bh / 12) * NCTX + (v & 1) * 128; nlt = 0; }
                        const int b = bh / 12, hh = bh % 12;
                        da::unit(P, MIX, qrow0, hh, b * SEQ, nlt, MLAT + b * NCTX, lam, post, sub_g, (LAS char*)(lds + RING_OFF), tid);
                    }
                    __syncthreads();
                }
                {
                    pg8::Gemm g{WSP(bf16, WS_CS), WSP(bf16, WS_FT), 8192, 2048, SEQ}; pg8::StaticOrder S; S.init(8192, 2048, G, bx);
                    pg8::EpiUV E{WSP(bf16, WS_UV)};
                    pg8::gemm_phase<pg8::EpiUV, pg8::StaticOrder, true, true>(lds + RING_OFF, g, S, E, tid);
                }
                if (need_ctx) {
                    __syncthreads();
                    LAS f32x2* tw = (LAS f32x2*)(lds + RING_OFF);
                    if (tid < 128) { float sn, cs; sincospif(2.0f * (float)tid / 128.0f, &sn, &cs); tw[tid] = (f32x2){cs, sn}; }
                    __syncthreads();
                    float* FA = WSP(float, WS_FA); float* FB = WSP(float, WS_FB);
                    for (int idx = gt; idx < MCTX * 512; idx += NT) {
                        const int row = MLAT + (idx >> 9), gj = idx & 511, g4 = gj >> 7, j = gj & 127; const bf16* xp = P + (size_t)row * INW + 4608 + g4 * 128; float fa = 0.f, fb = 0.f;
                        for (int c8 = 0; c8 < 16; ++c8) { const v4u w = ((const GAS v4u*)xp)[c8]; const float xv[8] = {bflo(w.x), bfhi(w.x), bflo(w.y), bfhi(w.y), bflo(w.z), bfhi(w.z), bflo(w.w), bfhi(w.w)};
#pragma unroll
                            for (int e = 0; e < 8; ++e) { const f32x2 t = tw[(j * (c8 * 8 + e)) & 127]; fa += xv[e] * t.x; fb += xv[e] * t.y; } }
                        FA[idx] = fa; FB[idx] = fb;
                    }
                    __syncthreads();
                }
            }
        }
        SEAM(pb + 3);
        if (IN(pb + 4) && odd) {
            THREAD_IDS();
            {
                pg8::Gemm g{WSP(bf16, WS_UV), WSP(bf16, WS_CT), SEQ * 16, 256, 256}; pg8::StaticOrder S; S.init(SEQ * 16, 256, G, bx);
                pg8::EpiChan E{WSP(bf16, WS_MIX), 0.0013810679320049757f};
                pg8::gemm_phase<pg8::EpiChan, pg8::StaticOrder, true, true>(lds + RING_OFF, g, S, E, tid);
            }
            if (need_ctx) {
                __syncthreads();
                LAS f32x2* tw = (LAS f32x2*)(lds + RING_OFF); bf16* MIX = WSP(bf16, WS_MIX); const float* FA = WSP(float, WS_FA); const float* FB = WSP(float, WS_FB);
                if (tid < NCTX) { float sn, cs; sincospif(2.0f * (float)tid / (float)NCTX, &sn, &cs); tw[tid] = (f32x2){cs, sn}; }
                __syncthreads();
                for (int idx = gt; idx < NB * NCTX * 512; idx += NT) {
                    const int gj = idx & 511, k = (idx >> 9) & (NCTX - 1), b = idx >> 17; float acc = 0.f;
                    const float* fa = FA + ((size_t)b * NCTX) * 512 + gj; const float* fb = FB + ((size_t)b * NCTX) * 512 + gj;
                    for (int n = 0; n < NCTX; ++n) { const f32x2 t = tw[(k * n) & (NCTX - 1)]; acc += fa[(size_t)n * 512] * t.x - fb[(size_t)n * 512] * t.y; }
                    MIX[((size_t)MLAT + b * NCTX + k) * DM + 1536 + gj] = (bf16)f2bf(acc * 0.005524271728019903f);
                }
                __syncthreads();
            }
        }
        if (odd) SEAM(pb + 4);
        if (IN(pb + 5)) {
            THREAD_IDS();
            pg8::Gemm g{WSP(bf16, WS_MIX), WSP(bf16, WS_WOUT) + (size_t)l * DM * DM, MR, DM, DM}; pg8::StaticOrder S; S.init(MR, DM, G, bx);
            pg8::EpiResid E{WSP(float, WS_X), DM, MODL() + 2 * DM, ADA};
            pg8::gemm_phase<pg8::EpiResid, pg8::StaticOrder, true, true>(lds + RING_OFF, g, S, E, tid);
        }
        SEAM(pb + 5);
        if (IN(pb + 6)) { THREAD_IDS(); norm_rows<0>(WSP(float, WS_X), WSP(bf16, WS_H), nullptr, ARG(7) + l * DM, MODL(), 3, MR, gw, NGW, lane); }
        SEAM(pb + 6);
        if (IN(pb + 7)) {
            THREAD_IDS();
            pg8::Gemm g{WSP(bf16, WS_H), WSP(bf16, WS_W1) + (size_t)l * DFF * DM, MR, DFF, DM}; pg8::StaticOrder S; S.init(MR, DFF, G, bx);
            pg8::EpiBf16<1> E{WSP(bf16, WS_HID), DFF};
            pg8::gemm_phase<pg8::EpiBf16<1>, pg8::StaticOrder, true, true>(lds + RING_OFF, g, S, E, tid);
        }
        SEAM(pb + 7);
        if (IN(pb + 8)) {
            THREAD_IDS();
            pg8::Gemm g{WSP(bf16, WS_HID), WSP(bf16, WS_W2) + (size_t)l * DM * DFF, MR, DM, DFF}; pg8::StaticOrder S; S.init(MR, DM, G, bx);
            pg8::EpiResid E{WSP(float, WS_X), DM, MODL() + 5 * DM, ADA};
            pg8::gemm_phase<pg8::EpiResid, pg8::StaticOrder, true, true>(lds + RING_OFF, g, S, E, tid);
        }
        SEAM(pb + 8);
    }
    if (IN(NPH - 1)) { THREAD_IDS(); norm_rows<1>(WSP(float, WS_X), nullptr, KA()->out, ARG(21), nullptr, 0, MLAT, gw, NGW, lane); }
#undef IN
#undef SEAM
#undef GRID_BAR
}

extern "C" void kernel_launch(void* const* d_in, const int* in_sizes, int n_in, void* d_out, int out_size, void* d_ws, size_t ws_size, hipStream_t stream) {
    static int grid = 0;
    if (grid == 0) {
        if (n_in != 22 || in_sizes[0] != MLAT * DM || out_size != MLAT * DM || ws_size < WS_END) { fprintf(stderr, "kernel_launch: unexpected shapes (n_in %d, in0 %d, out %d, ws %zu); nothing launched\n", n_in, n_in > 0 ? in_sizes[0] : -1, out_size, ws_size); grid = -1; return; }
        int dev = 0, cus = 0, per_cu = 0;
        if (hipGetDevice(&dev) != hipSuccess || hipDeviceGetAttribute(&cus, hipDeviceAttributeMultiprocessorCount, dev) != hipSuccess) { grid = -1; return; }
        if (hipFuncSetAttribute((const void*)fwd, hipFuncAttributeMaxDynamicSharedMemorySize, LDS_BYTES) != hipSuccess) { fprintf(stderr, "kernel_launch: hipFuncSetAttribute failed\n"); grid = -1; return; }
        if (hipOccupancyMaxActiveBlocksPerMultiprocessor(&per_cu, (const void*)fwd, NWAVES * 64, LDS_BYTES) != hipSuccess || per_cu < 1) fprintf(stderr, "kernel_launch: occupancy query reports %d workgroups per CU\n", per_cu);
        (void)hipGetLastError();
        grid = cus;
    }
    if (grid < 0) return;
    if (hipMemsetAsync((char*)d_ws + WS_CTL, 0, CTL_ZERO_BYTES, stream) != hipSuccess) return;
    Args a{};
    for (int i = 0; i < 22; ++i) a.in[i] = (const float*)d_in[i];
    a.out = (float*)d_out; a.ws = (unsigned char*)d_ws;
#if MK_ONE_LAUNCH
    a.ph_lo = 0; a.ph_hi = NPH;
    hipLaunchKernelGGL(fwd, dim3(grid), dim3(NWAVES * 64), LDS_BYTES, stream, a);
#else
    for (int ph = 0; ph < NPH; ++ph) {
        if (ph >= 2 && ph < NPH - 1) { const int l = (ph - 2) / 9, k = (ph - 2) % 9; if (k == 4 && !(l & 1)) continue; }
        a.ph_lo = ph; a.ph_hi = ph + 1;
        hipLaunchKernelGGL(fwd, dim3(grid), dim3(NWAVES * 64), LDS_BYTES, stream, a);
    }
#endif
    const hipError_t le = hipPeekAtLastError();
    if (le != hipSuccess) fprintf(stderr, "kernel_launch: launch failed: %s\n", hipGetErrorName(le));
}
```

```cpp
#include <hip/hip_runtime.h>
#include <cstdio>
#include <cstdint>
namespace pg8 {
#define PG8_LAS __attribute__((address_space(3)))
typedef unsigned short bf16_t;
typedef short bf16x8 __attribute__((ext_vector_type(8)));
typedef float f32x4 __attribute__((ext_vector_type(4)));
typedef unsigned u32x4 __attribute__((ext_vector_type(4)));
constexpr int BM = 256, BK = 64, HALF = 128, HTB = HALF * BK * 2  , STAGE_BYTES = 8 * HTB, NXCD = 8, WGM = 8;

__host__ __device__ __forceinline__ int lds_byte(int r, int c) { const int st = (r >> 4) * 2 + (c >> 5), rr = r & 15, cc = c & 31, ob = rr * 64 + cc * 2; return st * 1024 + (ob ^ (((ob >> 9) & 1) << 5)); }
__host__ __device__ __forceinline__ void stage_rc(int b, int& R, int& C) { const int st = b / 1024, sb = b % 1024, swz = sb ^ (((sb >> 9) & 1) << 5); R = (st >> 1) * 16 + swz / 64; C = (st & 1) * 32 + (swz % 64) / 2; }
__host__ __device__ __forceinline__ int perm32(int rho) { const int n = rho >> 4, i = rho & 15; return 8 * (i >> 2) + 4 * n + (i & 3); }

struct Unit { int pm, pn; };
struct Gemm { const bf16_t* A; const bf16_t* Bt; int M, N, K; };

struct StaticOrder {
    int nM, nN, nwg, G, c;
    __host__ __device__ void init(int M, int N, int G_, int c_) { nM = M / BM; nN = N / BM; nwg = nM * nN; G = G_; c = c_; }
    __host__ __device__ bool next(int i, Unit& u) const {
        const long L = (long)i * G + c; if (L >= nwg) return false;
        int wgid = (int)L; { const int q = nwg / NXCD, r = nwg % NXCD, xcd = wgid % NXCD, off = wgid / NXCD; wgid = (xcd < r ? xcd * (q + 1) : r * (q + 1) + (xcd - r) * q) + off; }
        const int nig = WGM * nN, gid = wgid / nig, fm = gid * WGM, gsz = (nM - fm) < WGM ? (nM - fm) : WGM;
        u.pm = fm + ((wgid % nig) % gsz); u.pn = (wgid % nig) / gsz; return true;
    }
    __device__ __forceinline__ void a_ready(const Unit&) const {}
    __device__ __forceinline__ void done(const Unit&) const {}
};

__device__ __forceinline__ unsigned cvt_pk_bf16(float lo, float hi) { unsigned r; asm volatile("v_cvt_pk_bf16_f32 %0, %1, %2" : "=v"(r) : "v"(lo), "v"(hi)); return r; }

template <int ACT  > struct EpiBf16 {
    static constexpr bool PERM = true, AFTER_DRAIN = false;
    bf16_t* O; int ldc;
    __device__ __forceinline__ void operator()(const f32x4 (&acc)[2][2][4][2], const Unit& u, int wr, int wc, int fr, int fq) const {
        const int row0 = u.pm * BM + wr * 64 + fr; const int col0 = u.pn * BM + wc * 32 + 8 * fq;
#pragma unroll
        for (int ai = 0; ai < 2; ++ai)
#pragma unroll
            for (int m = 0; m < 4; ++m) { bf16_t* rowp = O + (size_t)(row0 + ai * HALF + m * 16) * ldc + col0;
#pragma unroll
                for (int bj = 0; bj < 2; ++bj) { f32x4 v0 = acc[ai][bj][m][0], v1 = acc[ai][bj][m][1];
                    if (ACT == 1) {
#pragma unroll
                        for (int j = 0; j < 4; ++j) { const float a = fmaxf(v0[j], 0.f), b = fmaxf(v1[j], 0.f); v0[j] = a * a; v1[j] = b * b; } }
                    u32x4 w; w.x = cvt_pk_bf16(v0[0], v0[1]); w.y = cvt_pk_bf16(v0[2], v0[3]); w.z = cvt_pk_bf16(v1[0], v1[1]); w.w = cvt_pk_bf16(v1[2], v1[3]);
                    *(u32x4*)(rowp + bj * HALF) = w; } }
    }
};
struct EpiResid {
    static constexpr bool PERM = false, AFTER_DRAIN = false;
    float* X; int ldc; const float* gate; int gate_stride;
    __device__ __forceinline__ void operator()(const f32x4 (&acc)[2][2][4][2], const Unit& u, int wr, int wc, int fr, int fq) const {
        const int row0 = u.pm * BM + wr * 64 + fr, col0 = u.pn * BM + wc * 32 + 4 * fq;
        const float* g = gate + (size_t)(u.pm < 64 ? (u.pm >> 4) : 4) * gate_stride;
        f32x4 gv[2][2];
#pragma unroll
        for (int bj = 0; bj < 2; ++bj)
#pragma unroll
            for (int n = 0; n < 2; ++n) gv[bj][n] = *(const f32x4*)(g + col0 + bj * HALF + n * 16);
#pragma unroll
        for (int ai = 0; ai < 2; ++ai)
#pragma unroll
            for (int m = 0; m < 4; ++m) { float* rowp = X + (size_t)(row0 + ai * HALF + m * 16) * ldc + col0;
#pragma unroll
                for (int bj = 0; bj < 2; ++bj)
#pragma unroll
                    for (int n = 0; n < 2; ++n) { const f32x4 xo = *(const f32x4*)(rowp + bj * HALF + n * 16); *(f32x4*)(rowp + bj * HALF + n * 16) = xo + gv[bj][n] * acc[ai][bj][m][n]; } }
    }
};

struct EpiUV {
    static constexpr bool PERM = true, AFTER_DRAIN = false;
    bf16_t* UV2;
    __device__ __forceinline__ void operator()(const f32x4 (&acc)[2][2][4][2], const Unit& u, int wr, int wc, int fr, int fq) const {
        const int uv = u.pm >> 4, k0 = (u.pm & 15) * BM + wr * 64 + fr, cc = wc * 32 + 8 * fq;
#pragma unroll
        for (int ai = 0; ai < 2; ++ai)
#pragma unroll
            for (int m = 0; m < 4; ++m) { const int k = k0 + ai * HALF + m * 16;
#pragma unroll
                for (int bj = 0; bj < 2; ++bj) { const int bg = 2 * u.pn + bj; const f32x4 v0 = acc[ai][bj][m][0], v1 = acc[ai][bj][m][1];
                    u32x4 w; w.x = cvt_pk_bf16(v0[0], v0[1]); w.y = cvt_pk_bf16(v0[2], v0[3]); w.z = cvt_pk_bf16(v1[0], v1[1]); w.w = cvt_pk_bf16(v1[2], v1[3]);
                    *(u32x4*)(UV2 + ((size_t)k * 16 + bg) * 256 + uv * 128 + cc) = w; } }
    }
};
struct EpiChan {
    static constexpr bool PERM = true, AFTER_DRAIN = false;
    bf16_t* MIX; float scale;
    __device__ __forceinline__ void operator()(const f32x4 (&acc)[2][2][4][2], const Unit& u, int wr, int wc, int fr, int fq) const {
        const int b = fr >> 2, g = fr & 3, kq0 = u.pm * 16 + wr * 4, j0 = wc * 32 + 8 * fq;
#pragma unroll
        for (int ai = 0; ai < 2; ++ai)
#pragma unroll
            for (int m = 0; m < 4; ++m) { const int k = kq0 + ai * 8 + m; const f32x4 v0 = acc[ai][0][m][0] * scale, v1 = acc[ai][0][m][1] * scale;
                u32x4 w; w.x = cvt_pk_bf16(v0[0], v0[1]); w.y = cvt_pk_bf16(v0[2], v0[3]); w.z = cvt_pk_bf16(v1[0], v1[1]); w.w = cvt_pk_bf16(v1[2], v1[3]);
                *(u32x4*)(MIX + ((size_t)b * 4096 + k) * 2048 + 1536 + g * 128 + j0) = w; }
    }
};

template <class Epi, class Sched, bool ALIGN_EPI = false, bool SP2 = false>
__device__ __forceinline__ void gemm_phase(PG8_LAS unsigned char* lds, const Gemm g, const Sched& S, const Epi& E, const int tid) {
    const int wid = __builtin_amdgcn_readfirstlane(tid >> 6), lane = tid & 63, wr = wid >> 2, wc = wid & 3, fr = lane & 15, fq = lane >> 4;
    const int K = g.K, nt = K / BK;
    unsigned voffA[2], voffB[2];
#pragma unroll
    for (int i = 0; i < 2; ++i) { int R, C; stage_rc(tid * 16 + i * 8192, R, C); const int Rb = Epi::PERM ? ((R & ~31) + perm32(R & 31)) : R;
        voffA[i] = (unsigned)(R * K + C) * 2u; voffB[i] = (unsigned)(Rb * K + C) * 2u; }
    const size_t kstep = (size_t)(BK * 2);
    const size_t hstep = (size_t)HALF * K * 2;
    const size_t tstep = 2 * hstep;
    const unsigned ldsw = (unsigned)wid * 1024u;
    const int aoff = lds_byte(wr * 64 + fr, fq * 8), boff = lds_byte(wc * 32 + fr, fq * 8);
#define PG8_SA(b, h) (((b) * 2 + (h)) * HTB)
#define PG8_SB(b, h) ((4 + (b) * 2 + (h)) * HTB)
#define PG8_STAGE(bufoff, gbase, voff) do { _Pragma("unroll") for (int _i = 0; _i < 2; ++_i) \
        __builtin_amdgcn_global_load_lds((const unsigned*)((const char*)(gbase) + (voff)[_i]), (PG8_LAS unsigned*)(lds + (bufoff) + ldsw + _i * 8192), 16, 0, 0); } while (0)
#define PG8_LDA(dst, b, h) do { _Pragma("unroll") for (int m = 0; m < 4; ++m) _Pragma("unroll") for (int k = 0; k < 2; ++k) dst[m][k] = *(const PG8_LAS bf16x8*)(lds + PG8_SA(b, h) + aoff + m * 2048 + k * 1024); } while (0)
#define PG8_LDB(dst, b, h) do { _Pragma("unroll") for (int n = 0; n < 2; ++n) _Pragma("unroll") for (int k = 0; k < 2; ++k) dst[n][k] = *(const PG8_LAS bf16x8*)(lds + PG8_SB(b, h) + boff + n * 2048 + k * 1024); } while (0)
#define PG8_MMA(ai, bj, At, Bt) do { __builtin_amdgcn_s_setprio(1); _Pragma("unroll") for (int m = 0; m < 4; ++m) _Pragma("unroll") for (int n = 0; n < 2; ++n) _Pragma("unroll") for (int k = 0; k < 2; ++k) \
        acc[ai][bj][m][n] = __builtin_amdgcn_mfma_f32_16x16x32_bf16(Bt[n][k], At[m][k], acc[ai][bj][m][n], 0, 0, 0); __builtin_amdgcn_s_setprio(0); } while (0)
#define PG8_WAIT_V(n) asm volatile("s_waitcnt vmcnt(" #n ")" ::: "memory")
#define PG8_WAIT_L(n) asm volatile("s_waitcnt lgkmcnt(" #n ")" ::: "memory")
#define PG8_BAR __builtin_amdgcn_s_barrier()
#define PG8_SCHED __builtin_amdgcn_sched_barrier(0)
    Unit cur, nxt; int ui = 0;
    if (!S.next(0, cur)) return;
    f32x4 acc[2][2][4][2];
#pragma unroll
    for (int a = 0; a < 2; ++a)
#pragma unroll
        for (int b = 0; b < 2; ++b)
#pragma unroll
            for (int m = 0; m < 4; ++m)
#pragma unroll
                for (int n = 0; n < 2; ++n) acc[a][b][m][n] = (f32x4){0.f, 0.f, 0.f, 0.f};
    bf16x8 At[4][2], B0[2][2], B1[2][2];
    const char* cA = (const char*)g.A + (size_t)cur.pm * tstep; const char* cB = (const char*)g.Bt + (size_t)cur.pn * tstep;
    S.a_ready(cur);
    if constexpr (SP2) {
        PG8_STAGE(PG8_SB(0, 0), cB, voffB); PG8_STAGE(PG8_SB(0, 1), cB + hstep, voffB); PG8_STAGE(PG8_SA(0, 0), cA, voffA); PG8_STAGE(PG8_SA(0, 1), cA + hstep, voffA);
        if (wr == 1) PG8_BAR;
        PG8_WAIT_V(2); PG8_BAR;
        PG8_STAGE(PG8_SB(1, 0), cB + kstep, voffB); PG8_STAGE(PG8_SA(1, 0), cA + kstep, voffA); PG8_STAGE(PG8_SB(1, 1), cB + hstep + kstep, voffB);
        PG8_WAIT_V(6); PG8_BAR;
    } else {
        PG8_STAGE(PG8_SB(0, 0), cB, voffB); PG8_STAGE(PG8_SA(0, 0), cA, voffA); PG8_STAGE(PG8_SB(0, 1), cB + hstep, voffB); PG8_STAGE(PG8_SA(0, 1), cA + hstep, voffA);
        if (wr == 1) PG8_BAR;
        PG8_WAIT_V(4); PG8_BAR;
        PG8_STAGE(PG8_SB(1, 0), cB + kstep, voffB); PG8_STAGE(PG8_SA(1, 0), cA + kstep, voffA); PG8_STAGE(PG8_SB(1, 1), cB + hstep + kstep, voffB);
        PG8_WAIT_V(6); PG8_BAR;
    }
    for (;;) {
        const bool has_next = S.next(ui + 1, nxt);
        const char* nA = has_next ? (const char*)g.A + (size_t)nxt.pm * tstep : cA; const char* nB = has_next ? (const char*)g.Bt + (size_t)nxt.pn * tstep : cB;
        for (int t = 0; t < nt; t += 2) {
            const bool last = (t == nt - 2);
            const char* a1 = cA + (size_t)(t + 1) * kstep;
            const char* a2 = last ? nA : cA + (size_t)(t + 2) * kstep; const char* b2 = last ? nB : cB + (size_t)(t + 2) * kstep;
            const char* a3 = a2 + kstep; const char* b3 = b2 + kstep;
            if (last && has_next) S.a_ready(nxt);
            if constexpr (SP2) {
            PG8_LDB(B0, 0, 0); PG8_LDB(B1, 0, 1); PG8_SCHED; PG8_LDA(At, 0, 0); PG8_STAGE(PG8_SA(1, 1), a1 + hstep, voffA);
            PG8_WAIT_V(8); PG8_WAIT_L(0); PG8_BAR; PG8_MMA(0, 0, At, B0); PG8_MMA(0, 1, At, B1); PG8_BAR; PG8_SCHED;
            PG8_LDA(At, 0, 1); PG8_STAGE(PG8_SB(0, 0), b2, voffB); PG8_STAGE(PG8_SB(0, 1), b2 + hstep, voffB); PG8_STAGE(PG8_SA(0, 0), a2, voffA);
            PG8_WAIT_V(8); PG8_WAIT_L(0); PG8_BAR; PG8_MMA(1, 0, At, B0); PG8_MMA(1, 1, At, B1); PG8_BAR; PG8_SCHED;
            PG8_LDB(B0, 1, 0); PG8_LDB(B1, 1, 1); PG8_SCHED; PG8_LDA(At, 1, 0); PG8_STAGE(PG8_SA(0, 1), a2 + hstep, voffA);
            PG8_WAIT_V(8); PG8_WAIT_L(0); PG8_BAR; PG8_MMA(0, 0, At, B0); PG8_MMA(0, 1, At, B1); PG8_BAR; PG8_SCHED;
            PG8_LDA(At, 1, 1); PG8_STAGE(PG8_SB(1, 0), b3, voffB); PG8_STAGE(PG8_SB(1, 1), b3 + hstep, voffB); PG8_STAGE(PG8_SA(1, 0), a3, voffA);
            PG8_WAIT_V(8); PG8_WAIT_L(0); PG8_BAR; PG8_MMA(1, 0, At, B0); PG8_MMA(1, 1, At, B1); PG8_BAR; PG8_SCHED;
            } else {
            PG8_LDB(B0, 0, 0); PG8_SCHED; PG8_LDA(At, 0, 0); PG8_STAGE(PG8_SA(1, 1), a1 + hstep, voffA);
            PG8_WAIT_L(8); PG8_BAR; PG8_WAIT_L(0); PG8_MMA(0, 0, At, B0); PG8_BAR; PG8_SCHED;
            PG8_LDB(B1, 0, 1); PG8_STAGE(PG8_SB(0, 0), b2, voffB);
            PG8_BAR; PG8_WAIT_L(0); PG8_MMA(0, 1, At, B1); PG8_BAR;
            PG8_LDA(At, 0, 1); PG8_STAGE(PG8_SA(0, 0), a2, voffA);
            PG8_BAR; PG8_WAIT_L(0); PG8_MMA(1, 0, At, B0); PG8_BAR; PG8_SCHED;
            PG8_STAGE(PG8_SB(0, 1), b2 + hstep, voffB);
            PG8_WAIT_V(6); PG8_BAR; PG8_MMA(1, 1, At, B1); PG8_BAR;
            PG8_LDB(B0, 1, 0); PG8_SCHED; PG8_LDA(At, 1, 0); PG8_STAGE(PG8_SA(0, 1), a2 + hstep, voffA);
            PG8_WAIT_L(8); PG8_BAR; PG8_WAIT_L(0); PG8_MMA(0, 0, At, B0); PG8_BAR; PG8_SCHED;
            PG8_LDB(B1, 1, 1); PG8_STAGE(PG8_SB(1, 0), b3, voffB);
            PG8_BAR; PG8_WAIT_L(0); PG8_MMA(0, 1, At, B1); PG8_BAR;
            PG8_LDA(At, 1, 1); PG8_STAGE(PG8_SA(1, 0), a3, voffA);
            PG8_BAR; PG8_WAIT_L(0); PG8_MMA(1, 0, At, B0); PG8_BAR; PG8_SCHED;
            PG8_STAGE(PG8_SB(1, 1), b3 + hstep, voffB);
            PG8_WAIT_V(6); PG8_BAR; PG8_MMA(1, 1, At, B1); PG8_BAR;
            }
        }
        if constexpr (ALIGN_EPI) { if (wr == 0) PG8_BAR; }
        if constexpr (!Epi::AFTER_DRAIN) { E(acc, cur, wr, wc, fr, fq); S.done(cur); }
        if (!has_next) break;
#pragma unroll
        for (int a = 0; a < 2; ++a)
#pragma unroll
            for (int b = 0; b < 2; ++b)
#pragma unroll
                for (int m = 0; m < 4; ++m)
#pragma unroll
                    for (int n = 0; n < 2; ++n) acc[a][b][m][n] = (f32x4){0.f, 0.f, 0.f, 0.f};
        cur = nxt; cA = nA; cB = nB; ++ui;
        if constexpr (ALIGN_EPI) { if (wr == 1) PG8_BAR; }
    }
    PG8_WAIT_V(0);
    if constexpr (!ALIGN_EPI) { if (wr == 0) PG8_BAR; }
    PG8_BAR;
    if constexpr (Epi::AFTER_DRAIN) { E.fused(acc, cur, wr, wc, fr, fq, lds, wid, lane); S.done(cur); }
#undef PG8_SA
#undef PG8_SB
#undef PG8_STAGE
#undef PG8_LDA
#undef PG8_LDB
#undef PG8_MMA
#undef PG8_WAIT_V
#undef PG8_WAIT_L
#undef PG8_BAR
#undef PG8_SCHED
}
}

constexpr int NWAVES = 8;
#ifndef MK_ONE_LAUNCH
#define MK_ONE_LAUNCH 1
#endif

constexpr int DM = 2048, NB = 4, SEQ = 4096, DEPTH = 4, NCTX = 256, INW = 5120, DFF = 8192, ADA = 6 * DM;
constexpr int MLAT = NB * SEQ, MCTX = NB * NCTX, MALL = MLAT + MCTX;
constexpr float LAM_INIT1 = 0.35550906759096926f, LAM_INIT3 = 0.5560582041556405f;

constexpr size_t MiB = 1u << 20;
constexpr size_t WS_CTL = 0, CTL_ZERO_BYTES = 1 * MiB;
constexpr size_t WS_MOD = 1 * MiB;
constexpr size_t WS_LAM = 2 * MiB;
constexpr size_t WS_ADAP = 3 * MiB;
constexpr size_t WS_WIN = 16 * MiB, WS_WOUT = 96 * MiB, WS_W1 = 128 * MiB, WS_W2 = 256 * MiB;
constexpr size_t WS_X = 384 * MiB;
constexpr size_t WS_H = 520 * MiB;
constexpr size_t WS_P = 588 * MiB;
constexpr size_t WS_MIX = 758 * MiB;
constexpr size_t WS_HID = 826 * MiB;
constexpr size_t WS_VN = 826 * MiB;
constexpr size_t WS_O12 = 826 * MiB;
constexpr size_t WS_FA = 1030 * MiB, WS_FB = 1064 * MiB;
constexpr size_t WS_CS = 1098 * MiB;
constexpr size_t WS_CT = 1162 * MiB;
constexpr size_t WS_FT = 1163 * MiB;
constexpr size_t WS_UV = 1179 * MiB;
constexpr size_t WS_SGW = 1211 * MiB;
constexpr size_t WS_END = 1212 * MiB;
constexpr int CW_BAR = 4096;

constexpr int RING_OFF = 0, RING_BYTES = 131072;
constexpr int LDSCTL_OFF = RING_BYTES, MISC_OFF = LDSCTL_OFF + 320;
constexpr int LDS_BYTES = 147456;

#define GAS __attribute__((address_space(1)))
#define LAS __attribute__((address_space(3)))
typedef unsigned short bf16;
typedef unsigned v4u __attribute__((ext_vector_type(4)));
typedef unsigned v2u __attribute__((ext_vector_type(2)));
typedef float f32x4 __attribute__((ext_vector_type(4)));
typedef float f32x2 __attribute__((ext_vector_type(2)));
#define LDS_WAIT() asm volatile("s_waitcnt lgkmcnt(0)" ::: "memory")
__device__ __forceinline__ unsigned f2bf(float f) { unsigned u = __builtin_bit_cast(unsigned, f); return (u + 0x7fffu + ((u >> 16) & 1u)) >> 16; }
__device__ __forceinline__ unsigned pk2(float lo, float hi) { return f2bf(lo) | (f2bf(hi) << 16); }
__device__ __forceinline__ float bf2f(bf16 v) { return __builtin_bit_cast(float, (unsigned)v << 16); }
__device__ __forceinline__ float bflo(unsigned w) { return __builtin_bit_cast(float, w << 16); }
__device__ __forceinline__ float bfhi(unsigned w) { return __builtin_bit_cast(float, w & 0xffff0000u); }
#define XB_TMO      128
#define XB_XCNT(j)  (256  + 64 * (j))
#define XB_XSUB(j)  (1280 + 64 * (j))
#define XB_XGEN(j)  (2304 + 64 * (j))
#define XB_TOP      3328
#define XB_TOPGEN   3392
#define XCD_BAR_WORDS 3456
#define XB_SPIN_CAP (1u << 20)

__device__ __forceinline__ unsigned xb_ld(unsigned* p)              { return __hip_atomic_load(p, __ATOMIC_RELAXED, __HIP_MEMORY_SCOPE_AGENT); }
__device__ __forceinline__ unsigned xb_add(unsigned* p, unsigned v) { return __hip_atomic_fetch_add(p, v, __ATOMIC_RELAXED, __HIP_MEMORY_SCOPE_AGENT); }
__device__ __forceinline__ unsigned xb_xcc_id() { return (unsigned)__builtin_amdgcn_s_getreg((3 << 11) | 20) & 0xFu; }
#define XB_SPIN(cond, bar) do { unsigned _sp = 0; while (cond) { __builtin_amdgcn_s_sleep(1); \
    if ((++_sp & 255u) == 0u) { if (xb_ld(&(bar)[XB_TMO])) break; if (_sp > XB_SPIN_CAP) { atomicAdd(&(bar)[XB_TMO], 1u); break; } } } } while (0)

struct XcdBarrier {
    unsigned* bar; unsigned x;
    volatile LAS unsigned* st;
};

__device__ __forceinline__ XcdBarrier xcd_barrier_post(unsigned* bar, volatile LAS unsigned* st) {
    XcdBarrier b; b.bar = bar; b.x = xb_xcc_id(); b.st = st;
    if (threadIdx.x == 0) (void)xb_add(&bar[XB_XCNT(b.x)], 1u);
    return b;
}
__device__ __forceinline__ void xcd_barrier_complete(unsigned* bar, unsigned x, unsigned& nloc, unsigned& nx) {
    const unsigned G = gridDim.x * gridDim.y * gridDim.z;
    unsigned sum, cnt, mine, sp = 0u;
    for (;;) {
        sum = 0u; cnt = 0u; mine = 0u;
#pragma unroll
        for (unsigned j = 0; j < 16; ++j) { const unsigned c = xb_ld(&bar[XB_XCNT(j)]); sum += c; cnt += (c > 0u) ? 1u : 0u; mine = (j == x) ? c : mine; }
        if (sum == G) break;
        __builtin_amdgcn_s_sleep(1);
        if ((++sp & 255u) == 0u) { if (xb_ld(&bar[XB_TMO])) break; if (sp > XB_SPIN_CAP) { atomicAdd(&bar[XB_TMO], 1u); break; } }
    }
    nloc = mine > 0u ? mine : 1u; nx = cnt > 0u ? cnt : 1u;
}

__device__ __forceinline__ void xcd_barrier(const XcdBarrier& b) {
    asm volatile("s_waitcnt vmcnt(0)" ::: "memory");
    __syncthreads();
    if (threadIdx.x == 0) {
        unsigned* bar = b.bar;
        __builtin_amdgcn_s_waitcnt(0);
        unsigned nloc = b.st[0], nx = b.st[1];
        if (nloc == 0u) { xcd_barrier_complete(bar, b.x, nloc, nx); b.st[0] = nloc; b.st[1] = nx; }
        const unsigned old = xb_add(&bar[XB_XSUB(b.x)], 1u);
        const unsigned gen = old / nloc;
        if (old + 1u == (gen + 1u) * nloc) {
            __builtin_amdgcn_fence(__ATOMIC_RELEASE, "agent");
            asm volatile("s_waitcnt vmcnt(0)" ::: "memory");
            const unsigned og = xb_add(&bar[XB_TOP], 1u);
            const unsigned tg = og / nx;
            if (og + 1u == (tg + 1u) * nx) xb_add(&bar[XB_TOPGEN], 1u);
            else XB_SPIN(xb_ld(&bar[XB_TOPGEN]) == tg, bar);
            __builtin_amdgcn_fence(__ATOMIC_ACQUIRE, "agent");
            xb_add(&bar[XB_XGEN(b.x)], 1u);
            asm volatile("s_waitcnt vmcnt(0)" ::: "memory");
        } else {
            XB_SPIN(xb_ld(&bar[XB_XGEN(b.x)]) == gen, bar);
            __builtin_amdgcn_fence(__ATOMIC_ACQUIRE, "agent");
            asm volatile("s_waitcnt vmcnt(0)" ::: "memory");
        }
    }
    __syncthreads();
}

__device__ __forceinline__ float wave_sum(float v) {
#pragma unroll
    for (int o = 1; o < 64; o <<= 1) v += __shfl_xor(v, o);
    return v;
}
__device__ __forceinline__ void p0_transpose_item(const float* W, int K, int N, bf16* WT, LAS float* scr, int item, int lane) {
    const int nblk = N / 32, kb = item / nblk, nb = item % nblk, k0 = 64 * kb, n0 = 32 * nb;
#pragma unroll 8
    for (int i = 0; i < 32; ++i) { const int kk = 2 * i + (lane >> 5); scr[kk * 33 + (lane & 31)] = W[(size_t)(k0 + kk) * N + n0 + (lane & 31)]; }
    LDS_WAIT(); asm volatile("" ::: "memory");
    const int c = lane & 7;
#pragma unroll
    for (int j = 0; j < 4; ++j) { const int n = (lane >> 3) + 8 * j; const LAS float* s = scr + (8 * c) * 33 + n;
        v4u o; o.x = pk2(s[0 * 33], s[1 * 33]); o.y = pk2(s[2 * 33], s[3 * 33]); o.z = pk2(s[4 * 33], s[5 * 33]); o.w = pk2(s[6 * 33], s[7 * 33]);
        *(GAS v4u*)(WT + (size_t)(n0 + n) * K + k0 + 8 * c) = o; }
    LDS_WAIT(); asm volatile("" ::: "memory");
}

template <int MODE>
__device__ __forceinline__ void norm_rows(const float* X, bf16* H, float* OUT, const float* gain, const float* modl, int sh_chunk, int M, int gw, int NGW, int lane) {
    for (int row = gw; row < M; row += NGW) {
        const GAS f32x4* xr = (const GAS f32x4*)(X + (size_t)row * DM) + lane;
        f32x4 v[8]; float ss = 0.f;
#pragma unroll
        for (int j = 0; j < 8; ++j) { v[j] = xr[64 * j]; ss += (v[j].x * v[j].x + v[j].y * v[j].y) + (v[j].z * v[j].z + v[j].w * v[j].w); }
        const float rstd = 1.0f / sqrtf(wave_sum(ss) * (1.0f / DM) + 1e-6f);
        if (MODE == 0) {
            const float* mr = modl + (size_t)(row < MLAT ? (row >> 12) : 4) * ADA;
            const GAS f32x4* sh = (const GAS f32x4*)(mr + sh_chunk * DM) + lane; const GAS f32x4* sc = (const GAS f32x4*)(mr + (sh_chunk + 1) * DM) + lane;
            const GAS f32x4* gg = (const GAS f32x4*)gain + lane;
            GAS v2u* o8 = (GAS v2u*)(H + (size_t)row * DM) + lane;
#pragma unroll
            for (int j = 0; j < 8; ++j) { const f32x4 g4 = gg[64 * j], s4 = sc[64 * j], h4 = sh[64 * j]; const f32x4 y = v[j] * rstd * g4 * (s4 + 1.0f) + h4;
                v2u w; w.x = pk2(y.x, y.y); w.y = pk2(y.z, y.w); o8[64 * j] = w; }
        } else {
            const GAS f32x4* gg = (const GAS f32x4*)gain + lane; GAS f32x4* o = (GAS f32x4*)(OUT + (size_t)row * DM) + lane;
#pragma unroll
            for (int j = 0; j < 8; ++j) o[64 * j] = v[j] * rstd * gg[64 * j];
        }
    }
}

template <int N> __device__ __forceinline__ float dot_bf(const bf16* kp, const float (&q)[N]) {
    float s = 0.f;
#pragma unroll
    for (int c = 0; c < N / 8; ++c) { const v4u w = ((const GAS v4u*)kp)[c];
        s += q[8 * c + 0] * bflo(w.x) + q[8 * c + 1] * bfhi(w.x) + q[8 * c + 2] * bflo(w.y) + q[8 * c + 3] * bfhi(w.y)
           + q[8 * c + 4] * bflo(w.z) + q[8 * c + 5] * bfhi(w.z) + q[8 * c + 6] * bflo(w.w) + q[8 * c + 7] * bfhi(w.w); }
    return s;
}
template <int DQK, int DVS, class KeyF>
__device__ __forceinline__ void naive_attn(const bf16* P, const float (&q)[DQK], int nkeys, const KeyF& keyf, float (&o)[DVS]) {
    float m = -1e30f, l = 0.f;
    for (int i = 0; i < nkeys; ++i) { size_t koff, voff; float bias; keyf(i, koff, voff, bias);
        const float s = dot_bf<DQK>(P + koff, q) + bias; const float mn = fmaxf(m, s); l = l * __expf(m - mn) + __expf(s - mn); m = mn; }
    const float il = 1.0f / l;
#pragma unroll
    for (int j = 0; j < DVS; ++j) o[j] = 0.f;
    for (int i = 0; i < nkeys; ++i) { size_t koff, voff; float bias; keyf(i, koff, voff, bias);
        const float s = dot_bf<DQK>(P + koff, q) + bias; const float p = __expf(s - m) * il;
#pragma unroll
        for (int c = 0; c < DVS / 8; ++c) { const v4u w = ((const GAS v4u*)(P + voff))[c];
            o[8 * c + 0] += p * bflo(w.x); o[8 * c + 1] += p * bfhi(w.x); o[8 * c + 2] += p * bflo(w.y); o[8 * c + 3] += p * bfhi(w.y);
            o[8 * c + 4] += p * bflo(w.z); o[8 * c + 5] += p * bfhi(w.z); o[8 * c + 6] += p * bflo(w.w); o[8 * c + 7] += p * bfhi(w.w); } }
}
template <int N> __device__ __forceinline__ void load_q(const bf16* qp, float scale, float (&q)[N]) {
#pragma unroll
    for (int c = 0; c < N / 8; ++c) { const v4u w = ((const GAS v4u*)qp)[c];
        q[8 * c + 0] = scale * bflo(w.x); q[8 * c + 1] = scale * bfhi(w.x); q[8 * c + 2] = scale * bflo(w.y); q[8 * c + 3] = scale * bfhi(w.y);
        q[8 * c + 4] = scale * bflo(w.z); q[8 * c + 5] = scale * bfhi(w.z); q[8 * c + 6] = scale * bflo(w.w); q[8 * c + 7] = scale * bfhi(w.w); }
}
template <int N> __device__ __forceinline__ void store_bf(bf16* op, const float (&o)[N]) {
#pragma unroll
    for (int c = 0; c < N / 8; ++c) { v4u w; w.x = pk2(o[8 * c], o[8 * c + 1]); w.y = pk2(o[8 * c + 2], o[8 * c + 3]); w.z = pk2(o[8 * c + 4], o[8 * c + 5]); w.w = pk2(o[8 * c + 6], o[8 * c + 7]); ((GAS v4u*)op)[c] = w; }
}

namespace da {
using bf16x8 = __attribute__((ext_vector_type(8))) short;
using s16x4  = __attribute__((ext_vector_type(4))) short;
using f32x16 = __attribute__((ext_vector_type(16))) float;
using u32x4  = __attribute__((ext_vector_type(4))) unsigned;
constexpr int KVBLK = 64;
constexpr int SHM_V = KVBLK * 128 * 2, SHM_K = KVBLK * 128 * 2;
constexpr int LDS_X2 = 0;
constexpr int LDS_WS = 2 * SHM_V + 2 * SHM_K;
constexpr float SCALE = 0.125f;
constexpr float THR = 8.f;
#define DA_KSWZ(row, colB) ((row) * 256 + ((colB) ^ (((row) & 7) << 4)))
#define DA_SBAR() __builtin_amdgcn_sched_barrier(0)
__device__ __forceinline__ int crow(int r, int hi) { return (r & 3) + 8 * (r >> 2) + 4 * hi; }
__device__ __forceinline__ unsigned cvtpk(float lo, float hi) { unsigned r; asm volatile("v_cvt_pk_bf16_f32 %0, %1, %2" : "=v"(r) : "v"(lo), "v"(hi)); return r; }

__device__ __forceinline__ void partialSM(f32x16& p0, f32x16& p1, float& m_reg, float& mn, float& alpha) {
  constexpr float C = SCALE * 1.4426950408889634f;
  float pmax = p0[0];
#pragma unroll
  for (int r = 1; r < 16; ++r) pmax = fmaxf(pmax, p0[r]);
#pragma unroll
  for (int r = 0; r < 16; ++r) pmax = fmaxf(pmax, p1[r]);
  { auto rr = __builtin_amdgcn_permlane32_swap(__float_as_uint(pmax), __float_as_uint(pmax), false, false);
    pmax = fmaxf(__uint_as_float(rr[0]), __uint_as_float(rr[1])); }
  if (__builtin_expect(__all(pmax - m_reg <= THR / SCALE), 1)) { mn = m_reg; alpha = 1.f; }
  else { mn = fmaxf(m_reg, pmax); alpha = __builtin_amdgcn_exp2f((m_reg - mn) * C); m_reg = mn; }
  const float mnC = -mn * C;
#pragma unroll
  for (int r = 0; r < 16; ++r) p0[r] = fmaf(p0[r], C, mnC);
#pragma unroll
  for (int r = 0; r < 16; ++r) p1[r] = fmaf(p1[r], C, mnC);
#pragma unroll
  for (int r = 0; r < 16; ++r) p0[r] = __builtin_amdgcn_exp2f(p0[r]);
}
__device__ __forceinline__ void finishSM(f32x16& p0, f32x16& p1, float alpha, float& l_reg, bf16x8& pa0, bf16x8& pa1, bf16x8& pa2, bf16x8& pa3) {
#pragma unroll
  for (int r = 0; r < 16; ++r) p1[r] = __builtin_amdgcn_exp2f(p1[r]);
  float ps = 0;
#pragma unroll
  for (int r = 0; r < 16; ++r) ps += p0[r];
#pragma unroll
  for (int r = 0; r < 16; ++r) ps += p1[r];
  { auto rr = __builtin_amdgcn_permlane32_swap(__float_as_uint(ps), __float_as_uint(ps), false, false);
    ps = __uint_as_float(rr[0]) + __uint_as_float(rr[1]); }
  l_reg = l_reg * alpha + ps;
#define DA_PK4(P, BASE, OUT) do { unsigned a0 = cvtpk(P[BASE + 0], P[BASE + 1]), a1 = cvtpk(P[BASE + 2], P[BASE + 3]);   \
    unsigned b0 = cvtpk(P[BASE + 4], P[BASE + 5]), b1 = cvtpk(P[BASE + 6], P[BASE + 7]);                              \
    auto r0 = __builtin_amdgcn_permlane32_swap(a0, b0, false, false); auto r1 = __builtin_amdgcn_permlane32_swap(a1, b1, false, false); \
    u32x4 w = {r0[0], r1[0], r0[1], r1[1]}; OUT = *reinterpret_cast<bf16x8*>(&w); } while (0)
  DA_PK4(p0, 0, pa0); DA_PK4(p0, 8, pa1); DA_PK4(p1, 0, pa2); DA_PK4(p1, 8, pa3);
#undef DA_PK4
}
__device__ __forceinline__ void qkt(f32x16& p0, f32x16& p1, const LAS char* Ks, const bf16x8 (&qr)[4], int r32, int hi, int mapcolB) {
  p0 = f32x16{}; p1 = f32x16{};
#pragma unroll
  for (int d0 = 0; d0 < 4; ++d0) { const int cb = mapcolB + (d0 * 16 + hi * 8) * 2;
    const bf16x8 b0 = *reinterpret_cast<const LAS bf16x8*>(Ks + DA_KSWZ(r32, cb));
    const bf16x8 b1 = *reinterpret_cast<const LAS bf16x8*>(Ks + DA_KSWZ(32 + r32, cb));
    p0 = __builtin_amdgcn_mfma_f32_32x32x16_bf16(b0, qr[d0], p0, 0, 0, 0);
    p1 = __builtin_amdgcn_mfma_f32_32x32x16_bf16(b1, qr[d0], p1, 0, 0, 0); }
}
__device__ __forceinline__ int v_st(int k, int c) { const int kk = (k & ~0xC) | ((k & 4) << 1) | ((k & 8) >> 1); return ((kk >> 3) * 4 + (c >> 5)) * 512 + ((kk & 7) * 32 + (c & 31)) * 2; }
__device__ __forceinline__ int v_rd_base(int lane) { return ((lane & 3) << 3) | (((lane >> 2) & 3) << 6) | (((lane >> 4) & 1) << 5) | (((lane >> 5) & 1) << 8); }
constexpr int v_rd_off(int d0, int ks, int half) { return d0 * 512 + ks * 4096 + half * 2048; }
template <int OFF> __device__ __forceinline__ s16x4 tr_read(int vb) {
  s16x4 r; asm volatile("ds_read_b64_tr_b16 %0, %1 offset:%2" : "=&v"(r) : "v"(vb), "i"(OFF) : "memory"); return r;
}
template <int D0> __device__ __forceinline__ void pv_one(f32x16& od, int vb, bf16x8 pa0, bf16x8 pa1, bf16x8 pa2, bf16x8 pa3) {
  const s16x4 l0 = tr_read<v_rd_off(D0, 0, 0)>(vb), h0 = tr_read<v_rd_off(D0, 0, 1)>(vb), l1 = tr_read<v_rd_off(D0, 1, 0)>(vb), h1 = tr_read<v_rd_off(D0, 1, 1)>(vb);
  const s16x4 l2 = tr_read<v_rd_off(D0, 2, 0)>(vb), h2 = tr_read<v_rd_off(D0, 2, 1)>(vb), l3 = tr_read<v_rd_off(D0, 3, 0)>(vb), h3 = tr_read<v_rd_off(D0, 3, 1)>(vb);
  asm volatile("s_waitcnt lgkmcnt(0)" ::: "memory"); DA_SBAR();
#define DA_PK(L, H) (bf16x8){L[0], L[1], L[2], L[3], H[0], H[1], H[2], H[3]}
  od = __builtin_amdgcn_mfma_f32_32x32x16_bf16(pa0, DA_PK(l0, h0), od, 0, 0, 0);
  od = __builtin_amdgcn_mfma_f32_32x32x16_bf16(pa1, DA_PK(l1, h1), od, 0, 0, 0);
  od = __builtin_amdgcn_mfma_f32_32x32x16_bf16(pa2, DA_PK(l2, h2), od, 0, 0, 0);
  od = __builtin_amdgcn_mfma_f32_32x32x16_bf16(pa3, DA_PK(l3, h3), od, 0, 0, 0);
#undef DA_PK
}
__device__ __forceinline__ void pv_d0(f32x16 (&o)[4], int vb, bf16x8 pa0, bf16x8 pa1, bf16x8 pa2, bf16x8 pa3) {
  pv_one<0>(o[0], vb, pa0, pa1, pa2, pa3); pv_one<1>(o[1], vb, pa0, pa1, pa2, pa3); pv_one<2>(o[2], vb, pa0, pa1, pa2, pa3); pv_one<3>(o[3], vb, pa0, pa1, pa2, pa3);
}

__device__ __forceinline__ void unit(const bf16* __restrict__ P, bf16* __restrict__ MIX, int qrow0, int hh, int lat_row0, int n_lat_tiles, int ctx_row0,
                                     float lam, float post, const float* __restrict__ sub_g, LAS char* lds, int tid) {
  const int wid = __builtin_amdgcn_readfirstlane(tid >> 6), lane = tid & 63, r32 = lane & 31, hi = lane >> 5, mp = wid >> 2, wq = wid & 3;
  LAS char* V_lds = lds; LAS char* K_lds = lds + 2 * SHM_V;
  LAS float* wsl = (LAS float*)(lds + LDS_WS) + wid * 64; LAS float* li_l = wsl; LAS float* al_l = wsl + 32;
  float m_reg = -1e30f, l_reg = 0; f32x16 o[4] = {}; bf16x8 qr[4];
  { const bf16* Qw = P + (size_t)(qrow0 + wq * 32 + r32) * INW + hh * 128 + mp * 64 + hi * 8;
#pragma unroll
    for (int d0 = 0; d0 < 4; ++d0) qr[d0] = *reinterpret_cast<const bf16x8*>(Qw + d0 * 16); }
  const int mapcolB = mp * 128;
  const int sr = tid >> 4, sc = (tid & 15) * 8, vst0 = v_st(sr, sc), vst1 = v_st(32 + sr, sc);
  const int vb0 = (int)(uintptr_t)V_lds + v_rd_base(lane);
  const bf16* Kc = P + 1536 + hh * 128 + sc; const bf16* Vc = P + 3072 + hh * 128 + sc;
  const int NT = n_lat_tiles + 4;
  struct { bf16x8 vs0, vs1, ks0, ks1; } st_[2];
#define DA_TROW(j) ((j) < n_lat_tiles ? lat_row0 + (j) * KVBLK : ctx_row0 + ((j) - n_lat_tiles) * KVBLK)
#define DA_SLOAD(i, j) do { const size_t _r0 = (size_t)(DA_TROW(j) + sr) * INW, _r1 = _r0 + (size_t)32 * INW; \
    st_[i].vs0 = *reinterpret_cast<const bf16x8*>(Vc + _r0); st_[i].vs1 = *reinterpret_cast<const bf16x8*>(Vc + _r1); \
    st_[i].ks0 = *reinterpret_cast<const bf16x8*>(Kc + _r0); st_[i].ks1 = *reinterpret_cast<const bf16x8*>(Kc + _r1); } while (0)
#define DA_SWRITE(b, i) do { *(LAS bf16x8*)(V_lds + (b) * SHM_V + vst0) = st_[i].vs0; *(LAS bf16x8*)(V_lds + (b) * SHM_V + vst1) = st_[i].vs1; const int kc = sc * 2; \
    *(LAS bf16x8*)(K_lds + (b) * SHM_K + DA_KSWZ(sr, kc)) = st_[i].ks0; *(LAS bf16x8*)(K_lds + (b) * SHM_K + DA_KSWZ(32 + sr, kc)) = st_[i].ks1; } while (0)
#define DA_SWAIT() asm volatile("s_waitcnt vmcnt(4)" ::: "memory")
#define DA_RESC(a) do { if (__any((a) < 1.f)) { if (hi == 0) al_l[r32] = (a); asm volatile("s_waitcnt lgkmcnt(0)" ::: "memory"); \
    _Pragma("unroll") for (int d = 0; d < 4; ++d) _Pragma("unroll") for (int r = 0; r < 16; ++r) o[d][r] *= al_l[crow(r, hi)]; } } while (0)
  f32x16 pA0, pA1, pB0, pB1; float mnA, mnB, alA, alB; bf16x8 pa0, pa1, pa2, pa3;
  constexpr int SE = 0, SO = 1;
  DA_SLOAD(SE, 0); asm volatile("s_waitcnt vmcnt(0)" ::: "memory"); DA_SWRITE(0, SE); __syncthreads();
  qkt(pA0, pA1, K_lds, qr, r32, hi, mapcolB); partialSM(pA0, pA1, m_reg, mnA, alA);
  DA_SLOAD(SO, 1); if (2 < NT) DA_SLOAD(SE, 2);
  DA_SWAIT(); DA_SWRITE(1, SO); __syncthreads();
  for (int j = 1; j + 1 < NT; j += 2) {
    DA_SBAR(); qkt(pB0, pB1, K_lds + SHM_K, qr, r32, hi, mapcolB);
    finishSM(pA0, pA1, alA, l_reg, pa0, pa1, pa2, pa3); DA_SBAR();
    DA_SLOAD(SO, j + 2); DA_SBAR();
    pv_d0(o, vb0, pa0, pa1, pa2, pa3); partialSM(pB0, pB1, m_reg, mnB, alB);
    __syncthreads(); DA_SWAIT(); DA_SWRITE(0, SE);
    DA_RESC(alB); __syncthreads();
    DA_SBAR(); qkt(pA0, pA1, K_lds, qr, r32, hi, mapcolB);
    finishSM(pB0, pB1, alB, l_reg, pa0, pa1, pa2, pa3); DA_SBAR();
    if (j + 3 < NT) DA_SLOAD(SE, j + 3); DA_SBAR();
    pv_d0(o, vb0 + SHM_V, pa0, pa1, pa2, pa3); partialSM(pA0, pA1, m_reg, mnA, alA);
    __syncthreads(); DA_SWAIT(); DA_SWRITE(1, SO);
    DA_RESC(alA); __syncthreads();
  }
  DA_SBAR(); qkt(pB0, pB1, K_lds + SHM_K, qr, r32, hi, mapcolB);
  finishSM(pA0, pA1, alA, l_reg, pa0, pa1, pa2, pa3); DA_SBAR();
  pv_d0(o, vb0, pa0, pa1, pa2, pa3); partialSM(pB0, pB1, m_reg, mnB, alB);
  __syncthreads(); DA_RESC(alB);
  finishSM(pB0, pB1, alB, l_reg, pa0, pa1, pa2, pa3); DA_SBAR();
  pv_d0(o, vb0 + SHM_V, pa0, pa1, pa2, pa3);
  if (hi == 0) li_l[r32] = l_reg; asm volatile("s_waitcnt lgkmcnt(0)" ::: "memory");
  float rli[16];
#pragma unroll
  for (int r = 0; r < 16; ++r) rli[r] = 1.0f / li_l[crow(r, hi)];
  __syncthreads();
  LAS float* X2 = (LAS float*)(lds + LDS_X2);
  if (mp == 1) {
#pragma unroll
    for (int r = 0; r < 16; ++r) { const int row = wq * 32 + crow(r, hi);
#pragma unroll
      for (int d0 = 0; d0 < 4; ++d0) X2[row * 128 + d0 * 32 + r32] = lam * o[d0][r] * rli[r]; }
  }
  __syncthreads();
  if (mp == 0) {
    float ss[16];
#pragma unroll
    for (int r = 0; r < 16; ++r) { const int row = wq * 32 + crow(r, hi); float s = 0.f;
#pragma unroll
      for (int d0 = 0; d0 < 4; ++d0) { const float v = o[d0][r] * rli[r] - X2[row * 128 + d0 * 32 + r32]; o[d0][r] = v; s += v * v; }
      ss[r] = s; }
#pragma unroll
    for (int r = 0; r < 16; ++r) { float s = ss[r];
      s += __shfl_xor(s, 1); s += __shfl_xor(s, 2); s += __shfl_xor(s, 4); s += __shfl_xor(s, 8); s += __shfl_xor(s, 16);
      ss[r] = post / sqrtf(s * (1.0f / 128.0f) + 1e-6f); }
    float gsub[4];
#pragma unroll
    for (int d0 = 0; d0 < 4; ++d0) gsub[d0] = sub_g[d0 * 32 + r32];
#pragma unroll
    for (int r = 0; r < 16; ++r) { bf16* op = MIX + (size_t)(qrow0 + wq * 32 + crow(r, hi)) * DM + hh * 128 + r32;
#pragma unroll
      for (int d0 = 0; d0 < 4; ++d0) op[d0 * 32] = (bf16)f2bf(o[d0][r] * ss[r] * gsub[d0]); }
  }
  __syncthreads();
#undef DA_TROW
#undef DA_SLOAD
#undef DA_SWRITE
#undef DA_SWAIT
#undef DA_RESC
}
}

namespace na {
using da::bf16x8; using da::s16x4; using da::f32x16; using da::u32x4; using da::crow; using da::SHM_V; using da::SHM_K; using da::LDS_WS;
constexpr float QSCALE = 0.08838834764831845f, LOG2E = 1.4426950408889634f, THR2 = 8.f * LOG2E, NEG = -1e30f;
constexpr int LDS_TAB = LDS_WS + 8 * 64 * 4 + 512;
__device__ __forceinline__ void qkt(f32x16& p0, f32x16& p1, const LAS char* Ks, const bf16x8 (&qr)[8], int r32, int hi) {
  p0 = f32x16{}; p1 = f32x16{};
#pragma unroll
  for (int d0 = 0; d0 < 8; ++d0) { const int cb = (d0 * 16 + hi * 8) * 2;
    const bf16x8 b0 = *reinterpret_cast<const LAS bf16x8*>(Ks + DA_KSWZ(r32, cb));
    const bf16x8 b1 = *reinterpret_cast<const LAS bf16x8*>(Ks + DA_KSWZ(32 + r32, cb));
    p0 = __builtin_amdgcn_mfma_f32_32x32x16_bf16(b0, qr[d0], p0, 0, 0, 0);
    p1 = __builtin_amdgcn_mfma_f32_32x32x16_bf16(b1, qr[d0], p1, 0, 0, 0); }
}
__device__ __forceinline__ void bias_mask(f32x16& p0, f32x16& p1, int mode, const LAS float* lanetab, int kb) {
  constexpr float C = QSCALE * LOG2E;
  if (mode == 0) {
#pragma unroll
    for (int r = 0; r < 16; ++r) { p0[r] *= C; p1[r] *= C; }
  } else if (mode == 2) {
#pragma unroll
    for (int r = 0; r < 16; ++r) { p0[r] = NEG; p1[r] = NEG; }
  } else {
#pragma unroll
    for (int r = 0; r < 16; ++r) { const int c = (r & 3) + 8 * (r >> 2);
      const float b0 = lanetab[c], b1 = lanetab[c + 32];
      p0[r] = ((unsigned)(kb + c) < 16u) ? fmaf(p0[r], C, b0) : NEG;
      p1[r] = ((unsigned)(kb + c + 32) < 16u) ? fmaf(p1[r], C, b1) : NEG; }
  }
}
__device__ __forceinline__ void partialSM(f32x16& p0, f32x16& p1, float& m_reg, float& mn, float& alpha) {
  float pmax = p0[0];
#pragma unroll
  for (int r = 1; r < 16; ++r) pmax = fmaxf(pmax, p0[r]);
#pragma unroll
  for (int r = 0; r < 16; ++r) pmax = fmaxf(pmax, p1[r]);
  { auto rr = __builtin_amdgcn_permlane32_swap(__float_as_uint(pmax), __float_as_uint(pmax), false, false);
    pmax = fmaxf(__uint_as_float(rr[0]), __uint_as_float(rr[1])); }
  if (__builtin_expect(__all(pmax - m_reg <= THR2), 1)) { mn = m_reg; alpha = 1.f; }
  else { mn = fmaxf(m_reg, pmax); alpha = __builtin_amdgcn_exp2f(m_reg - mn); m_reg = mn; }
#pragma unroll
  for (int r = 0; r < 16; ++r) p0[r] = __builtin_amdgcn_exp2f(p0[r] - mn);
#pragma unroll
  for (int r = 0; r < 16; ++r) p1[r] = p1[r] - mn;
}

__device__ __forceinline__ void unit(const bf16* __restrict__ P, bf16* __restrict__ MIX, int qrow0, int hh, bool lat, int b, int r0, const float* __restrict__ rpb_h, LAS char* lds, int tid) {
  const int wid = __builtin_amdgcn_readfirstlane(tid >> 6), lane = tid & 63, r32 = lane & 31, hi = lane >> 5;
  LAS char* V_lds = lds; LAS char* K_lds = lds + 2 * SHM_V;
  LAS float* wsl = (LAS float*)(lds + LDS_WS) + wid * 64; LAS float* li_l = wsl; LAS float* al_l = wsl + 32;
  LAS float* tab = (LAS float*)(lds + LDS_TAB);
  if (lat) for (int i = tid; i < 15 * 31; i += 512) tab[i] = rpb_h[i] * LOG2E;
  float m_reg = -1e28f, l_reg = 0; f32x16 o[4] = {}; bf16x8 qr[8];
  { const bf16* Qw = P + (size_t)(qrow0 + wid * 32 + r32) * INW + 2048 + hh * 128 + hi * 8;
#pragma unroll
    for (int d0 = 0; d0 < 8; ++d0) qr[d0] = *reinterpret_cast<const bf16x8*>(Qw + d0 * 16); }
  const int qgr = r0 + (wid >> 1), rs = min(max(qgr - 4, 0), 56), rbase = min(max(r0 - 4, 0), 52);
  const int qc = 32 * (wid & 1) + r32, cs = min(max(qc - 8, 0), 48), lt0 = 4 * hi - qc + 15, kb0 = 4 * hi - cs;
  const int sr = tid >> 4, sc = (tid & 15) * 8, vst0 = da::v_st(sr, sc), vst1 = da::v_st(32 + sr, sc);
  const int vb0 = (int)(uintptr_t)V_lds + da::v_rd_base(lane);
  const bf16* Kc = P + 3072 + hh * 128 + sc; const bf16* Vc = P + 4096 + hh * 128 + sc;
  const int NLT = lat ? 12 : 0, NT = NLT + 4;
  const int lat_row0 = b * SEQ + rbase * 64, ctx_row0 = MLAT + b * NCTX;
  struct { bf16x8 vs0, vs1, ks0, ks1; } st_;
#define NA_TROW(j) ((j) < NLT ? lat_row0 + (j) * 64 : ctx_row0 + ((j) - NLT) * 64)
#define NA_SLOAD(j) do { const size_t _r0 = (size_t)(NA_TROW(j) + sr) * INW, _r1 = _r0 + (size_t)32 * INW; \
    st_.vs0 = *reinterpret_cast<const bf16x8*>(Vc + _r0); st_.vs1 = *reinterpret_cast<const bf16x8*>(Vc + _r1); \
    st_.ks0 = *reinterpret_cast<const bf16x8*>(Kc + _r0); st_.ks1 = *reinterpret_cast<const bf16x8*>(Kc + _r1); } while (0)
#define NA_SWRITE(bb) do { *(LAS bf16x8*)(V_lds + (bb) * SHM_V + vst0) = st_.vs0; *(LAS bf16x8*)(V_lds + (bb) * SHM_V + vst1) = st_.vs1; const int kc = sc * 2; \
    *(LAS bf16x8*)(K_lds + (bb) * SHM_K + DA_KSWZ(sr, kc)) = st_.ks0; *(LAS bf16x8*)(K_lds + (bb) * SHM_K + DA_KSWZ(32 + sr, kc)) = st_.ks1; } while (0)
#define NA_RESC(a) do { if (__any((a) < 1.f)) { if (hi == 0) al_l[r32] = (a); asm volatile("s_waitcnt lgkmcnt(0)" ::: "memory"); \
    _Pragma("unroll") for (int d = 0; d < 4; ++d) _Pragma("unroll") for (int r = 0; r < 16; ++r) o[d][r] *= al_l[crow(r, hi)]; } } while (0)
#define NA_BM(p0, p1, j) do { const int _kr = rbase + (j); const int _mode = (j) >= NLT ? 0 : ((_kr >= rs && _kr < rs + 8) ? 1 : 2); \
    int _lt = min(max(_kr - qgr + 7, 0), 14) * 31 + lt0, _kb = kb0; asm volatile("" : "+v"(_lt), "+v"(_kb)); \
    bias_mask(p0, p1, _mode, tab + _lt, _kb); } while (0)
  f32x16 p0, p1; float mn, al; bf16x8 pa0, pa1, pa2, pa3;
  NA_SLOAD(0); asm volatile("s_waitcnt vmcnt(0)" ::: "memory"); NA_SWRITE(0); __syncthreads();
  NA_SLOAD(1);
  for (int j = 0; j < NT; ++j) {
    const int bb = j & 1;
    DA_SBAR(); qkt(p0, p1, K_lds + bb * SHM_K, qr, r32, hi); NA_BM(p0, p1, j); partialSM(p0, p1, m_reg, mn, al);
    NA_RESC(al);
    da::finishSM(p0, p1, al, l_reg, pa0, pa1, pa2, pa3); DA_SBAR();
    if (j + 1 < NT) { asm volatile("s_waitcnt vmcnt(0)" ::: "memory"); NA_SWRITE(bb ^ 1); }
    if (j + 2 < NT) NA_SLOAD(j + 2);
    DA_SBAR();
    da::pv_d0(o, vb0 + bb * SHM_V, pa0, pa1, pa2, pa3);
    __syncthreads();
  }
  if (hi == 0) li_l[r32] = l_reg; asm volatile("s_waitcnt lgkmcnt(0)" ::: "memory");
  float rli[16];
#pragma unroll
  for (int r = 0; r < 16; ++r) rli[r] = 1.0f / li_l[crow(r, hi)];
#pragma unroll
  for (int r = 0; r < 16; ++r) { bf16* op = MIX + (size_t)(qrow0 + wid * 32 + crow(r, hi)) * DM + 1024 + hh * 128 + r32;
#pragma unroll
    for (int d0 = 0; d0 < 4; ++d0) op[d0 * 32] = (bf16)f2bf(o[d0][r] * rli[r]); }
  __syncthreads();
#undef NA_TROW
#undef NA_SLOAD
#undef NA_SWRITE
#undef NA_RESC
#undef NA_BM
}
}

namespace sgu {
using da::bf16x8; using da::f32x16; using da::crow; using da::SHM_V;
__device__ __forceinline__ void unit(const bf16* __restrict__ P, bf16* __restrict__ MIX, int row0, int g, const bf16* __restrict__ Wg  , const float* __restrict__ gain  ,
                                     const float* __restrict__ bias  , LAS char* lds, int tid) {
  const int wid = __builtin_amdgcn_readfirstlane(tid >> 6), lane = tid & 63, r32 = lane & 31, hi = lane >> 5, pb = wid & 3, ch = wid >> 2;
  { const int q = tid >> 2, c0 = (tid & 3) * 32; const bf16* vp = P + (size_t)(row0 + q) * INW + 1024 + g * 128 + c0; float v[32];
#pragma unroll
    for (int c8 = 0; c8 < 4; ++c8) { const v4u w = ((const GAS v4u*)vp)[c8];
      v[8 * c8 + 0] = bflo(w.x); v[8 * c8 + 1] = bfhi(w.x); v[8 * c8 + 2] = bflo(w.y); v[8 * c8 + 3] = bfhi(w.y); v[8 * c8 + 4] = bflo(w.z); v[8 * c8 + 5] = bfhi(w.z); v[8 * c8 + 6] = bflo(w.w); v[8 * c8 + 7] = bfhi(w.w); }
    float s = 0.f;
#pragma unroll
    for (int j = 0; j < 32; ++j) s += v[j];
    s += __shfl_xor(s, 1); s += __shfl_xor(s, 2);
    const float mu = s * (1.0f / 128.0f); float qq = 0.f;
#pragma unroll
    for (int j = 0; j < 32; ++j) { v[j] -= mu; qq += v[j] * v[j]; }
    qq += __shfl_xor(qq, 1); qq += __shfl_xor(qq, 2);
    const float rstd = 1.0f / sqrtf(qq * (1.0f / 128.0f) + 1e-5f);
    LAS char* vt = lds + (q >> 6) * SHM_V;
#pragma unroll
    for (int c8 = 0; c8 < 4; ++c8) { const f32x4 g0 = *(const GAS f32x4*)(gain + c0 + 8 * c8), g1 = *(const GAS f32x4*)(gain + c0 + 8 * c8 + 4); v4u w;
      w.x = pk2(v[8 * c8 + 0] * rstd * g0.x, v[8 * c8 + 1] * rstd * g0.y); w.y = pk2(v[8 * c8 + 2] * rstd * g0.z, v[8 * c8 + 3] * rstd * g0.w);
      w.z = pk2(v[8 * c8 + 4] * rstd * g1.x, v[8 * c8 + 5] * rstd * g1.y); w.w = pk2(v[8 * c8 + 6] * rstd * g1.z, v[8 * c8 + 7] * rstd * g1.w);
      *(LAS v4u*)(vt + da::v_st(q & 63, c0 + 8 * c8)) = w; } }
  bf16x8 wa[8];
  { const bf16* wp = Wg + (size_t)(32 * pb + r32) * 128 + hi * 8;
#pragma unroll
    for (int ks = 0; ks < 8; ++ks) wa[ks] = *reinterpret_cast<const bf16x8*>(wp + ks * 16); }
  __syncthreads();
  f32x16 o0 = {}, o1 = {};
  const int vb = (int)(uintptr_t)lds + da::v_rd_base(lane) + ch * 1024;
  da::pv_one<0>(o0, vb, wa[0], wa[1], wa[2], wa[3]); da::pv_one<1>(o1, vb, wa[0], wa[1], wa[2], wa[3]);
  da::pv_one<0>(o0, vb + SHM_V, wa[4], wa[5], wa[6], wa[7]); da::pv_one<1>(o1, vb + SHM_V, wa[4], wa[5], wa[6], wa[7]);
  const int colb = g * 128 + ch * 64 + r32;
#pragma unroll
  for (int r = 0; r < 16; ++r) { const int p = 32 * pb + crow(r, hi); const float bs = bias[p]; const size_t row = (size_t)(row0 + p);
    const float u0 = bf2f(P[row * INW + colb]), u1 = bf2f(P[row * INW + colb + 32]);
    MIX[row * DM + colb] = (bf16)f2bf(u0 * (o0[r] + bs)); MIX[row * DM + colb + 32] = (bf16)f2bf(u1 * (o1[r] + bs)); }
  __syncthreads();
}
}

constexpr int NPH = 39;
struct Args { const float* in[22]; float* out; unsigned char* ws; int ph_lo, ph_hi; };
__global__ void __launch_bounds__(NWAVES * 64, 2) fwd(Args args) {
    extern __shared__ __attribute__((aligned(16))) unsigned char lds_raw[];
    LAS unsigned char* lds = (LAS unsigned char*)lds_raw;
    volatile LAS unsigned* MISC = (volatile LAS unsigned*)(lds + MISC_OFF);
    const int G = gridDim.x;
    typedef const __attribute__((address_space(4))) Args* KArgs;
    const KArgs ka0 = (KArgs)__builtin_amdgcn_kernarg_segment_ptr();
#define KA() ({ KArgs _p = ka0; asm volatile("" : "+s"(_p)); _p; })
#define ARG(i) (KA()->in[i])
#define WSP(T, off) ((T*)(KA()->ws + (off)))
#define THREAD_IDS() int tid = threadIdx.x; asm volatile("" : "+v"(tid)); int bx = blockIdx.x; asm volatile("" : "+s"(bx)); \
    const int lane = tid & 63, wave = __builtin_amdgcn_readfirstlane(tid >> 6); const int gw = bx * NWAVES + wave, NGW = G * NWAVES; const int gt = bx * (NWAVES * 64) + tid, NT = G * NWAVES * 64; \
    (void)lane; (void)wave; (void)gw; (void)NGW; (void)gt; (void)NT;
    {
    THREAD_IDS();
    for (int u = tid; u < (LDS_BYTES - LDSCTL_OFF) / 4; u += NWAVES * 64) ((LAS unsigned*)(lds + LDSCTL_OFF))[u] = 0u;
    __syncthreads();
    }
#if MK_ONE_LAUNCH
    XcdBarrier bar = xcd_barrier_post(WSP(unsigned, WS_CTL) + CW_BAR, MISC + 8);
#define GRID_BAR() xcd_barrier(bar)
#else
    (void)MISC;
#define GRID_BAR() do { } while (0)
#endif
    const int lo = args.ph_lo, hi = args.ph_hi;
#define IN(k) (lo <= (k) && (k) < hi)
#define SEAM(k) do { if (IN(k) && IN((k) + 1)) GRID_BAR(); } while (0)

    if (IN(0)) {
        THREAD_IDS();
        const float* x_in = ARG(0); const float* c_in = ARG(1); const float* ctx_in = ARG(2); const float* cctx_in = ARG(3); const float* ada_w = ARG(4);
        const float* w_in = ARG(8); const float* w_out = ARG(9); const float* mlp_w1 = ARG(19); const float* mlp_w2 = ARG(20);
        const float* lq1 = ARG(14); const float* lk1 = ARG(15); const float* lq2 = ARG(16); const float* lk2 = ARG(17);
        float* ADAP = WSP(float, WS_ADAP); float* LAM = WSP(float, WS_LAM); float* X = WSP(float, WS_X);
        bf16* WIN_T = WSP(bf16, WS_WIN); bf16* WOUT_T = WSP(bf16, WS_WOUT); bf16* W1_T = WSP(bf16, WS_W1); bf16* W2_T = WSP(bf16, WS_W2);
        LAS float* s_lds = (LAS float*)(lds + RING_OFF);
        for (int it = bx; it < DEPTH * 8 * 24; it += G) {
            const int l = it / 192, rem = it % 192, kc = rem / 24, cb = rem % 24;
            __syncthreads();
            for (int i = tid; i < 5 * 256; i += NWAVES * 64) { const int r = i >> 8, k = i & 255; const float cv = r < 4 ? c_in[r * DM + kc * 256 + k] : cctx_in[kc * 256 + k]; s_lds[i] = cv / (1.0f + expf(-cv)); }
            __syncthreads();
            const int col = cb * 512 + tid; float a0 = 0.f, a1 = 0.f, a2 = 0.f, a3 = 0.f, a4 = 0.f;
            const float* wp = ada_w + ((size_t)l * DM + kc * 256) * ADA + col;
#pragma unroll 8
            for (int k = 0; k < 256; ++k) { const float w = wp[(size_t)k * ADA]; a0 += s_lds[k] * w; a1 += s_lds[256 + k] * w; a2 += s_lds[512 + k] * w; a3 += s_lds[768 + k] * w; a4 += s_lds[1024 + k] * w; }
            float* pp = ADAP + ((size_t)(l * 8 + kc) * 5) * ADA + col;
            pp[0] = a0; pp[ADA] = a1; pp[2 * ADA] = a2; pp[3 * ADA] = a3; pp[4 * ADA] = a4;
        }
        __syncthreads();
        LAS float* scr = (LAS float*)(lds + RING_OFF + wave * 16384);
        constexpr int I_IN = (DM / 64) * (INW / 32), I_OUT = (DM / 64) * (DM / 32), I_1 = (DM / 64) * (DFF / 32), I_2 = (DFF / 64) * (DM / 32), I_L = I_IN + I_OUT + I_1 + I_2;
        for (int it = gw; it < DEPTH * I_L; it += NGW) {
            const int l = it / I_L; int r = it % I_L;
            if (r < I_IN) { p0_transpose_item(w_in + (size_t)l * DM * INW, DM, INW, WIN_T + (size_t)l * INW * DM, scr, r, lane); continue; } r -= I_IN;
            if (r < I_OUT) { p0_transpose_item(w_out + (size_t)l * DM * DM, DM, DM, WOUT_T + (size_t)l * DM * DM, scr, r, lane); continue; } r -= I_OUT;
            if (r < I_1) { p0_transpose_item(mlp_w1 + (size_t)l * DM * DFF, DM, DFF, W1_T + (size_t)l * DFF * DM, scr, r, lane); continue; } r -= I_1;
            p0_transpose_item(mlp_w2 + (size_t)l * DFF * DM, DFF, DM, W2_T + (size_t)l * DM * DFF, scr, r, lane);
        }
        for (size_t i = gt; i < (size_t)MALL * DM / 4; i += NT) { const f32x4 v = i < (size_t)MLAT * DM / 4 ? ((const GAS f32x4*)x_in)[i] : ((const GAS f32x4*)ctx_in)[i - (size_t)MLAT * DM / 4]; ((GAS f32x4*)X)[i] = v; }
        { bf16* CS = WSP(bf16, WS_CS);
          for (int i = gt; i < 8192 * 4096 / 8; i += NT) { const int row = i >> 9, n0 = (i & 511) * 8, k = row & 4095; const bool sinrow = row >= 4096; unsigned w[4];
#pragma unroll
              for (int e = 0; e < 8; e += 2) { float s0, c0, s1, c1; sincospif((float)((k * (n0 + e)) & 4095) * (1.0f / 2048.0f), &s0, &c0); sincospif((float)((k * (n0 + e + 1)) & 4095) * (1.0f / 2048.0f), &s1, &c1);
                  w[e >> 1] = sinrow ? pk2(s0, s1) : pk2(c0, c1); }
              *(GAS v4u*)(CS + (size_t)i * 8) = (v4u){w[0], w[1], w[2], w[3]}; }
          bf16* CT = WSP(bf16, WS_CT);
          for (int i = gt; i < 256 * 256; i += NT) { const int j = i >> 8, cc = i & 255, c = cc & 127; float sn, cs; sincospif((float)((j * c) & 127) * (1.0f / 64.0f), &sn, &cs);
              CT[i] = j < 128 ? (bf16)f2bf(cc < 128 ? cs : -sn) : (bf16)0; } }
        { const float* sgu_w = ARG(11); bf16* SGW = WSP(bf16, WS_SGW); for (int i = gt; i < 2 * 8 * 128 * 128; i += NT) SGW[i] = (bf16)f2bf(sgu_w[i]); }
        if (bx == 0 && tid < 2) { float d1 = 0.f, d2 = 0.f; for (int j = 0; j < 64; ++j) { d1 += lq1[tid * 64 + j] * lk1[tid * 64 + j]; d2 += lq2[tid * 64 + j] * lk2[tid * 64 + j]; }
            LAM[tid] = expf(d1) - expf(d2) + (tid == 0 ? LAM_INIT1 : LAM_INIT3); }
    }
    SEAM(0);
    if (IN(1)) {
        THREAD_IDS();
        const float* ada_b = ARG(5); const float* ADAP = WSP(float, WS_ADAP); float* MOD = WSP(float, WS_MOD);
        for (int i = gt; i < DEPTH * 5 * ADA; i += NT) { const int l = i / (5 * ADA), rc = i % (5 * ADA), col = rc % ADA; float s = ada_b[l * ADA + col];
#pragma unroll
            for (int kc = 0; kc < 8; ++kc) s += ADAP[(size_t)(l * 8 + kc) * 5 * ADA + rc];
            MOD[i] = s; }
    }
    SEAM(1);

    for (int l = 0; l < DEPTH; ++l) {
        const int pb = 2 + 9 * l; const bool odd = (l & 1) != 0, need_ctx = l < DEPTH - 1; const int li = l >> 1;
        const int MR = need_ctx ? MALL : MLAT;
#define MODL() (WSP(float, WS_MOD) + (size_t)l * 5 * ADA)
        if (IN(pb + 0)) { THREAD_IDS(); norm_rows<0>(WSP(float, WS_X), WSP(bf16, WS_H), nullptr, ARG(6) + l * DM, MODL(), 0, MALL, gw, NGW, lane); }
        SEAM(pb + 0);
        if (IN(pb + 1)) {
            THREAD_IDS();
            pg8::Gemm g{WSP(bf16, WS_H), WSP(bf16, WS_WIN) + (size_t)l * INW * DM, MALL, INW, DM}; pg8::StaticOrder S; S.init(MALL, INW, G, bx);
            pg8::EpiBf16<0> E{WSP(bf16, WS_P), INW};
            pg8::gemm_phase<pg8::EpiBf16<0>, pg8::StaticOrder, true, true>(lds + RING_OFF, g, S, E, tid);
        }
        SEAM(pb + 1);
        if (IN(pb + 2) && odd) {
            THREAD_IDS();
            bf16* P = WSP(bf16, WS_P);
            if (odd) {
                for (int idx = gt; idx < MLAT * 12 * 2 * 2 * 32; idx += NT) {
                    const int pi = idx & 31, mp = (idx >> 5) & 1, qk = (idx >> 6) & 1, rest = idx >> 7, hh = rest % 12, row = rest / 12;
                    const int axis = pi >> 4, i = pi & 15, n = row & (SEQ - 1); const float pos = (float)(axis == 0 ? (n >> 6) : (n & 63));
                    const float inv = exp2f(-(float)i * (13.287712379549449f / 16.0f)); const float ang = pos * inv; float sn, cs; sincosf(ang, &sn, &cs);
                    bf16* zp = P + (size_t)row * INW + qk * 1536 + hh * 128 + mp * 64 + axis * 32 + i;
                    const float z1 = bf2f(zp[0]), z2 = bf2f(zp[16]);
                    zp[0] = (bf16)f2bf(z1 * cs - z2 * sn); zp[16] = (bf16)f2bf(z2 * cs + z1 * sn);
                }
                { bf16* FT = WSP(bf16, WS_FT); LAS bf16* scr = (LAS bf16*)(lds + RING_OFF + wave * 16384);
                  for (int it = gw; it < NB * 64 * 8; it += NGW) { const int b = it >> 9, nb = (it >> 3) & 63, cb = it & 7;
#pragma unroll
                      for (int i = 0; i < 8; ++i) { const int r = 8 * i + (lane >> 3), ch = lane & 7; const v4u w = *(const GAS v4u*)(P + (size_t)(b * SEQ + nb * 64 + r) * INW + 4608 + cb * 64 + ch * 8);
                          LAS unsigned* d = (LAS unsigned*)(scr + r * 66 + ch * 8); d[0] = w.x; d[1] = w.y; d[2] = w.z; d[3] = w.w; }
                      LDS_WAIT(); asm volatile("" ::: "memory");
#pragma unroll
                      for (int i = 0; i < 8; ++i) { const int c = 8 * i + (lane >> 3), ch = lane & 7; unsigned short e[8];
#pragma unroll
                          for (int q = 0; q < 8; ++q) e[q] = scr[(ch * 8 + q) * 66 + c];
                          v4u w; w.x = e[0] | ((unsigned)e[1] << 16); w.y = e[2] | ((unsigned)e[3] << 16); w.z = e[4] | ((unsigned)e[5] << 16); w.w = e[6] | ((unsigned)e[7] << 16);
                          *(GAS v4u*)(FT + (size_t)(b * 512 + cb * 64 + c) * SEQ + nb * 64 + ch * 8) = w; }
                      LDS_WAIT(); asm volatile("" ::: "memory"); } }
            }
        }
        if (odd) SEAM(pb + 2);
        if (IN(pb + 3)) {
            THREAD_IDS();
            const bf16* P = WSP(bf16, WS_P); bf16* MIX = WSP(bf16, WS_MIX);
            const float* sgu_b = ARG(12); const float* na_rpb = ARG(13);
            if (!odd) {
                {
                    const bf16* SGW = WSP(bf16, WS_SGW); const float* sgu_g = ARG(10);
                    for (int u = bx; u < (MALL / 128) * 8; u += G) { const int g8 = u & 7, ck = u >> 3;
                        sgu::unit(P, MIX, ck * 128, g8, SGW + (size_t)(li * 8 + g8) * 16384, sgu_g + li * 1024 + g8 * 128, sgu_b + (li * 8 + g8) * 128, (LAS char*)(lds + RING_OFF), tid); }
                }
                __syncthreads();
                {
                    const int vcu = (G % 8 == 0) ? (bx % 8) * (G / 8) + bx / 8 : bx;
                    const int NU = NB * 8 * 16 + (need_ctx ? NB * 8 : 0);
                    for (int u = vcu; u < NU; u += G) {
                        const bool lat = u < NB * 8 * 16; int b, hh, r0, qrow0;
                        if (lat) { b = u >> 7; hh = (u >> 4) & 7; r0 = (u & 15) * 4; qrow0 = b * SEQ + r0 * 64; }
                        else { const int v = u - NB * 8 * 16; b = v >> 3; hh = v & 7; r0 = 0; qrow0 = MLAT + b * NCTX; }
                        na::unit(P, MIX, qrow0, hh, lat, b, r0, na_rpb + (size_t)(li * 8 + hh) * 465, (LAS char*)(lds + RING_OFF), tid);
                    }
                }
            } else {
                {
                    const int vcu = (G % 8 == 0) ? (bx % 8) * (G / 8) + bx / 8 : bx;
                    const float lam = WSP(float, WS_LAM)[li], post = 1.0f - (li == 0 ? LAM_INIT1 : LAM_INIT3); const float* sub_g = ARG(18) + li * 128;
                    const int NU = NB * 12 * 32 + (need_ctx ? NB * 12 * 2 : 0);
                    for (int u = vcu; u < NU; u += G) {
                        int bh, qrow0, nlt;
                        if (u < NB * 12 * 32) { bh = u >> 5; qrow0 = (bh / 12) * SEQ + (u & 31) * 128; nlt = SEQ / 64; }
                        else { const int v = u - NB * 12 * 32; bh = v >> 1; qrow0 = MLAT + (bh / 12) * NCTX + (v & 1) * 128; nlt = 0; }
                        const int b = bh / 12, hh = bh % 12;
                        da::unit(P, MIX, qrow0, hh, b * SEQ, nlt, MLAT + b * NCTX, lam, post, sub_g, (LAS char*)(lds + RING_OFF), tid);
                    }
                    __syncthreads();
                }
                {
                    pg8::Gemm g{WSP(bf16, WS_CS), WSP(bf16, WS_FT), 8192, 2048, SEQ}; pg8::StaticOrder S; S.init(8192, 2048, G, bx);
                    pg8::EpiUV E{WSP(bf16, WS_UV)};
                    pg8::gemm_phase<pg8::EpiUV, pg8::StaticOrder, true, true>(lds + RING_OFF, g, S, E, tid);
                }
                if (need_ctx) {
                    __syncthreads();
                    LAS f32x2* tw = (LAS f32x2*)(lds + RING_OFF);
                    if (tid < 128) { float sn, cs; sincospif(2.0f * (float)tid / 128.0f, &sn, &cs); tw[tid] = (f32x2){cs, sn}; }
                    __syncthreads();
                    float* FA = WSP(float, WS_FA); float* FB = WSP(float, WS_FB);
                    for (int idx = gt; idx < MCTX * 512; idx += NT) {
                        const int row = MLAT + (idx >> 9), gj = idx & 511, g4 = gj >> 7, j = gj & 127; const bf16* xp = P + (size_t)row * INW + 4608 + g4 * 128; float fa = 0.f, fb = 0.f;
                        for (int c8 = 0; c8 < 16; ++c8) { const v4u w = ((const GAS v4u*)xp)[c8]; const float xv[8] = {bflo(w.x), bfhi(w.x), bflo(w.y), bfhi(w.y), bflo(w.z), bfhi(w.z), bflo(w.w), bfhi(w.w)};
#pragma unroll
                            for (int e = 0; e < 8; ++e) { const f32x2 t = tw[(j * (c8 * 8 + e)) & 127]; fa += xv[e] * t.x; fb += xv[e] * t.y; } }
                        FA[idx] = fa; FB[idx] = fb;
                    }
                    __syncthreads();
                }
            }
        }
        SEAM(pb + 3);
        if (IN(pb + 4) && odd) {
            THREAD_IDS();
            {
                pg8::Gemm g{WSP(bf16, WS_UV), WSP(bf16, WS_CT), SEQ * 16, 256, 256}; pg8::StaticOrder S; S.init(SEQ * 16, 256, G, bx);
                pg8::EpiChan E{WSP(bf16, WS_MIX), 0.0013810679320049757f};
                pg8::gemm_phase<pg8::EpiChan, pg8::StaticOrder, true, true>(lds + RING_OFF, g, S, E, tid);
            }
            if (need_ctx) {
                __syncthreads();
                LAS f32x2* tw = (LAS f32x2*)(lds + RING_OFF); bf16* MIX = WSP(bf16, WS_MIX); const float* FA = WSP(float, WS_FA); const float* FB = WSP(float, WS_FB);
                if (tid < NCTX) { float sn, cs; sincospif(2.0f * (float)tid / (float)NCTX, &sn, &cs); tw[tid] = (f32x2){cs, sn}; }
                __syncthreads();
                for (int idx = gt; idx < NB * NCTX * 512; idx += NT) {
                    const int gj = idx & 511, k = (idx >> 9) & (NCTX - 1), b = idx >> 17; float acc = 0.f;
                    const float* fa = FA + ((size_t)b * NCTX) * 512 + gj; const float* fb = FB + ((size_t)b * NCTX) * 512 + gj;
                    for (int n = 0; n < NCTX; ++n) { const f32x2 t = tw[(k * n) & (NCTX - 1)]; acc += fa[(size_t)n * 512] * t.x - fb[(size_t)n * 512] * t.y; }
                    MIX[((size_t)MLAT + b * NCTX + k) * DM + 1536 + gj] = (bf16)f2bf(acc * 0.005524271728019903f);
                }
                __syncthreads();
            }
        }
        if (odd) SEAM(pb + 4);
        if (IN(pb + 5)) {
            THREAD_IDS();
            pg8::Gemm g{WSP(bf16, WS_MIX), WSP(bf16, WS_WOUT) + (size_t)l * DM * DM, MR, DM, DM}; pg8::StaticOrder S; S.init(MR, DM, G, bx);
            pg8::EpiResid E{WSP(float, WS_X), DM, MODL() + 2 * DM, ADA};
            pg8::gemm_phase<pg8::EpiResid, pg8::StaticOrder, true, true>(lds + RING_OFF, g, S, E, tid);
        }
        SEAM(pb + 5);
        if (IN(pb + 6)) { THREAD_IDS(); norm_rows<0>(WSP(float, WS_X), WSP(bf16, WS_H), nullptr, ARG(7) + l * DM, MODL(), 3, MR, gw, NGW, lane); }
        SEAM(pb + 6);
        if (IN(pb + 7)) {
            THREAD_IDS();
            pg8::Gemm g{WSP(bf16, WS_H), WSP(bf16, WS_W1) + (size_t)l * DFF * DM, MR, DFF, DM}; pg8::StaticOrder S; S.init(MR, DFF, G, bx);
            pg8::EpiBf16<1> E{WSP(bf16, WS_HID), DFF};
            pg8::gemm_phase<pg8::EpiBf16<1>, pg8::StaticOrder, true, true>(lds + RING_OFF, g, S, E, tid);
        }
        SEAM(pb + 7);
        if (IN(pb + 8)) {
            THREAD_IDS();
            pg8::Gemm g{WSP(bf16, WS_HID), WSP(bf16, WS_W2) + (size_t)l * DM * DFF, MR, DM, DFF}; pg8::StaticOrder S; S.init(MR, DM, G, bx);
            pg8::EpiResid E{WSP(float, WS_X), DM, MODL() + 5 * DM, ADA};
            pg8::gemm_phase<pg8::EpiResid, pg8::StaticOrder, true, true>(lds + RING_OFF, g, S, E, tid);
        }
        SEAM(pb + 8);
    }
    if (IN(NPH - 1)) { THREAD_IDS(); norm_rows<1>(WSP(float, WS_X), nullptr, KA()->out, ARG(21), nullptr, 0, MLAT, gw, NGW, lane); }
#undef IN
#undef SEAM
#undef GRID_BAR
}

extern "C" void kernel_launch(void* const* d_in, const int* in_sizes, int n_in, void* d_out, int out_size, void* d_ws, size_t ws_size, hipStream_t stream) {
    static int grid = 0;
    if (grid == 0) {
        if (n_in != 22 || in_sizes[0] != MLAT * DM || out_size != MLAT * DM || ws_size < WS_END) { fprintf(stderr, "kernel_launch: unexpected shapes (n_in %d, in0 %d, out %d, ws %zu); nothing launched\n", n_in, n_in > 0 ? in_sizes[0] : -1, out_size, ws_size); grid = -1; return; }
        int dev = 0, cus = 0, per_cu = 0;
        if (hipGetDevice(&dev) != hipSuccess || hipDeviceGetAttribute(&cus, hipDeviceAttributeMultiprocessorCount, dev) != hipSuccess) { grid = -1; return; }
        if (hipFuncSetAttribute((const void*)fwd, hipFuncAttributeMaxDynamicSharedMemorySize, LDS_BYTES) != hipSuccess) { fprintf(stderr, "kernel_launch: hipFuncSetAttribute failed\n"); grid = -1; return; }
        if (hipOccupancyMaxActiveBlocksPerMultiprocessor(&per_cu, (const void*)fwd, NWAVES * 64, LDS_BYTES) != hipSuccess || per_cu < 1) fprintf(stderr, "kernel_launch: occupancy query reports %d workgroups per CU\n", per_cu);
        (void)hipGetLastError();
        grid = cus;
    }
    if (grid < 0) return;
    if (hipMemsetAsync((char*)d_ws + WS_CTL, 0, CTL_ZERO_BYTES, stream) != hipSuccess) return;
    Args a{};
    for (int i = 0; i < 22; ++i) a.in[i] = (const float*)d_in[i];
    a.out = (float*)d_out; a.ws = (unsigned char*)d_ws;
#if MK_ONE_LAUNCH
    a.ph_lo = 0; a.ph_hi = NPH;
    hipLaunchKernelGGL(fwd, dim3(grid), dim3(NWAVES * 64), LDS_BYTES, stream, a);
#else
    for (int ph = 0; ph < NPH; ++ph) {
        if (ph >= 2 && ph < NPH - 1) { const int l = (ph - 2) / 9, k = (ph - 2) % 9; if ((k == 4 || k == 2) && !(l & 1)) continue; }
        a.ph_lo = ph; a.ph_hi = ph + 1;
        hipLaunchKernelGGL(fwd, dim3(grid), dim3(NWAVES * 64), LDS_BYTES, stream, a);
    }
#endif
    const hipError_t le = hipPeekAtLastError();
    if (le != hipSuccess) fprintf(stderr, "kernel_launch: launch failed: %s\n", hipGetErrorName(le));
}
```

```cpp
#include <hip/hip_runtime.h>
#include <cstdio>
#include <cstdint>
namespace pg8 {
#define PG8_LAS __attribute__((address_space(3)))
typedef unsigned short bf16_t;
typedef short bf16x8 __attribute__((ext_vector_type(8)));
typedef float f32x4 __attribute__((ext_vector_type(4)));
typedef unsigned u32x4 __attribute__((ext_vector_type(4)));
constexpr int BM = 256, BK = 64, HALF = 128, HTB = HALF * BK * 2  , STAGE_BYTES = 8 * HTB, NXCD = 8, WGM = 8;

__host__ __device__ __forceinline__ int lds_byte(int r, int c) { const int st = (r >> 4) * 2 + (c >> 5), rr = r & 15, cc = c & 31, ob = rr * 64 + cc * 2; return st * 1024 + (ob ^ (((ob >> 9) & 1) << 5)); }
__host__ __device__ __forceinline__ void stage_rc(int b, int& R, int& C) { const int st = b / 1024, sb = b % 1024, swz = sb ^ (((sb >> 9) & 1) << 5); R = (st >> 1) * 16 + swz / 64; C = (st & 1) * 32 + (swz % 64) / 2; }
__host__ __device__ __forceinline__ int perm32(int rho) { const int n = rho >> 4, i = rho & 15; return 8 * (i >> 2) + 4 * n + (i & 3); }

struct Unit { int pm, pn, koff, nt; };
struct Unit_doc_;
struct Gemm { const bf16_t* A; const bf16_t* Bt; int M, N, K, ldk; };

struct StaticOrder {
    int nM, nN, nwg, G, c, pm0;
    __host__ __device__ void init(int M, int N, int G_, int c_, int pm0_ = 0) { nM = M / BM; nN = N / BM; nwg = nM * nN; G = G_; c = c_; pm0 = pm0_; }
    __host__ __device__ bool next(int i, Unit& u) const {
        const long L = (long)i * G + c; if (L >= nwg) return false;
        int wgid = (int)L; { const int q = nwg / NXCD, r = nwg % NXCD, xcd = wgid % NXCD, off = wgid / NXCD; wgid = (xcd < r ? xcd * (q + 1) : r * (q + 1) + (xcd - r) * q) + off; }
        const int nig = WGM * nN, gid = wgid / nig, fm = gid * WGM, gsz = (nM - fm) < WGM ? (nM - fm) : WGM;
        u.pm = pm0 + fm + ((wgid % nig) % gsz); u.pn = (wgid % nig) / gsz; u.koff = 0; u.nt = 0; return true;
    }
    __device__ __forceinline__ void a_ready(const Unit&) const {}
    __device__ __forceinline__ void done(const Unit&) const {}
};

struct SplitKOrder {
    int npm, npn, nks, kslice, G, c;
    __host__ __device__ bool next(int i, Unit& u) const {
        const int L = i * G + c; if (L >= npm * npn * nks) return false;
        const int t = L % (npm * npn); u.pn = t % npn; u.pm = t / npn; u.koff = (L / (npm * npn)) * kslice; u.nt = 0; return true;
    }
    __device__ __forceinline__ void a_ready(const Unit&) const {}
    __device__ __forceinline__ void done(const Unit&) const {}
};

struct ResidOrder {
    StaticOrder lat; int nctx, kslice, c;
    __host__ __device__ bool next(int i, Unit& u) const {
        const int nl = (lat.nwg - c + lat.G - 1) / lat.G; const bool first = nctx && (c & 1);
        const int j = first ? i - 1 : i;
        if (j >= 0 && j < nl) return lat.next(j, u);
        if (nctx && ((first && i == 0) || (!first && i == nl))) { const int t = c & 31; u.pn = t & 7; u.pm = 64 + (t >> 3); u.koff = (c >> 5) * kslice; u.nt = kslice / BK; return true; }
        return false;
    }
    __device__ __forceinline__ void a_ready(const Unit&) const {}
    __device__ __forceinline__ void done(const Unit&) const {}
};

__device__ __forceinline__ unsigned cvt_pk_bf16(float lo, float hi) { unsigned r; asm volatile("v_cvt_pk_bf16_f32 %0, %1, %2" : "=v"(r) : "v"(lo), "v"(hi)); return r; }

template <int ACT  > struct EpiBf16 {
    static constexpr bool PERM = true, AFTER_DRAIN = false;
    bf16_t* O; int ldc;
    __device__ __forceinline__ void operator()(const f32x4 (&acc)[2][2][4][2], const Unit& u, int wr, int wc, int fr, int fq) const {
        const int row0 = u.pm * BM + wr * 64 + fr; const int col0 = u.pn * BM + wc * 32 + 8 * fq;
#pragma unroll
        for (int ai = 0; ai < 2; ++ai)
#pragma unroll
            for (int m = 0; m < 4; ++m) { bf16_t* rowp = O + (size_t)(row0 + ai * HALF + m * 16) * ldc + col0;
#pragma unroll
                for (int bj = 0; bj < 2; ++bj) { f32x4 v0 = acc[ai][bj][m][0], v1 = acc[ai][bj][m][1];
                    if (ACT == 1) {
#pragma unroll
                        for (int j = 0; j < 4; ++j) { const float a = fmaxf(v0[j], 0.f), b = fmaxf(v1[j], 0.f); v0[j] = a * a; v1[j] = b * b; } }
                    u32x4 w; w.x = cvt_pk_bf16(v0[0], v0[1]); w.y = cvt_pk_bf16(v0[2], v0[3]); w.z = cvt_pk_bf16(v1[0], v1[1]); w.w = cvt_pk_bf16(v1[2], v1[3]);
                    *(u32x4*)(rowp + bj * HALF) = w; } }
    }
};
struct EpiResid {
    static constexpr bool PERM = false, AFTER_DRAIN = false;
    const float* Xin; float* X; int ldc; const float* gate; int gate_stride;
    __device__ __forceinline__ void operator()(const f32x4 (&acc)[2][2][4][2], const Unit& u, int wr, int wc, int fr, int fq) const {
        const int row0 = u.pm * BM + wr * 64 + fr, col0 = u.pn * BM + wc * 32 + 4 * fq;
        const float* g = gate + (size_t)(u.pm < 64 ? (u.pm >> 4) : 4) * gate_stride;
        f32x4 gv[2][2];
#pragma unroll
        for (int bj = 0; bj < 2; ++bj)
#pragma unroll
            for (int n = 0; n < 2; ++n) gv[bj][n] = *(const f32x4*)(g + col0 + bj * HALF + n * 16);
#pragma unroll
        for (int ai = 0; ai < 2; ++ai)
#pragma unroll
            for (int m = 0; m < 4; ++m) { const size_t off = (size_t)(row0 + ai * HALF + m * 16) * ldc + col0; const float* rin = Xin + off; float* rowp = X + off;
#pragma unroll
                for (int bj = 0; bj < 2; ++bj)
#pragma unroll
                    for (int n = 0; n < 2; ++n) { const f32x4 xo = *(const f32x4*)(rin + bj * HALF + n * 16); *(f32x4*)(rowp + bj * HALF + n * 16) = xo + gv[bj][n] * acc[ai][bj][m][n]; } }
    }
};

struct EpiUV {
    static constexpr bool PERM = true, AFTER_DRAIN = false;
    bf16_t* UV2;
    __device__ __forceinline__ void operator()(const f32x4 (&acc)[2][2][4][2], const Unit& u, int wr, int wc, int fr, int fq) const {
        const int s = u.koff >> 11, vpart = u.pm >> 3, i0 = (u.pm & 7) * BM + wr * 64 + fr, cc = wc * 32 + 8 * fq;
#pragma unroll
        for (int ai = 0; ai < 2; ++ai)
#pragma unroll
            for (int m = 0; m < 4; ++m) { const int idx = i0 + ai * HALF + m * 16;
#pragma unroll
                for (int bj = 0; bj < 2; ++bj) { const int bg = 2 * u.pn + bj; const f32x4 v0 = acc[ai][bj][m][0], v1 = acc[ai][bj][m][1];
                    u32x4 w; w.x = cvt_pk_bf16(v0[0], v0[1]); w.y = cvt_pk_bf16(v0[2], v0[3]); w.z = cvt_pk_bf16(v1[0], v1[1]); w.w = cvt_pk_bf16(v1[2], v1[3]);
                    bf16_t* colp = UV2 + (size_t)bg * 512 + s * 256 + cc;
                    if (vpart == 0) { *(u32x4*)(colp + (size_t)idx * 8192) = w; if (idx > 0) *(u32x4*)(colp + (size_t)(4096 - idx) * 8192) = w; }
                    else if (idx == 0) { const u32x4 z = {0u, 0u, 0u, 0u}; *(u32x4*)(colp + (size_t)2048 * 8192) = w; *(u32x4*)(colp + (size_t)2048 * 8192 + 128) = z; *(u32x4*)(colp + 128) = z; }
                    else { const u32x4 wn = w ^ (u32x4){0x80008000u, 0x80008000u, 0x80008000u, 0x80008000u}; *(u32x4*)(colp + (size_t)idx * 8192 + 128) = w; *(u32x4*)(colp + (size_t)(4096 - idx) * 8192 + 128) = wn; } } }
    }
};
struct EpiIn {
    static constexpr bool PERM = true, AFTER_DRAIN = false;
    bf16_t* O; int ldc; const float* rope; bf16_t* FT;
    __device__ __forceinline__ void operator()(const f32x4 (&acc)[2][2][4][2], const Unit& u, int wr, int wc, int fr, int fq) const {
        const int row0 = u.pm * BM + wr * 64 + fr; const int col0 = u.pn * BM + wc * 32 + 8 * fq;
        const int kind = (rope != nullptr && u.pm < 64) ? (u.pn < 12 ? 1 : (u.pn >= 18 ? 2 : 0)) : 0;
        if (kind == 0) {
#pragma unroll
            for (int ai = 0; ai < 2; ++ai)
#pragma unroll
                for (int m = 0; m < 4; ++m) { bf16_t* rowp = O + (size_t)(row0 + ai * HALF + m * 16) * ldc + col0;
#pragma unroll
                    for (int bj = 0; bj < 2; ++bj) { const f32x4 v0 = acc[ai][bj][m][0], v1 = acc[ai][bj][m][1];
                        u32x4 w; w.x = cvt_pk_bf16(v0[0], v0[1]); w.y = cvt_pk_bf16(v0[2], v0[3]); w.z = cvt_pk_bf16(v1[0], v1[1]); w.w = cvt_pk_bf16(v1[2], v1[3]);
                        *(u32x4*)(rowp + bj * HALF) = w; } }
        } else if (kind == 1) {
            const bool second = (fq & 2) != 0, upper = (fq & 2) != 0;
            const int ioff = 8 * (fq & 1);
#pragma unroll
            for (int ai = 0; ai < 2; ++ai)
#pragma unroll
                for (int m = 0; m < 4; ++m) { const int row = row0 + ai * HALF + m * 16, n = row & 4095, pos = (wc & 1) ? (n & 63) : (n >> 6);
                    const f32x4* tp = (const f32x4*)(rope + (size_t)(pos * 16 + ioff) * 2); const f32x4 t0 = tp[0], t1 = tp[1], t2 = tp[2], t3 = tp[3];
                    const float cs[8] = {t0[0], t0[2], t1[0], t1[2], t2[0], t2[2], t3[0], t3[2]}; const float sn[8] = {t0[1], t0[3], t1[1], t1[3], t2[1], t2[3], t3[1], t3[3]};
                    bf16_t* rowp = O + (size_t)row * ldc + col0;
#pragma unroll
                    for (int bj = 0; bj < 2; ++bj) { float v[8], o[8];
#pragma unroll
                        for (int j = 0; j < 4; ++j) { v[j] = acc[ai][bj][m][0][j]; v[4 + j] = acc[ai][bj][m][1][j]; }
#pragma unroll
                        for (int j = 0; j < 8; ++j) { const auto rr = __builtin_amdgcn_permlane32_swap(__builtin_bit_cast(unsigned, v[j]), __builtin_bit_cast(unsigned, v[j]), false, false);
                            const float pv = __builtin_bit_cast(float, upper ? rr[0] : rr[1]);
                            o[j] = second ? fmaf(pv, sn[j], v[j] * cs[j]) : fmaf(-pv, sn[j], v[j] * cs[j]); }
                        u32x4 w; w.x = cvt_pk_bf16(o[0], o[1]); w.y = cvt_pk_bf16(o[2], o[3]); w.z = cvt_pk_bf16(o[4], o[5]); w.w = cvt_pk_bf16(o[6], o[7]);
                        *(u32x4*)(rowp + bj * HALF) = w; } }
        } else {
#pragma unroll
            for (int ai = 0; ai < 2; ++ai)
#pragma unroll
                for (int m = 0; m < 4; ++m) { const int row = row0 + ai * HALF + m * 16, n = row & 4095, b = row >> 12;
#pragma unroll
                    for (int bj = 0; bj < 2; ++bj) { bf16_t* fp = FT + ((size_t)(b * 512 + (col0 - 4608) + bj * HALF)) * 4096 + n; const f32x4 v0 = acc[ai][bj][m][0], v1 = acc[ai][bj][m][1];
                        const unsigned w0 = cvt_pk_bf16(v0[0], v0[1]), w1 = cvt_pk_bf16(v0[2], v0[3]), w2 = cvt_pk_bf16(v1[0], v1[1]), w3 = cvt_pk_bf16(v1[2], v1[3]);
                        fp[0] = (bf16_t)w0; fp[4096] = (bf16_t)(w0 >> 16); fp[2 * 4096] = (bf16_t)w1; fp[3 * 4096] = (bf16_t)(w1 >> 16);
                        fp[4 * 4096] = (bf16_t)w2; fp[5 * 4096] = (bf16_t)(w2 >> 16); fp[6 * 4096] = (bf16_t)w3; fp[7 * 4096] = (bf16_t)(w3 >> 16); } }
        }
    }
};
struct EpiChan {
    static constexpr bool PERM = true, AFTER_DRAIN = false;
    bf16_t* MIX; float scale_lat, scale_ctx;
    __device__ __forceinline__ void operator()(const f32x4 (&acc)[2][2][4][2], const Unit& u, int wr, int wc, int fr, int fq) const {
        const bool lat = u.pm < 256; const float scale = lat ? scale_lat : scale_ctx;
        const int b = fr >> 2, g = fr & 3, kq0 = (lat ? u.pm : u.pm - 256) * 16 + wr * 4, j0 = wc * 32 + 8 * fq;
        const size_t rbase = lat ? (size_t)b * 4096 : (size_t)16384 + b * 256;
#pragma unroll
        for (int ai = 0; ai < 2; ++ai)
#pragma unroll
            for (int m = 0; m < 4; ++m) { const int k = kq0 + ai * 8 + m; const f32x4 v0 = acc[ai][0][m][0] * scale, v1 = acc[ai][0][m][1] * scale;
                u32x4 w; w.x = cvt_pk_bf16(v0[0], v0[1]); w.y = cvt_pk_bf16(v0[2], v0[3]); w.z = cvt_pk_bf16(v1[0], v1[1]); w.w = cvt_pk_bf16(v1[2], v1[3]);
                *(u32x4*)(MIX + (rbase + k) * 2048 + 1536 + g * 128 + j0) = w; }
    }
};

struct EpiPart {
    static constexpr bool PERM = false, AFTER_DRAIN = false;
    bf16_t* PART; int ldc; const float* gate; int kslice;
    __device__ __forceinline__ void operator()(const f32x4 (&acc)[2][2][4][2], const Unit& u, int wr, int wc, int fr, int fq) const {
        const int row0 = u.pm * BM + wr * 64 + fr, col0 = u.pn * BM + wc * 32 + 4 * fq; bf16_t* base = PART + (size_t)(u.koff / kslice) * 1024 * ldc;
        f32x4 gv[2][2];
#pragma unroll
        for (int bj = 0; bj < 2; ++bj)
#pragma unroll
            for (int n = 0; n < 2; ++n) gv[bj][n] = *(const f32x4*)(gate + col0 + bj * HALF + n * 16);
#pragma unroll
        for (int ai = 0; ai < 2; ++ai)
#pragma unroll
            for (int m = 0; m < 4; ++m) { bf16_t* rowp = base + (size_t)(row0 + ai * HALF + m * 16) * ldc + col0;
#pragma unroll
                for (int bj = 0; bj < 2; ++bj)
#pragma unroll
                    for (int n = 0; n < 2; ++n) { const f32x4 v = gv[bj][n] * acc[ai][bj][m][n]; typedef unsigned u32x2 __attribute__((ext_vector_type(2)));
                        u32x2 w; w.x = cvt_pk_bf16(v[0], v[1]); w.y = cvt_pk_bf16(v[2], v[3]); *(u32x2*)(rowp + bj * HALF + n * 16) = w; } }
    }
};

struct EpiResidPart {
    static constexpr bool PERM = true, AFTER_DRAIN = false;
    const float* Xin32; bf16_t* XL; int ldc; const float* gate; int gate_stride; bf16_t* PART; int kslice;
    __device__ __forceinline__ void operator()(const f32x4 (&acc)[2][2][4][2], const Unit& u, int wr, int wc, int fr, int fq) const {
        const int col0 = u.pn * BM + wc * 32 + 8 * fq; const bool lat = u.pm < 64;
        const float* g = gate + (size_t)(lat ? (u.pm >> 4) : 4) * gate_stride;
        f32x4 gv[2][2];
#pragma unroll
        for (int bj = 0; bj < 2; ++bj)
#pragma unroll
            for (int n = 0; n < 2; ++n) gv[bj][n] = *(const f32x4*)(g + col0 + bj * HALF + n * 4);
        if (lat) {
            const int row0 = u.pm * BM + wr * 64 + fr;
#pragma unroll
            for (int ai = 0; ai < 2; ++ai)
#pragma unroll
                for (int m = 0; m < 4; ++m) { const size_t off = (size_t)(row0 + ai * HALF + m * 16) * ldc + col0;
#pragma unroll
                    for (int bj = 0; bj < 2; ++bj) { f32x4 x0, x1;
                        if (Xin32 != nullptr) { x0 = *(const f32x4*)(Xin32 + off + bj * HALF); x1 = *(const f32x4*)(Xin32 + off + bj * HALF + 4); }
                        else { const u32x4 xw = *(const u32x4*)(XL + off + bj * HALF);
                            x0 = (f32x4){__builtin_bit_cast(float, xw.x << 16), __builtin_bit_cast(float, xw.x & 0xffff0000u), __builtin_bit_cast(float, xw.y << 16), __builtin_bit_cast(float, xw.y & 0xffff0000u)};
                            x1 = (f32x4){__builtin_bit_cast(float, xw.z << 16), __builtin_bit_cast(float, xw.z & 0xffff0000u), __builtin_bit_cast(float, xw.w << 16), __builtin_bit_cast(float, xw.w & 0xffff0000u)}; }
                        const f32x4 v0 = x0 + gv[bj][0] * acc[ai][bj][m][0], v1 = x1 + gv[bj][1] * acc[ai][bj][m][1];
                        u32x4 w; w.x = cvt_pk_bf16(v0[0], v0[1]); w.y = cvt_pk_bf16(v0[2], v0[3]); w.z = cvt_pk_bf16(v1[0], v1[1]); w.w = cvt_pk_bf16(v1[2], v1[3]);
                        *(u32x4*)(XL + off + bj * HALF) = w; } }
        } else {
            const int row0 = (u.pm - 64) * BM + wr * 64 + fr; bf16_t* base = PART + (size_t)(u.koff / kslice) * 1024 * ldc;
#pragma unroll
            for (int ai = 0; ai < 2; ++ai)
#pragma unroll
                for (int m = 0; m < 4; ++m) { bf16_t* rowp = base + (size_t)(row0 + ai * HALF + m * 16) * ldc + col0;
#pragma unroll
                    for (int bj = 0; bj < 2; ++bj) { const f32x4 v0 = gv[bj][0] * acc[ai][bj][m][0], v1 = gv[bj][1] * acc[ai][bj][m][1];
                        u32x4 w; w.x = cvt_pk_bf16(v0[0], v0[1]); w.y = cvt_pk_bf16(v0[2], v0[3]); w.z = cvt_pk_bf16(v1[0], v1[1]); w.w = cvt_pk_bf16(v1[2], v1[3]);
                        *(u32x4*)(rowp + bj * HALF) = w; } }
        }
    }
};

template <class Epi, class Sched, bool ALIGN_EPI = false, bool SP2 = false>
__device__ __forceinline__ void gemm_phase(PG8_LAS unsigned char* lds, const Gemm g, const Sched& S, const Epi& E, const int tid) {
    const int wid = __builtin_amdgcn_readfirstlane(tid >> 6), lane = tid & 63, wr = wid >> 2, wc = wid & 3, fr = lane & 15, fq = lane >> 4;
    const int K = g.ldk, ntd = g.K / BK;
    unsigned voffA[2], voffB[2];
#pragma unroll
    for (int i = 0; i < 2; ++i) { int R, C; stage_rc(tid * 16 + i * 8192, R, C); const int Rb = Epi::PERM ? ((R & ~31) + perm32(R & 31)) : R;
        voffA[i] = (unsigned)(R * K + C) * 2u; voffB[i] = (unsigned)(Rb * K + C) * 2u; }
    const size_t kstep = (size_t)(BK * 2);
    const size_t hstep = (size_t)HALF * K * 2;
    const size_t tstep = 2 * hstep;
    const unsigned ldsw = (unsigned)wid * 1024u;
    const int aoff = lds_byte(wr * 64 + fr, fq * 8), boff = lds_byte(wc * 32 + fr, fq * 8);
#define PG8_SA(b, h) (((b) * 2 + (h)) * HTB)
#define PG8_SB(b, h) ((4 + (b) * 2 + (h)) * HTB)
#define PG8_STAGE(bufoff, gbase, voff) do { _Pragma("unroll") for (int _i = 0; _i < 2; ++_i) \
        __builtin_amdgcn_global_load_lds((const unsigned*)((const char*)(gbase) + (voff)[_i]), (PG8_LAS unsigned*)(lds + (bufoff) + ldsw + _i * 8192), 16, 0, 0); } while (0)
#define PG8_LDA(dst, b, h) do { _Pragma("unroll") for (int m = 0; m < 4; ++m) _Pragma("unroll") for (int k = 0; k < 2; ++k) dst[m][k] = *(const PG8_LAS bf16x8*)(lds + PG8_SA(b, h) + aoff + m * 2048 + k * 1024); } while (0)
#define PG8_LDB(dst, b, h) do { _Pragma("unroll") for (int n = 0; n < 2; ++n) _Pragma("unroll") for (int k = 0; k < 2; ++k) dst[n][k] = *(const PG8_LAS bf16x8*)(lds + PG8_SB(b, h) + boff + n * 2048 + k * 1024); } while (0)
#define PG8_MMA(ai, bj, At, Bt) do { __builtin_amdgcn_s_setprio(1); _Pragma("unroll") for (int m = 0; m < 4; ++m) _Pragma("unroll") for (int n = 0; n < 2; ++n) _Pragma("unroll") for (int k = 0; k < 2; ++k) \
        acc[ai][bj][m][n] = __builtin_amdgcn_mfma_f32_16x16x32_bf16(Bt[n][k], At[m][k], acc[ai][bj][m][n], 0, 0, 0); __builtin_amdgcn_s_setprio(0); } while (0)
#define PG8_WAIT_V(n) asm volatile("s_waitcnt vmcnt(" #n ")" ::: "memory")
#define PG8_WAIT_L(n) asm volatile("s_waitcnt lgkmcnt(" #n ")" ::: "memory")
#define PG8_BAR __builtin_amdgcn_s_barrier()
#define PG8_SCHED __builtin_amdgcn_sched_barrier(0)
    Unit cur, nxt; int ui = 0;
    if (!S.next(0, cur)) return;
    int nt = cur.nt ? cur.nt : ntd;
    f32x4 acc[2][2][4][2];
#pragma unroll
    for (int a = 0; a < 2; ++a)
#pragma unroll
        for (int b = 0; b < 2; ++b)
#pragma unroll
            for (int m = 0; m < 4; ++m)
#pragma unroll
                for (int n = 0; n < 2; ++n) acc[a][b][m][n] = (f32x4){0.f, 0.f, 0.f, 0.f};
    bf16x8 At[4][2], B0[2][2], B1[2][2];
    const char* cA = (const char*)g.A + (size_t)cur.pm * tstep + (size_t)cur.koff * 2; const char* cB = (const char*)g.Bt + (size_t)cur.pn * tstep + (size_t)cur.koff * 2;
    S.a_ready(cur);
    if constexpr (SP2) {
        PG8_STAGE(PG8_SB(0, 0), cB, voffB); PG8_STAGE(PG8_SB(0, 1), cB + hstep, voffB); PG8_STAGE(PG8_SA(0, 0), cA, voffA); PG8_STAGE(PG8_SA(0, 1), cA + hstep, voffA);
        if (wr == 1) PG8_BAR;
        PG8_WAIT_V(2); PG8_BAR;
        PG8_STAGE(PG8_SB(1, 0), cB + kstep, voffB); PG8_STAGE(PG8_SA(1, 0), cA + kstep, voffA); PG8_STAGE(PG8_SB(1, 1), cB + hstep + kstep, voffB);
        PG8_WAIT_V(6); PG8_BAR;
    } else {
        PG8_STAGE(PG8_SB(0, 0), cB, voffB); PG8_STAGE(PG8_SA(0, 0), cA, voffA); PG8_STAGE(PG8_SB(0, 1), cB + hstep, voffB); PG8_STAGE(PG8_SA(0, 1), cA + hstep, voffA);
        if (wr == 1) PG8_BAR;
        PG8_WAIT_V(4); PG8_BAR;
        PG8_STAGE(PG8_SB(1, 0), cB + kstep, voffB); PG8_STAGE(PG8_SA(1, 0), cA + kstep, voffA); PG8_STAGE(PG8_SB(1, 1), cB + hstep + kstep, voffB);
        PG8_WAIT_V(6); PG8_BAR;
    }
    for (;;) {
        const bool has_next = S.next(ui + 1, nxt);
        const char* nA = has_next ? (const char*)g.A + (size_t)nxt.pm * tstep + (size_t)nxt.koff * 2 : cA; const char* nB = has_next ? (const char*)g.Bt + (size_t)nxt.pn * tstep + (size_t)nxt.koff * 2 : cB;
        for (int t = 0; t < nt; t += 2) {
            const bool last = (t == nt - 2);
            const char* a1 = cA + (size_t)(t + 1) * kstep;
            const char* a2 = last ? nA : cA + (size_t)(t + 2) * kstep; const char* b2 = last ? nB : cB + (size_t)(t + 2) * kstep;
            const char* a3 = a2 + kstep; const char* b3 = b2 + kstep;
            if (last && has_next) S.a_ready(nxt);
            if constexpr (SP2) {
            PG8_LDB(B0, 0, 0); PG8_LDB(B1, 0, 1); PG8_SCHED; PG8_LDA(At, 0, 0); PG8_STAGE(PG8_SA(1, 1), a1 + hstep, voffA);
            PG8_WAIT_V(8); PG8_WAIT_L(0); PG8_BAR; PG8_MMA(0, 0, At, B0); PG8_MMA(0, 1, At, B1); PG8_BAR; PG8_SCHED;
            PG8_LDA(At, 0, 1); PG8_STAGE(PG8_SB(0, 0), b2, voffB); PG8_STAGE(PG8_SB(0, 1), b2 + hstep, voffB); PG8_STAGE(PG8_SA(0, 0), a2, voffA);
            PG8_WAIT_V(8); PG8_WAIT_L(0); PG8_BAR; PG8_MMA(1, 0, At, B0); PG8_MMA(1, 1, At, B1); PG8_BAR; PG8_SCHED;
            PG8_LDB(B0, 1, 0); PG8_LDB(B1, 1, 1); PG8_SCHED; PG8_LDA(At, 1, 0); PG8_STAGE(PG8_SA(0, 1), a2 + hstep, voffA);
            PG8_WAIT_V(8); PG8_WAIT_L(0); PG8_BAR; PG8_MMA(0, 0, At, B0); PG8_MMA(0, 1, At, B1); PG8_BAR; PG8_SCHED;
            PG8_LDA(At, 1, 1); PG8_STAGE(PG8_SB(1, 0), b3, voffB); PG8_STAGE(PG8_SB(1, 1), b3 + hstep, voffB); PG8_STAGE(PG8_SA(1, 0), a3, voffA);
            PG8_WAIT_V(8); PG8_WAIT_L(0); PG8_BAR; PG8_MMA(1, 0, At, B0); PG8_MMA(1, 1, At, B1); PG8_BAR; PG8_SCHED;
            } else {
            PG8_LDB(B0, 0, 0); PG8_SCHED; PG8_LDA(At, 0, 0); PG8_STAGE(PG8_SA(1, 1), a1 + hstep, voffA);
            PG8_WAIT_L(8); PG8_BAR; PG8_WAIT_L(0); PG8_MMA(0, 0, At, B0); PG8_BAR; PG8_SCHED;
            PG8_LDB(B1, 0, 1); PG8_STAGE(PG8_SB(0, 0), b2, voffB);
            PG8_BAR; PG8_WAIT_L(0); PG8_MMA(0, 1, At, B1); PG8_BAR;
            PG8_LDA(At, 0, 1); PG8_STAGE(PG8_SA(0, 0), a2, voffA);
            PG8_BAR; PG8_WAIT_L(0); PG8_MMA(1, 0, At, B0); PG8_BAR; PG8_SCHED;
            PG8_STAGE(PG8_SB(0, 1), b2 + hstep, voffB);
            PG8_WAIT_V(6); PG8_BAR; PG8_MMA(1, 1, At, B1); PG8_BAR;
            PG8_LDB(B0, 1, 0); PG8_SCHED; PG8_LDA(At, 1, 0); PG8_STAGE(PG8_SA(0, 1), a2 + hstep, voffA);
            PG8_WAIT_L(8); PG8_BAR; PG8_WAIT_L(0); PG8_MMA(0, 0, At, B0); PG8_BAR; PG8_SCHED;
            PG8_LDB(B1, 1, 1); PG8_STAGE(PG8_SB(1, 0), b3, voffB);
            PG8_BAR; PG8_WAIT_L(0); PG8_MMA(0, 1, At, B1); PG8_BAR;
            PG8_LDA(At, 1, 1); PG8_STAGE(PG8_SA(1, 0), a3, voffA);
            PG8_BAR; PG8_WAIT_L(0); PG8_MMA(1, 0, At, B0); PG8_BAR; PG8_SCHED;
            PG8_STAGE(PG8_SB(1, 1), b3 + hstep, voffB);
            PG8_WAIT_V(6); PG8_BAR; PG8_MMA(1, 1, At, B1); PG8_BAR;
            }
        }
        if constexpr (ALIGN_EPI) { if (wr == 0) PG8_BAR; }
        if constexpr (!Epi::AFTER_DRAIN) { E(acc, cur, wr, wc, fr, fq); S.done(cur); }
        if (!has_next) break;
#pragma unroll
        for (int a = 0; a < 2; ++a)
#pragma unroll
            for (int b = 0; b < 2; ++b)
#pragma unroll
                for (int m = 0; m < 4; ++m)
#pragma unroll
                    for (int n = 0; n < 2; ++n) acc[a][b][m][n] = (f32x4){0.f, 0.f, 0.f, 0.f};
        cur = nxt; cA = nA; cB = nB; ++ui; nt = cur.nt ? cur.nt : ntd;
        if constexpr (ALIGN_EPI) { if (wr == 1) PG8_BAR; }
    }
    PG8_WAIT_V(0);
    if constexpr (!ALIGN_EPI) { if (wr == 0) PG8_BAR; }
    PG8_BAR;
    if constexpr (Epi::AFTER_DRAIN) { E.fused(acc, cur, wr, wc, fr, fq, lds, wid, lane); S.done(cur); }
#undef PG8_SA
#undef PG8_SB
#undef PG8_STAGE
#undef PG8_LDA
#undef PG8_LDB
#undef PG8_MMA
#undef PG8_WAIT_V
#undef PG8_WAIT_L
#undef PG8_BAR
#undef PG8_SCHED
}
}

constexpr int NWAVES = 8;
#ifndef MK_ONE_LAUNCH
#define MK_ONE_LAUNCH 1
#endif

constexpr int DM = 2048, NB = 4, SEQ = 4096, DEPTH = 4, NCTX = 256, INW = 5120, DFF = 8192, ADA = 6 * DM;
constexpr int MLAT = NB * SEQ, MCTX = NB * NCTX, MALL = MLAT + MCTX;
constexpr float LAM_INIT1 = 0.35550906759096926f, LAM_INIT3 = 0.5560582041556405f;

constexpr size_t MiB = 1u << 20;
constexpr size_t WS_CTL = 0, CTL_ZERO_BYTES = 1 * MiB;
constexpr size_t WS_MOD = 1 * MiB;
constexpr size_t WS_LAM = 2 * MiB;
constexpr size_t WS_ADAP = 1353 * MiB;
constexpr size_t WS_WIN = 16 * MiB, WS_WOUT = 96 * MiB, WS_W1 = 128 * MiB, WS_W2 = 256 * MiB;
constexpr size_t WS_X = 384 * MiB;
constexpr size_t WS_H = 520 * MiB;
constexpr size_t WS_P = 588 * MiB;
constexpr size_t WS_MIX = 758 * MiB;
constexpr size_t WS_HID = 826 * MiB;
constexpr size_t WS_VN = 826 * MiB;
constexpr size_t WS_O12 = 826 * MiB;
constexpr size_t WS_FA = 1030 * MiB, WS_FB = 1064 * MiB;
constexpr size_t WS_CS = 1098 * MiB;
constexpr size_t WS_CT = 1162 * MiB;
constexpr size_t WS_FT = 1163 * MiB;
constexpr size_t WS_UV = 1281 * MiB;
constexpr size_t WS_SGW = 1214 * MiB;
constexpr size_t WS_ROPE = 1215 * MiB;
constexpr size_t WS_PART = 1217 * MiB;
constexpr size_t WS_STAMP = 1216 * MiB;
constexpr size_t WS_XL = 1385 * MiB;
constexpr size_t WS_END = 1449 * MiB;
constexpr int CW_BAR = 4096;

constexpr int RING_OFF = 0, RING_BYTES = 131072;
constexpr int LDSCTL_OFF = RING_BYTES, MISC_OFF = LDSCTL_OFF + 320;
constexpr int LDS_BYTES = 147456;

#define GAS __attribute__((address_space(1)))
#define LAS __attribute__((address_space(3)))
typedef unsigned short bf16;
typedef unsigned v4u __attribute__((ext_vector_type(4)));
typedef unsigned v2u __attribute__((ext_vector_type(2)));
typedef float f32x4 __attribute__((ext_vector_type(4)));
typedef float f32x2 __attribute__((ext_vector_type(2)));
#define LDS_WAIT() asm volatile("s_waitcnt lgkmcnt(0)" ::: "memory")
__device__ __forceinline__ unsigned f2bf(float f) { unsigned u = __builtin_bit_cast(unsigned, f); return (u + 0x7fffu + ((u >> 16) & 1u)) >> 16; }
__device__ __forceinline__ unsigned pk2(float lo, float hi) { return f2bf(lo) | (f2bf(hi) << 16); }
__device__ __forceinline__ float bf2f(bf16 v) { return __builtin_bit_cast(float, (unsigned)v << 16); }
__device__ __forceinline__ float bflo(unsigned w) { return __builtin_bit_cast(float, w << 16); }
__device__ __forceinline__ float bfhi(unsigned w) { return __builtin_bit_cast(float, w & 0xffff0000u); }
template <int M> __device__ __forceinline__ float shx(float v) { return __builtin_bit_cast(float, __builtin_amdgcn_ds_swizzle(__builtin_bit_cast(int, v), (M << 10) | 0x1f)); }
__device__ __forceinline__ float half_sum(float v) { return __builtin_bit_cast(float, __builtin_amdgcn_readlane(__builtin_bit_cast(int, v), 0)) + __builtin_bit_cast(float, __builtin_amdgcn_readlane(__builtin_bit_cast(int, v), 32)); }
#define XB_TMO      128
#define XB_XCNT(j)  (256  + 64 * (j))
#define XB_XSUB(j)  (1280 + 64 * (j))
#define XB_XGEN(j)  (2304 + 64 * (j))
#define XB_TOP      3328
#define XB_TOPGEN   3392
#define XCD_BAR_WORDS 3456
#define XB_SPIN_CAP (1u << 20)

__device__ __forceinline__ unsigned xb_ld(unsigned* p)              { return __hip_atomic_load(p, __ATOMIC_RELAXED, __HIP_MEMORY_SCOPE_AGENT); }
__device__ __forceinline__ unsigned xb_add(unsigned* p, unsigned v) { return __hip_atomic_fetch_add(p, v, __ATOMIC_RELAXED, __HIP_MEMORY_SCOPE_AGENT); }
__device__ __forceinline__ unsigned xb_xcc_id() { return (unsigned)__builtin_amdgcn_s_getreg((3 << 11) | 20) & 0xFu; }
#define XB_SPIN(cond, bar) do { unsigned _sp = 0; while (cond) { __builtin_amdgcn_s_sleep(1); \
    if ((++_sp & 255u) == 0u) { if (xb_ld(&(bar)[XB_TMO])) break; if (_sp > XB_SPIN_CAP) { atomicAdd(&(bar)[XB_TMO], 1u); break; } } } } while (0)

struct XcdBarrier {
    unsigned* bar; unsigned x;
    volatile LAS unsigned* st;
};

__device__ __forceinline__ XcdBarrier xcd_barrier_post(unsigned* bar, volatile LAS unsigned* st) {
    XcdBarrier b; b.bar = bar; b.x = xb_xcc_id(); b.st = st;
    if (threadIdx.x == 0) (void)xb_add(&bar[XB_XCNT(b.x)], 1u);
    return b;
}
__device__ __forceinline__ void xcd_barrier_complete(unsigned* bar, unsigned x, unsigned& nloc, unsigned& nx) {
    const unsigned G = gridDim.x * gridDim.y * gridDim.z;
    unsigned sum, cnt, mine, sp = 0u;
    for (;;) {
        sum = 0u; cnt = 0u; mine = 0u;
#pragma unroll
        for (unsigned j = 0; j < 16; ++j) { const unsigned c = xb_ld(&bar[XB_XCNT(j)]); sum += c; cnt += (c > 0u) ? 1u : 0u; mine = (j == x) ? c : mine; }
        if (sum == G) break;
        __builtin_amdgcn_s_sleep(1);
        if ((++sp & 255u) == 0u) { if (xb_ld(&bar[XB_TMO])) break; if (sp > XB_SPIN_CAP) { atomicAdd(&bar[XB_TMO], 1u); break; } }
    }
    nloc = mine > 0u ? mine : 1u; nx = cnt > 0u ? cnt : 1u;
}

__device__ __forceinline__ void xcd_barrier(const XcdBarrier& b) {
    asm volatile("s_waitcnt vmcnt(0)" ::: "memory");
    __syncthreads();
    if (threadIdx.x == 0) {
        unsigned* bar = b.bar;
        __builtin_amdgcn_s_waitcnt(0);
        unsigned nloc = b.st[0], nx = b.st[1];
        if (nloc == 0u) { xcd_barrier_complete(bar, b.x, nloc, nx); b.st[0] = nloc; b.st[1] = nx; }
        const unsigned old = xb_add(&bar[XB_XSUB(b.x)], 1u);
        const unsigned gen = old / nloc;
        if (old + 1u == (gen + 1u) * nloc) {
            __builtin_amdgcn_fence(__ATOMIC_RELEASE, "agent");
            asm volatile("s_waitcnt vmcnt(0)" ::: "memory");
            const unsigned og = xb_add(&bar[XB_TOP], 1u);
            const unsigned tg = og / nx;
            if (og + 1u == (tg + 1u) * nx) xb_add(&bar[XB_TOPGEN], 1u);
            else XB_SPIN(xb_ld(&bar[XB_TOPGEN]) == tg, bar);
            __builtin_amdgcn_fence(__ATOMIC_ACQUIRE, "agent");
            xb_add(&bar[XB_XGEN(b.x)], 1u);
            asm volatile("s_waitcnt vmcnt(0)" ::: "memory");
        } else {
            XB_SPIN(xb_ld(&bar[XB_XGEN(b.x)]) == gen, bar);
            __builtin_amdgcn_fence(__ATOMIC_ACQUIRE, "agent");
            asm volatile("s_waitcnt vmcnt(0)" ::: "memory");
        }
    }
    __syncthreads();
}

__device__ __forceinline__ float wave_sum(float v) {
    v += shx<1>(v); v += shx<2>(v); v += shx<4>(v); v += shx<8>(v); v += shx<16>(v);
    return half_sum(v);
}
__device__ __forceinline__ void p0_transpose_item(const float* W, int K, int N, bf16* WT, LAS float* scr, int item, int lane) {
    const int nblk = N / 32, kb = item / nblk, nb = item % nblk, k0 = 64 * kb, n0 = 32 * nb;
    float wv[32];
#pragma unroll
    for (int i = 0; i < 32; ++i) wv[i] = __builtin_nontemporal_load(W + (size_t)(k0 + 2 * i + (lane >> 5)) * N + n0 + (lane & 31));
#pragma unroll
    for (int i = 0; i < 32; ++i) scr[(2 * i + (lane >> 5)) * 33 + (lane & 31)] = wv[i];
    LDS_WAIT(); asm volatile("" ::: "memory");
    const int c = lane & 7;
#pragma unroll
    for (int j = 0; j < 4; ++j) { const int n = (lane >> 3) + 8 * j; const LAS float* s = scr + (8 * c) * 33 + n;
        v4u o; o.x = pk2(s[0 * 33], s[1 * 33]); o.y = pk2(s[2 * 33], s[3 * 33]); o.z = pk2(s[4 * 33], s[5 * 33]); o.w = pk2(s[6 * 33], s[7 * 33]);
        *(GAS v4u*)(WT + (size_t)(n0 + n) * K + k0 + 8 * c) = o; }
    LDS_WAIT(); asm volatile("" ::: "memory");
}

template <int MODE>
__device__ __forceinline__ void norm_rows(const float* Xlat, const float* Xctx, float* X, bf16* H, float* OUT, const float* gain, const float* modl, int sh_chunk, int R0, int M, int gw, int NGW, int lane, const bf16* part, bool wb_ctx) {
    for (int row0 = R0 + gw; row0 < M; row0 += 2 * NGW) {
        f32x4 v[2][8]; float ss[2];
#pragma unroll
        for (int u = 0; u < 2; ++u) { const int row = row0 + u * NGW; if (row < M) {
            const GAS f32x4* xr = (const GAS f32x4*)(row < MLAT ? Xlat + (size_t)row * DM : Xctx + (size_t)(row - MLAT) * DM) + lane;
#pragma unroll
            for (int j = 0; j < 8; ++j) v[u][j] = xr[64 * j]; } }
#pragma unroll
        for (int u = 0; u < 2; ++u) { const int row = row0 + u * NGW; if (row < M) {
            if (MODE == 0 && row >= MLAT) {
                if (part != nullptr) {
#pragma unroll
                    for (int ks = 0; ks < 8; ++ks) { const GAS v2u* pr = (const GAS v2u*)(part + ((size_t)ks * MCTX + (row - MLAT)) * DM) + lane;
#pragma unroll
                        for (int j = 0; j < 8; ++j) { const v2u w = pr[64 * j]; v[u][j] += (f32x4){bflo(w.x), bfhi(w.x), bflo(w.y), bfhi(w.y)}; } } }
                if (part != nullptr || wb_ctx) { GAS f32x4* xw = (GAS f32x4*)(X + (size_t)row * DM) + lane;
#pragma unroll
                    for (int j = 0; j < 8; ++j) xw[64 * j] = v[u][j]; }
            }
            float s = 0.f;
#pragma unroll
            for (int j = 0; j < 8; ++j) s += (v[u][j].x * v[u][j].x + v[u][j].y * v[u][j].y) + (v[u][j].z * v[u][j].z + v[u][j].w * v[u][j].w);
            ss[u] = s; } else ss[u] = 0.f; }
        ss[0] = wave_sum(ss[0]); ss[1] = wave_sum(ss[1]);
#pragma unroll
        for (int u = 0; u < 2; ++u) { const int row = row0 + u * NGW; if (row < M) {
            const float rstd = 1.0f / sqrtf(ss[u] * (1.0f / DM) + 1e-6f);
            if (MODE == 0) {
                const float* mr = modl + (size_t)(row < MLAT ? (row >> 12) : 4) * ADA;
                const GAS f32x4* sh = (const GAS f32x4*)(mr + sh_chunk * DM) + lane; const GAS f32x4* sc = (const GAS f32x4*)(mr + (sh_chunk + 1) * DM) + lane;
                const GAS f32x4* gg = (const GAS f32x4*)gain + lane;
                GAS v2u* o8 = (GAS v2u*)(H + (size_t)row * DM) + lane;
#pragma unroll
                for (int j = 0; j < 8; ++j) { const f32x4 g4 = gg[64 * j], s4 = sc[64 * j], h4 = sh[64 * j]; const f32x4 y = v[u][j] * rstd * g4 * (s4 + 1.0f) + h4;
                    v2u w; w.x = pk2(y.x, y.y); w.y = pk2(y.z, y.w); o8[64 * j] = w; }
            } else {
                const GAS f32x4* gg = (const GAS f32x4*)gain + lane; GAS f32x4* o = (GAS f32x4*)(OUT + (size_t)row * DM) + lane;
#pragma unroll
                for (int j = 0; j < 8; ++j) o[64 * j] = v[u][j] * rstd * gg[64 * j];
            } } }
    }
}

__device__ __forceinline__ void load_row8(const float* X32, const bf16* XL, size_t rowoff, int lane, f32x4 (&v)[8]) {
    if (X32 != nullptr) { const GAS f32x4* xr = (const GAS f32x4*)(X32 + rowoff) + 2 * lane;
#pragma unroll
        for (int j = 0; j < 4; ++j) { v[2 * j] = xr[128 * j]; v[2 * j + 1] = xr[128 * j + 1]; } }
    else { const GAS v4u* xr = (const GAS v4u*)(XL + rowoff) + lane;
#pragma unroll
        for (int j = 0; j < 4; ++j) { const v4u w = xr[64 * j]; v[2 * j] = (f32x4){bflo(w.x), bfhi(w.x), bflo(w.y), bfhi(w.y)}; v[2 * j + 1] = (f32x4){bflo(w.z), bfhi(w.z), bflo(w.w), bfhi(w.w)}; } }
}
__device__ __forceinline__ void norm_lat_rows(const float* X32, const bf16* XL, bf16* H, const float* gain, const float* modl, int sh_chunk, int w, int NW, int lane) {
    const int b = w & 3, w4 = w >> 2, NW4 = NW >> 2;
    f32x4 gp[8], sh[8];
    { const float* mr = modl + (size_t)b * ADA; const GAS f32x4* shp = (const GAS f32x4*)(mr + sh_chunk * DM) + 2 * lane; const GAS f32x4* scp = (const GAS f32x4*)(mr + (sh_chunk + 1) * DM) + 2 * lane; const GAS f32x4* gg = (const GAS f32x4*)gain + 2 * lane;
#pragma unroll
      for (int j = 0; j < 4; ++j) { gp[2 * j] = gg[128 * j] * (scp[128 * j] + 1.0f); gp[2 * j + 1] = gg[128 * j + 1] * (scp[128 * j + 1] + 1.0f); sh[2 * j] = shp[128 * j]; sh[2 * j + 1] = shp[128 * j + 1]; } }
    for (int r0 = w4; r0 < SEQ; r0 += 2 * NW4) {
        f32x4 v[2][8]; float ss[2] = {0.f, 0.f};
#pragma unroll
        for (int u = 0; u < 2; ++u) { const int r = r0 + u * NW4; if (r < SEQ) load_row8(X32, XL, ((size_t)b * SEQ + r) * DM, lane, v[u]); }
#pragma unroll
        for (int u = 0; u < 2; ++u) { const int r = r0 + u * NW4; if (r < SEQ) { float s = 0.f;
#pragma unroll
            for (int j = 0; j < 8; ++j) s += (v[u][j].x * v[u][j].x + v[u][j].y * v[u][j].y) + (v[u][j].z * v[u][j].z + v[u][j].w * v[u][j].w);
            ss[u] = s; } }
        ss[0] = wave_sum(ss[0]); ss[1] = wave_sum(ss[1]);
#pragma unroll
        for (int u = 0; u < 2; ++u) { const int r = r0 + u * NW4; if (r < SEQ) { const float rstd = 1.0f / sqrtf(ss[u] * (1.0f / DM) + 1e-6f);
            GAS v4u* o16 = (GAS v4u*)(H + ((size_t)b * SEQ + r) * DM) + lane;
#pragma unroll
            for (int j = 0; j < 4; ++j) { const f32x4 y0 = v[u][2 * j] * rstd * gp[2 * j] + sh[2 * j], y1 = v[u][2 * j + 1] * rstd * gp[2 * j + 1] + sh[2 * j + 1];
                v4u wv; wv.x = pk2(y0.x, y0.y); wv.y = pk2(y0.z, y0.w); wv.z = pk2(y1.x, y1.y); wv.w = pk2(y1.z, y1.w); o16[64 * j] = wv; } } }
    }
}
__device__ __forceinline__ void final_norm_rows(const bf16* XL, float* OUT, const float* gain, int gw, int NGW, int lane) {
    f32x4 gg[8];
    { const GAS f32x4* gp = (const GAS f32x4*)gain + 2 * lane;
#pragma unroll
      for (int j = 0; j < 4; ++j) { gg[2 * j] = gp[128 * j]; gg[2 * j + 1] = gp[128 * j + 1]; } }
    for (int row0 = gw; row0 < MLAT; row0 += 2 * NGW) {
        f32x4 v[2][8]; float ss[2] = {0.f, 0.f};
#pragma unroll
        for (int u = 0; u < 2; ++u) { const int row = row0 + u * NGW; if (row < MLAT) load_row8(nullptr, XL, (size_t)row * DM, lane, v[u]); }
#pragma unroll
        for (int u = 0; u < 2; ++u) { const int row = row0 + u * NGW; if (row < MLAT) { float s = 0.f;
#pragma unroll
            for (int j = 0; j < 8; ++j) s += (v[u][j].x * v[u][j].x + v[u][j].y * v[u][j].y) + (v[u][j].z * v[u][j].z + v[u][j].w * v[u][j].w);
            ss[u] = s; } }
        ss[0] = wave_sum(ss[0]); ss[1] = wave_sum(ss[1]);
#pragma unroll
        for (int u = 0; u < 2; ++u) { const int row = row0 + u * NGW; if (row < MLAT) { const float rstd = 1.0f / sqrtf(ss[u] * (1.0f / DM) + 1e-6f);
            GAS f32x4* o = (GAS f32x4*)(OUT + (size_t)row * DM) + 2 * lane;
#pragma unroll
            for (int j = 0; j < 4; ++j) { o[128 * j] = v[u][2 * j] * rstd * gg[2 * j]; o[128 * j + 1] = v[u][2 * j + 1] * rstd * gg[2 * j + 1]; } } }
    }
}

template <int N> __device__ __forceinline__ float dot_bf(const bf16* kp, const float (&q)[N]) {
    float s = 0.f;
#pragma unroll
    for (int c = 0; c < N / 8; ++c) { const v4u w = ((const GAS v4u*)kp)[c];
        s += q[8 * c + 0] * bflo(w.x) + q[8 * c + 1] * bfhi(w.x) + q[8 * c + 2] * bflo(w.y) + q[8 * c + 3] * bfhi(w.y)
           + q[8 * c + 4] * bflo(w.z) + q[8 * c + 5] * bfhi(w.z) + q[8 * c + 6] * bflo(w.w) + q[8 * c + 7] * bfhi(w.w); }
    return s;
}
template <int DQK, int DVS, class KeyF>
__device__ __forceinline__ void naive_attn(const bf16* P, const float (&q)[DQK], int nkeys, const KeyF& keyf, float (&o)[DVS]) {
    float m = -1e30f, l = 0.f;
    for (int i = 0; i < nkeys; ++i) { size_t koff, voff; float bias; keyf(i, koff, voff, bias);
        const float s = dot_bf<DQK>(P + koff, q) + bias; const float mn = fmaxf(m, s); l = l * __expf(m - mn) + __expf(s - mn); m = mn; }
    const float il = 1.0f / l;
#pragma unroll
    for (int j = 0; j < DVS; ++j) o[j] = 0.f;
    for (int i = 0; i < nkeys; ++i) { size_t koff, voff; float bias; keyf(i, koff, voff, bias);
        const float s = dot_bf<DQK>(P + koff, q) + bias; const float p = __expf(s - m) * il;
#pragma unroll
        for (int c = 0; c < DVS / 8; ++c) { const v4u w = ((const GAS v4u*)(P + voff))[c];
            o[8 * c + 0] += p * bflo(w.x); o[8 * c + 1] += p * bfhi(w.x); o[8 * c + 2] += p * bflo(w.y); o[8 * c + 3] += p * bfhi(w.y);
            o[8 * c + 4] += p * bflo(w.z); o[8 * c + 5] += p * bfhi(w.z); o[8 * c + 6] += p * bflo(w.w); o[8 * c + 7] += p * bfhi(w.w); } }
}
template <int N> __device__ __forceinline__ void load_q(const bf16* qp, float scale, float (&q)[N]) {
#pragma unroll
    for (int c = 0; c < N / 8; ++c) { const v4u w = ((const GAS v4u*)qp)[c];
        q[8 * c + 0] = scale * bflo(w.x); q[8 * c + 1] = scale * bfhi(w.x); q[8 * c + 2] = scale * bflo(w.y); q[8 * c + 3] = scale * bfhi(w.y);
        q[8 * c + 4] = scale * bflo(w.z); q[8 * c + 5] = scale * bfhi(w.z); q[8 * c + 6] = scale * bflo(w.w); q[8 * c + 7] = scale * bfhi(w.w); }
}
template <int N> __device__ __forceinline__ void store_bf(bf16* op, const float (&o)[N]) {
#pragma unroll
    for (int c = 0; c < N / 8; ++c) { v4u w; w.x = pk2(o[8 * c], o[8 * c + 1]); w.y = pk2(o[8 * c + 2], o[8 * c + 3]); w.z = pk2(o[8 * c + 4], o[8 * c + 5]); w.w = pk2(o[8 * c + 6], o[8 * c + 7]); ((GAS v4u*)op)[c] = w; }
}

namespace da {
using bf16x8 = __attribute__((ext_vector_type(8))) short;
using s16x4  = __attribute__((ext_vector_type(4))) short;
using f32x16 = __attribute__((ext_vector_type(16))) float;
using u32x4  = __attribute__((ext_vector_type(4))) unsigned;
constexpr int KVBLK = 64;
constexpr int SHM_V = KVBLK * 128 * 2, SHM_K = KVBLK * 128 * 2;
constexpr int LDS_X2 = 0;
constexpr int LDS_WS = 2 * SHM_V + 2 * SHM_K;
constexpr int LDS_OT = LDS_WS + 4096;
constexpr int LDS_WS3 = 3 * SHM_V + 3 * SHM_K, LDS_OT3 = 4 * SHM_V;
constexpr float SCALE = 0.125f;
constexpr float THR = 8.f;
#define DA_KSWZ(row, colB) ((row) * 256 + ((colB) ^ (((row) & 15) << 4)))
#define DA_SBAR() __builtin_amdgcn_sched_barrier(0)
__device__ __forceinline__ int crow(int r, int hi) { return (r & 3) + 8 * (r >> 2) + 4 * hi; }
__device__ __forceinline__ unsigned cvtpk(float lo, float hi) { unsigned r; asm volatile("v_cvt_pk_bf16_f32 %0, %1, %2" : "=v"(r) : "v"(lo), "v"(hi)); return r; }

__device__ __forceinline__ void partialSM(f32x16& p0, f32x16& p1, float& m_reg, float& mn, float& alpha) {
  constexpr float C = SCALE * 1.4426950408889634f;
  float pmax = p0[0];
#pragma unroll
  for (int r = 1; r < 16; ++r) pmax = fmaxf(pmax, p0[r]);
#pragma unroll
  for (int r = 0; r < 16; ++r) pmax = fmaxf(pmax, p1[r]);
  { auto rr = __builtin_amdgcn_permlane32_swap(__float_as_uint(pmax), __float_as_uint(pmax), false, false);
    pmax = fmaxf(__uint_as_float(rr[0]), __uint_as_float(rr[1])); }
  if (__builtin_expect(__all(pmax - m_reg <= THR / SCALE), 1)) { mn = m_reg; alpha = 1.f; }
  else { mn = fmaxf(m_reg, pmax); alpha = __builtin_amdgcn_exp2f((m_reg - mn) * C); m_reg = mn; }
  const float mnC = -mn * C;
#pragma unroll
  for (int r = 0; r < 16; ++r) p0[r] = fmaf(p0[r], C, mnC);
#pragma unroll
  for (int r = 0; r < 16; ++r) p1[r] = fmaf(p1[r], C, mnC);
#pragma unroll
  for (int r = 0; r < 16; ++r) p0[r] = __builtin_amdgcn_exp2f(p0[r]);
}
__device__ __forceinline__ void finishSM(f32x16& p0, f32x16& p1, float alpha, float& l_reg, bf16x8& pa0, bf16x8& pa1, bf16x8& pa2, bf16x8& pa3) {
#pragma unroll
  for (int r = 0; r < 16; ++r) p1[r] = __builtin_amdgcn_exp2f(p1[r]);
  float ps = 0;
#pragma unroll
  for (int r = 0; r < 16; ++r) ps += p0[r];
#pragma unroll
  for (int r = 0; r < 16; ++r) ps += p1[r];
  { auto rr = __builtin_amdgcn_permlane32_swap(__float_as_uint(ps), __float_as_uint(ps), false, false);
    ps = __uint_as_float(rr[0]) + __uint_as_float(rr[1]); }
  l_reg = l_reg * alpha + ps;
#define DA_PK4(P, BASE, OUT) do { unsigned a0 = cvtpk(P[BASE + 0], P[BASE + 1]), a1 = cvtpk(P[BASE + 2], P[BASE + 3]);   \
    unsigned b0 = cvtpk(P[BASE + 4], P[BASE + 5]), b1 = cvtpk(P[BASE + 6], P[BASE + 7]);                              \
    auto r0 = __builtin_amdgcn_permlane32_swap(a0, b0, false, false); auto r1 = __builtin_amdgcn_permlane32_swap(a1, b1, false, false); \
    u32x4 w = {r0[0], r1[0], r0[1], r1[1]}; OUT = *reinterpret_cast<bf16x8*>(&w); } while (0)
  DA_PK4(p0, 0, pa0); DA_PK4(p0, 8, pa1); DA_PK4(p1, 0, pa2); DA_PK4(p1, 8, pa3);
#undef DA_PK4
}
__device__ __forceinline__ void finishSM2(f32x16& p0, f32x16& p1, float alpha, float& l_reg, bf16x8& pa0, bf16x8& pa1, bf16x8& pa2, bf16x8& pa3) {
  float ps = 0;
#pragma unroll
  for (int r = 0; r < 16; ++r) ps += p0[r];
#pragma unroll
  for (int r = 0; r < 16; ++r) ps += p1[r];
  { auto rr = __builtin_amdgcn_permlane32_swap(__float_as_uint(ps), __float_as_uint(ps), false, false);
    ps = __uint_as_float(rr[0]) + __uint_as_float(rr[1]); }
  l_reg = l_reg * alpha + ps;
#define DA_PK4(P, BASE, OUT) do { unsigned a0 = cvtpk(P[BASE + 0], P[BASE + 1]), a1 = cvtpk(P[BASE + 2], P[BASE + 3]);   \
    unsigned b0 = cvtpk(P[BASE + 4], P[BASE + 5]), b1 = cvtpk(P[BASE + 6], P[BASE + 7]);                              \
    auto r0 = __builtin_amdgcn_permlane32_swap(a0, b0, false, false); auto r1 = __builtin_amdgcn_permlane32_swap(a1, b1, false, false); \
    u32x4 w = {r0[0], r1[0], r0[1], r1[1]}; OUT = *reinterpret_cast<bf16x8*>(&w); } while (0)
  DA_PK4(p0, 0, pa0); DA_PK4(p0, 8, pa1); DA_PK4(p1, 0, pa2); DA_PK4(p1, 8, pa3);
#undef DA_PK4
}
__device__ __forceinline__ void qkt(f32x16& p0, f32x16& p1, const LAS char* Ks, const bf16x8 (&qr)[4], int r32, int hi, int mapcolB) {
  p0 = f32x16{}; p1 = f32x16{};
#pragma unroll
  for (int d0 = 0; d0 < 4; ++d0) { const int cb = mapcolB + (d0 * 16 + hi * 8) * 2;
    const bf16x8 b0 = *reinterpret_cast<const LAS bf16x8*>(Ks + DA_KSWZ(r32, cb));
    const bf16x8 b1 = *reinterpret_cast<const LAS bf16x8*>(Ks + DA_KSWZ(32 + r32, cb));
    p0 = __builtin_amdgcn_mfma_f32_32x32x16_bf16(b0, qr[d0], p0, 0, 0, 0);
    p1 = __builtin_amdgcn_mfma_f32_32x32x16_bf16(b1, qr[d0], p1, 0, 0, 0); }
}
__device__ __forceinline__ bf16x8 k_read(int addr) { bf16x8 r; asm volatile("ds_read_b128 %0, %1" : "=&v"(r) : "v"(addr) : "memory"); return r; }
__device__ __forceinline__ bf16x8 k_read_hi(int addr) { bf16x8 r; asm volatile("ds_read_b128 %0, %1 offset:8192" : "=&v"(r) : "v"(addr) : "memory"); return r; }
__device__ __forceinline__ void qkt_pipe(f32x16& p0, f32x16& p1, const LAS char* Ks, const bf16x8 (&qr)[4], int r32, int hi, int mapcolB, const f32x16& seed) {
  const int kb = (int)(uintptr_t)Ks;
  const int a0 = kb + DA_KSWZ(r32, mapcolB + (0 * 16 + hi * 8) * 2), a1 = kb + DA_KSWZ(r32, mapcolB + (1 * 16 + hi * 8) * 2), a2 = kb + DA_KSWZ(r32, mapcolB + (2 * 16 + hi * 8) * 2), a3 = kb + DA_KSWZ(r32, mapcolB + (3 * 16 + hi * 8) * 2);
  bf16x8 k0 = k_read(a0), k1 = k_read_hi(a0), k2 = k_read(a1), k3 = k_read_hi(a1), k4 = k_read(a2), k5 = k_read_hi(a2), k6 = k_read(a3), k7 = k_read_hi(a3);
  asm volatile("s_waitcnt lgkmcnt(6)" : "+v"(k0), "+v"(k1) :: "memory");
  p0 = __builtin_amdgcn_mfma_f32_32x32x16_bf16(k0, qr[0], seed, 0, 0, 0); p1 = __builtin_amdgcn_mfma_f32_32x32x16_bf16(k1, qr[0], seed, 0, 0, 0);
  asm volatile("s_waitcnt lgkmcnt(4)" : "+v"(k2), "+v"(k3) :: "memory");
  p0 = __builtin_amdgcn_mfma_f32_32x32x16_bf16(k2, qr[1], p0, 0, 0, 0); p1 = __builtin_amdgcn_mfma_f32_32x32x16_bf16(k3, qr[1], p1, 0, 0, 0);
  asm volatile("s_waitcnt lgkmcnt(2)" : "+v"(k4), "+v"(k5) :: "memory");
  p0 = __builtin_amdgcn_mfma_f32_32x32x16_bf16(k4, qr[2], p0, 0, 0, 0); p1 = __builtin_amdgcn_mfma_f32_32x32x16_bf16(k5, qr[2], p1, 0, 0, 0);
  asm volatile("s_waitcnt lgkmcnt(0)" : "+v"(k6), "+v"(k7) :: "memory");
  p0 = __builtin_amdgcn_mfma_f32_32x32x16_bf16(k6, qr[3], p0, 0, 0, 0); p1 = __builtin_amdgcn_mfma_f32_32x32x16_bf16(k7, qr[3], p1, 0, 0, 0);
}
__device__ __forceinline__ int v_st(int k, int c) { const int kk = (k & ~0xC) | ((k & 4) << 1) | ((k & 8) >> 1); return ((kk >> 3) * 4 + (c >> 5)) * 512 + ((kk & 7) * 32 + (c & 31)) * 2; }
__device__ __forceinline__ int v_rd_base(int lane) { return ((lane & 3) << 3) | (((lane >> 2) & 3) << 6) | (((lane >> 4) & 1) << 5) | (((lane >> 5) & 1) << 8); }
constexpr int v_rd_off(int d0, int ks, int half) { return d0 * 512 + ks * 4096 + half * 2048; }
template <int OFF> __device__ __forceinline__ s16x4 tr_read(int vb) {
  s16x4 r; asm volatile("ds_read_b64_tr_b16 %0, %1 offset:%2" : "=&v"(r) : "v"(vb), "i"(OFF) : "memory"); return r;
}
template <int D0> __device__ __forceinline__ void pv_one(f32x16& od, int vb, bf16x8 pa0, bf16x8 pa1, bf16x8 pa2, bf16x8 pa3) {
  const s16x4 l0 = tr_read<v_rd_off(D0, 0, 0)>(vb), h0 = tr_read<v_rd_off(D0, 0, 1)>(vb), l1 = tr_read<v_rd_off(D0, 1, 0)>(vb), h1 = tr_read<v_rd_off(D0, 1, 1)>(vb);
  const s16x4 l2 = tr_read<v_rd_off(D0, 2, 0)>(vb), h2 = tr_read<v_rd_off(D0, 2, 1)>(vb), l3 = tr_read<v_rd_off(D0, 3, 0)>(vb), h3 = tr_read<v_rd_off(D0, 3, 1)>(vb);
  asm volatile("s_waitcnt lgkmcnt(0)" ::: "memory"); DA_SBAR();
#define DA_PK(L, H) (bf16x8){L[0], L[1], L[2], L[3], H[0], H[1], H[2], H[3]}
  od = __builtin_amdgcn_mfma_f32_32x32x16_bf16(pa0, DA_PK(l0, h0), od, 0, 0, 0);
  od = __builtin_amdgcn_mfma_f32_32x32x16_bf16(pa1, DA_PK(l1, h1), od, 0, 0, 0);
  od = __builtin_amdgcn_mfma_f32_32x32x16_bf16(pa2, DA_PK(l2, h2), od, 0, 0, 0);
  od = __builtin_amdgcn_mfma_f32_32x32x16_bf16(pa3, DA_PK(l3, h3), od, 0, 0, 0);
#undef DA_PK
}
__device__ __forceinline__ void pv_d0(f32x16 (&o)[4], int vb, bf16x8 pa0, bf16x8 pa1, bf16x8 pa2, bf16x8 pa3) {
  pv_one<0>(o[0], vb, pa0, pa1, pa2, pa3); pv_one<1>(o[1], vb, pa0, pa1, pa2, pa3); pv_one<2>(o[2], vb, pa0, pa1, pa2, pa3); pv_one<3>(o[3], vb, pa0, pa1, pa2, pa3);
}

__device__ __forceinline__ float fma1(float a, float c, float b) { float d; asm("v_fma_f32 %0, %1, %2, %3" : "=v"(d) : "v"(a), "s"(c), "v"(b)); return d; }
template <class MID>
__device__ __forceinline__ void pv_sm(f32x16 (&o)[4], int vb, bf16x8 pa0, bf16x8 pa1, bf16x8 pa2, bf16x8 pa3, f32x16& p0, f32x16& p1, float& m_reg, float& alpha, f32x16& negm, MID&& mid) {
  s16x4 a0, a1, a2, a3, a4, a5, a6, a7, b0, b1, b2, b3, b4, b5, b6, b7; float x, y;
#define DA_TR4(D0, X) X##0 = tr_read<v_rd_off(D0, 0, 0)>(vb); X##1 = tr_read<v_rd_off(D0, 0, 1)>(vb); X##2 = tr_read<v_rd_off(D0, 1, 0)>(vb); X##3 = tr_read<v_rd_off(D0, 1, 1)>(vb); \
    X##4 = tr_read<v_rd_off(D0, 2, 0)>(vb); X##5 = tr_read<v_rd_off(D0, 2, 1)>(vb); X##6 = tr_read<v_rd_off(D0, 3, 0)>(vb); X##7 = tr_read<v_rd_off(D0, 3, 1)>(vb)
#define DA_LW() asm volatile("s_waitcnt lgkmcnt(0)" ::: "memory")
#define DA_PK(L, H) (bf16x8){L[0], L[1], L[2], L[3], H[0], H[1], H[2], H[3]}
#define DA_MF(od, pa, L, H) od = __builtin_amdgcn_mfma_f32_32x32x16_bf16(pa, DA_PK(L, H), od, 0, 0, 0)
#define DA_MX3(v, a, b) v = fmaxf(fmaxf(v, a), b)
#define DA_EX(i) do { float t_ = p0[i]; asm volatile("v_exp_f32 %0, %0" : "+v"(t_)); p0[i] = t_; } while (0)
#define DA_EY(i) do { float t_ = p1[i]; asm volatile("v_exp_f32 %0, %0" : "+v"(t_)); p1[i] = t_; } while (0)
  DA_TR4(0, a); DA_LW(); DA_SBAR();
  DA_TR4(1, b);
  DA_MF(o[0], pa0, a0, a1); x = fmaxf(fmaxf(p0[0], p0[1]), p0[2]); DA_MX3(x, p0[3], p0[4]); DA_MX3(x, p0[5], p0[6]); DA_MX3(x, p0[7], p0[8]); DA_SBAR();
  DA_MF(o[0], pa1, a2, a3); DA_MX3(x, p0[9], p0[10]); DA_MX3(x, p0[11], p0[12]); DA_MX3(x, p0[13], p0[14]); x = fmaxf(x, p0[15]); DA_SBAR();
  DA_MF(o[0], pa2, a4, a5); y = fmaxf(fmaxf(p1[0], p1[1]), p1[2]); DA_MX3(y, p1[3], p1[4]); DA_MX3(y, p1[5], p1[6]); DA_MX3(y, p1[7], p1[8]); DA_SBAR();
  DA_MF(o[0], pa3, a6, a7); DA_MX3(y, p1[9], p1[10]); DA_MX3(y, p1[11], p1[12]); DA_MX3(y, p1[13], p1[14]); DA_MX3(y, p1[15], x); DA_LW(); DA_SBAR();
  DA_TR4(2, a);
  DA_MF(o[1], pa0, b0, b1);
  { auto rr = __builtin_amdgcn_permlane32_swap(__float_as_uint(y), __float_as_uint(y), false, false);
    const float pmax = fmaxf(__uint_as_float(rr[0]), __uint_as_float(rr[1]));
    alpha = 1.0f;
    if (__builtin_expect(!__all(pmax <= THR * 1.4426950408889634f), 0)) {
      const float sh = fmaxf(pmax, 0.0f); alpha = __builtin_amdgcn_exp2f(-sh); m_reg += sh;
#pragma unroll
      for (int r = 0; r < 16; ++r) { p0[r] -= sh; p1[r] -= sh; negm[r] = -m_reg; }
    } }
  DA_SBAR();
  DA_MF(o[1], pa1, b2, b3); DA_EX(0); DA_EX(1); DA_EX(2); DA_SBAR();
  DA_MF(o[1], pa2, b4, b5); DA_EX(3); DA_EX(4); DA_EX(5); DA_SBAR();
  DA_MF(o[1], pa3, b6, b7); DA_EX(6); DA_EX(7); DA_EX(8); DA_LW(); DA_SBAR();
  DA_TR4(3, b);
  DA_MF(o[2], pa0, a0, a1); mid(); DA_EX(9); DA_EX(10); DA_EX(11); DA_SBAR();
  DA_MF(o[2], pa1, a2, a3); DA_EX(12); DA_EX(13); DA_EX(14); DA_SBAR();
  DA_MF(o[2], pa2, a4, a5); DA_EX(15); DA_EY(0); DA_EY(1); DA_SBAR();
  DA_MF(o[2], pa3, a6, a7); DA_EY(2); DA_EY(3); DA_EY(4); DA_LW(); DA_SBAR();
  DA_MF(o[3], pa0, b0, b1); DA_EY(5); DA_EY(6); DA_EY(7); DA_SBAR();
  DA_MF(o[3], pa1, b2, b3); DA_EY(8); DA_EY(9); DA_EY(10); DA_SBAR();
  DA_MF(o[3], pa2, b4, b5); DA_EY(11); DA_EY(12); DA_EY(13); DA_SBAR();
  DA_MF(o[3], pa3, b6, b7); DA_EY(14); DA_EY(15); DA_SBAR();
#undef DA_TR4
#undef DA_EX
#undef DA_EY
#undef DA_LW
#undef DA_PK
#undef DA_MF
#undef DA_MX3
}

__device__ __forceinline__ void unit(const bf16* __restrict__ P, bf16* __restrict__ MIX, int qrow0, int hh, int lat_row0, int n_lat_tiles, int ctx_row0,
                                     float lam, float post, const float* __restrict__ sub_g, LAS char* lds, int tid) {
  const int wid = __builtin_amdgcn_readfirstlane(tid >> 6), lane = tid & 63, r32 = lane & 31, hi = lane >> 5, mp = wid >> 2, wq = wid & 3;
  LAS char* V_lds = lds; LAS char* K_lds = lds + 3 * SHM_V;
  LAS float* wsl = (LAS float*)(lds + LDS_WS3) + wid * 64; LAS float* li_l = wsl; LAS float* al_l = wsl + 32;
  float m_reg = 0.f, l_reg = 0; f32x16 o[4] = {}; bf16x8 qr[4];
  { const bf16* Qw = P + (size_t)(qrow0 + wq * 32 + r32) * INW + hh * 128 + mp * 64 + hi * 8;
#pragma unroll
    for (int d0 = 0; d0 < 4; ++d0) qr[d0] = *reinterpret_cast<const bf16x8*>(Qw + d0 * 16); }
#pragma unroll
  for (int d0 = 0; d0 < 4; ++d0)
#pragma unroll
    for (int e = 0; e < 8; ++e) qr[d0][e] = (short)f2bf(bf2f((bf16)(unsigned short)qr[d0][e]) * (SCALE * 1.4426950408889634f));
  const int mapcolB = mp * 128;
  const int sr = tid >> 4, sc = (tid & 15) * 8, vst0 = v_st(sr, sc), vst1 = v_st(32 + sr, sc);
  const int vb0 = (int)(uintptr_t)V_lds + v_rd_base(lane);
  const bf16* Kc = P + 1536 + hh * 128 + sc; const bf16* Vc = P + 3072 + hh * 128 + sc;
  const int NT = n_lat_tiles + 4;
  unsigned voK[2], voV[2];
#pragma unroll
  for (int j = 0; j < 2; ++j) { const int p = 2 * wid + j, row = 4 * p + (lane >> 4), chunk = (lane & 15) ^ (row & 15); voK[j] = (unsigned)(row * INW * 2 + chunk * 16);
    const int sub = 2 * p + (lane >> 5), kk = (sub >> 2) * 8 + ((lane & 31) >> 2), c = (sub & 3) * 32 + (lane & 3) * 8, k = (kk & ~0xC) | ((kk & 4) << 1) | ((kk & 8) >> 1); voV[j] = (unsigned)(k * INW * 2 + c * 2); }
  const char* Kb = (const char*)(P + 1536 + hh * 128); const char* Vb = (const char*)(P + 3072 + hh * 128);
#define DA_TROW(j) ((j) < n_lat_tiles ? lat_row0 + (j) * KVBLK : ctx_row0 + ((j) - n_lat_tiles) * KVBLK)
#define DA_DMA(off, j) do { const size_t _t = (size_t)DA_TROW(j) * (INW * 2); \
    _Pragma("unroll") for (int _i = 0; _i < 2; ++_i) { \
      __builtin_amdgcn_global_load_lds((const unsigned*)(Kb + _t + voK[_i]), (LAS unsigned*)(K_lds + (off) + wid * 2048 + _i * 1024), 16, 0, 0); \
      __builtin_amdgcn_global_load_lds((const unsigned*)(Vb + _t + voV[_i]), (LAS unsigned*)(V_lds + (off) + wid * 2048 + _i * 1024), 16, 0, 0); } } while (0)
#define DA_SWAIT() asm volatile("s_waitcnt vmcnt(0)" ::: "memory")
#define DA_RESC(a) do { if (__any((a) < 1.f)) { if (hi == 0) al_l[r32] = (a); asm volatile("s_waitcnt lgkmcnt(0)" ::: "memory"); \
    _Pragma("unroll") for (int d = 0; d < 4; ++d) _Pragma("unroll") for (int r = 0; r < 16; ++r) o[d][r] *= al_l[crow(r, hi)]; } } while (0)
  f32x16 pA0, pA1, pB0, pB1, negm; float alA, alB; bf16x8 pa0, pa1, pa2, pa3;
  DA_DMA(0, 0); DA_DMA(SHM_V, 1); DA_SWAIT(); __syncthreads();
  qkt(pA0, pA1, K_lds, qr, r32, hi, mapcolB);
  { float pm = pA0[0];
#pragma unroll
    for (int r = 1; r < 16; ++r) pm = fmaxf(pm, pA0[r]);
#pragma unroll
    for (int r = 0; r < 16; ++r) pm = fmaxf(pm, pA1[r]);
    { auto rr = __builtin_amdgcn_permlane32_swap(__float_as_uint(pm), __float_as_uint(pm), false, false); pm = fmaxf(__uint_as_float(rr[0]), __uint_as_float(rr[1])); }
    m_reg = pm; alA = 1.0f;
#pragma unroll
    for (int r = 0; r < 16; ++r) { pA0[r] = __builtin_amdgcn_exp2f(pA0[r] - pm); pA1[r] = __builtin_amdgcn_exp2f(pA1[r] - pm); negm[r] = -pm; } }
  if (wid >= 4) __builtin_amdgcn_s_setprio(1);
  int bp = 0, bc = SHM_V, bn = 2 * SHM_V;
  for (int s = 1; s + 1 < NT; s += 2) {
    DA_DMA(bn, s + 1);
    DA_SBAR(); qkt_pipe(pB0, pB1, K_lds + bc, qr, r32, hi, mapcolB, negm);
    finishSM2(pA0, pA1, alA, l_reg, pa0, pa1, pa2, pa3); DA_SBAR();
    pv_sm(o, vb0 + bp, pa0, pa1, pa2, pa3, pB0, pB1, m_reg, alB, negm, [] {});
    DA_RESC(alB); DA_SWAIT(); __syncthreads();
    if (s + 2 < NT) DA_DMA(bp, s + 2);
    DA_SBAR(); qkt_pipe(pA0, pA1, K_lds + bn, qr, r32, hi, mapcolB, negm);
    finishSM2(pB0, pB1, alB, l_reg, pa0, pa1, pa2, pa3); DA_SBAR();
    pv_sm(o, vb0 + bc, pa0, pa1, pa2, pa3, pA0, pA1, m_reg, alA, negm, [] {});
    DA_RESC(alA); DA_SWAIT(); __syncthreads();
    { const int t = bp; bp = bn; bn = bc; bc = t; }
  }
  DA_SBAR(); qkt_pipe(pB0, pB1, K_lds + bc, qr, r32, hi, mapcolB, negm);
  finishSM2(pA0, pA1, alA, l_reg, pa0, pa1, pa2, pa3); DA_SBAR();
  pv_sm(o, vb0 + bp, pa0, pa1, pa2, pa3, pB0, pB1, m_reg, alB, negm, [] {});
  DA_RESC(alB);
  finishSM2(pB0, pB1, alB, l_reg, pa0, pa1, pa2, pa3); DA_SBAR();
  pv_d0(o, vb0 + bc, pa0, pa1, pa2, pa3);
  __builtin_amdgcn_s_setprio(0);
  int te = tid; asm volatile("" : "+v"(te)); const int lane_e = te & 63, r32e = lane_e & 31, hie = lane_e >> 5;
  if (hie == 0) li_l[r32e] = l_reg; asm volatile("s_waitcnt lgkmcnt(0)" ::: "memory");
  float rli[16];
#pragma unroll
  for (int r = 0; r < 16; ++r) rli[r] = 1.0f / li_l[crow(r, hie)];
  __syncthreads();
  LAS float* X2 = (LAS float*)(lds + LDS_X2);
  if (mp == 1) {
#pragma unroll
    for (int r = 0; r < 16; ++r) { const int row = wq * 32 + crow(r, hie);
#pragma unroll
      for (int d0 = 0; d0 < 4; ++d0) X2[row * 128 + d0 * 32 + r32e] = lam * o[d0][r] * rli[r]; }
  }
  __syncthreads();
  if (mp == 0) {
    float ss[16];
#pragma unroll
    for (int r = 0; r < 16; ++r) { const int row = wq * 32 + crow(r, hie); float s = 0.f;
#pragma unroll
      for (int d0 = 0; d0 < 4; ++d0) { const float v = o[d0][r] * rli[r] - X2[row * 128 + d0 * 32 + r32e]; o[d0][r] = v; s += v * v; }
      ss[r] = s; }
#pragma unroll
    for (int r = 0; r < 16; ++r) { float s = ss[r];
      s += shx<1>(s); s += shx<2>(s); s += shx<4>(s); s += shx<8>(s); s += shx<16>(s);
      ss[r] = post / sqrtf(s * (1.0f / 128.0f) + 1e-6f); }
    float gsub[4];
#pragma unroll
    for (int d0 = 0; d0 < 4; ++d0) gsub[d0] = sub_g[d0 * 32 + r32e];
    LAS bf16* OT = (LAS bf16*)(lds + LDS_OT3);
#pragma unroll
    for (int r = 0; r < 16; ++r) { const int row = wq * 32 + crow(r, hie);
#pragma unroll
      for (int d0 = 0; d0 < 4; ++d0) OT[row * 128 + d0 * 32 + r32e] = (bf16)f2bf(o[d0][r] * ss[r] * gsub[d0]); }
  }
  __syncthreads();
  { const LAS bf16* OT = (const LAS bf16*)(lds + LDS_OT3);
#pragma unroll
    for (int i = 0; i < 4; ++i) { const int chunk = te + 512 * i, row = chunk >> 4, c8 = (chunk & 15) * 8;
      *(GAS v4u*)(MIX + (size_t)(qrow0 + row) * DM + hh * 128 + c8) = *(const LAS v4u*)(OT + row * 128 + c8); } }
  __syncthreads();
#undef DA_TROW
#undef DA_DMA
#undef DA_SWAIT
#undef DA_RESC
}
}

namespace na {
using da::bf16x8; using da::s16x4; using da::f32x16; using da::u32x4; using da::crow; using da::SHM_V; using da::SHM_K; using da::LDS_WS;
constexpr float QSCALE = 0.08838834764831845f, LOG2E = 1.4426950408889634f, THR2 = 8.f * LOG2E, NEG = -1e30f;
constexpr int LDS_TAB = LDS_WS + 8 * 64 * 4 + 512;
__device__ __forceinline__ void qkt(f32x16& p0, f32x16& p1, const LAS char* Ks, const bf16x8 (&qr)[8], int r32, int hi) {
  p0 = f32x16{}; p1 = f32x16{};
#pragma unroll
  for (int d0 = 0; d0 < 8; ++d0) { const int cb = (d0 * 16 + hi * 8) * 2;
    const bf16x8 b0 = *reinterpret_cast<const LAS bf16x8*>(Ks + DA_KSWZ(r32, cb));
    const bf16x8 b1 = *reinterpret_cast<const LAS bf16x8*>(Ks + DA_KSWZ(32 + r32, cb));
    p0 = __builtin_amdgcn_mfma_f32_32x32x16_bf16(b0, qr[d0], p0, 0, 0, 0);
    p1 = __builtin_amdgcn_mfma_f32_32x32x16_bf16(b1, qr[d0], p1, 0, 0, 0); }
}
__device__ __forceinline__ void bias_mask(f32x16& p0, f32x16& p1, int mode, const LAS float* lanetab, int kb) {
  constexpr float C = QSCALE * LOG2E;
  if (mode == 0) {
#pragma unroll
    for (int r = 0; r < 16; ++r) { p0[r] *= C; p1[r] *= C; }
  } else if (mode == 2) {
#pragma unroll
    for (int r = 0; r < 16; ++r) { p0[r] = NEG; p1[r] = NEG; }
  } else {
#pragma unroll
    for (int r = 0; r < 16; ++r) { const int c = (r & 3) + 8 * (r >> 2);
      const float b0 = lanetab[c], b1 = lanetab[c + 32];
      p0[r] = ((unsigned)(kb + c) < 16u) ? fmaf(p0[r], C, b0) : NEG;
      p1[r] = ((unsigned)(kb + c + 32) < 16u) ? fmaf(p1[r], C, b1) : NEG; }
  }
}
__device__ __forceinline__ void partialSM(f32x16& p0, f32x16& p1, float& m_reg, float& mn, float& alpha) {
  float pmax = p0[0];
#pragma unroll
  for (int r = 1; r < 16; ++r) pmax = fmaxf(pmax, p0[r]);
#pragma unroll
  for (int r = 0; r < 16; ++r) pmax = fmaxf(pmax, p1[r]);
  { auto rr = __builtin_amdgcn_permlane32_swap(__float_as_uint(pmax), __float_as_uint(pmax), false, false);
    pmax = fmaxf(__uint_as_float(rr[0]), __uint_as_float(rr[1])); }
  if (__builtin_expect(__all(pmax - m_reg <= THR2), 1)) { mn = m_reg; alpha = 1.f; }
  else { mn = fmaxf(m_reg, pmax); alpha = __builtin_amdgcn_exp2f(m_reg - mn); m_reg = mn; }
#pragma unroll
  for (int r = 0; r < 16; ++r) p0[r] = __builtin_amdgcn_exp2f(p0[r] - mn);
#pragma unroll
  for (int r = 0; r < 16; ++r) p1[r] = p1[r] - mn;
}

__device__ __forceinline__ void unit(const bf16* __restrict__ P, bf16* __restrict__ MIX, int qrow0, int hh, bool lat, int b, int r0, const float* __restrict__ rpb_h, LAS char* lds, int tid) {
  const int wid = __builtin_amdgcn_readfirstlane(tid >> 6), lane = tid & 63, r32 = lane & 31, hi = lane >> 5;
  LAS char* V_lds = lds; LAS char* K_lds = lds + 2 * SHM_V;
  LAS float* wsl = (LAS float*)(lds + LDS_WS) + wid * 64; LAS float* li_l = wsl; LAS float* al_l = wsl + 32;
  LAS float* tab = (LAS float*)(lds + LDS_TAB);
  if (lat) for (int i = tid; i < 15 * 31; i += 512) tab[i] = rpb_h[i] * LOG2E;
  float m_reg = -1e28f, l_reg = 0; f32x16 o[4] = {}; bf16x8 qr[8];
  { const bf16* Qw = P + (size_t)(qrow0 + wid * 32 + r32) * INW + 2048 + hh * 128 + hi * 8;
#pragma unroll
    for (int d0 = 0; d0 < 8; ++d0) qr[d0] = *reinterpret_cast<const bf16x8*>(Qw + d0 * 16); }
  const int qgr = r0 + (wid >> 1), rs = min(max(qgr - 4, 0), 56), rbase = min(max(r0 - 4, 0), 52);
  const int qc = 32 * (wid & 1) + r32, cs = min(max(qc - 8, 0), 48), lt0 = 4 * hi - qc + 15, kb0 = 4 * hi - cs;
  const int sr = tid >> 4, sc = (tid & 15) * 8, vst0 = da::v_st(sr, sc), vst1 = da::v_st(32 + sr, sc);
  const int vb0 = (int)(uintptr_t)V_lds + da::v_rd_base(lane);
  const bf16* Kc = P + 3072 + hh * 128 + sc; const bf16* Vc = P + 4096 + hh * 128 + sc;
  const int NLT = lat ? 12 : 0, NT = NLT + 4;
  const int lat_row0 = b * SEQ + rbase * 64, ctx_row0 = MLAT + b * NCTX;
  unsigned voK[2], voV[2];
#pragma unroll
  for (int j = 0; j < 2; ++j) { const int p = 2 * wid + j, row = 4 * p + (lane >> 4), chunk = (lane & 15) ^ (row & 15); voK[j] = (unsigned)(row * INW * 2 + chunk * 16);
    const int sub = 2 * p + (lane >> 5), kk = (sub >> 2) * 8 + ((lane & 31) >> 2), c = (sub & 3) * 32 + (lane & 3) * 8, k = (kk & ~0xC) | ((kk & 4) << 1) | ((kk & 8) >> 1); voV[j] = (unsigned)(k * INW * 2 + c * 2); }
  const char* Kb = (const char*)(P + 3072 + hh * 128); const char* Vb = (const char*)(P + 4096 + hh * 128);
#define NA_TROW(j) ((j) < NLT ? lat_row0 + (j) * 64 : ctx_row0 + ((j) - NLT) * 64)
#define NA_DMA(bb, j) do { const size_t _t = (size_t)NA_TROW(j) * (INW * 2); \
    _Pragma("unroll") for (int _i = 0; _i < 2; ++_i) { \
      __builtin_amdgcn_global_load_lds((const unsigned*)(Kb + _t + voK[_i]), (LAS unsigned*)(K_lds + (bb) * SHM_K + wid * 2048 + _i * 1024), 16, 0, 0); \
      __builtin_amdgcn_global_load_lds((const unsigned*)(Vb + _t + voV[_i]), (LAS unsigned*)(V_lds + (bb) * SHM_V + wid * 2048 + _i * 1024), 16, 0, 0); } } while (0)
#define NA_RESC(a) do { if (__any((a) < 1.f)) { if (hi == 0) al_l[r32] = (a); asm volatile("s_waitcnt lgkmcnt(0)" ::: "memory"); \
    _Pragma("unroll") for (int d = 0; d < 4; ++d) _Pragma("unroll") for (int r = 0; r < 16; ++r) o[d][r] *= al_l[crow(r, hi)]; } } while (0)
#define NA_BM(p0, p1, j) do { const int _kr = rbase + (j); const int _mode = (j) >= NLT ? 0 : ((_kr >= rs && _kr < rs + 8) ? 1 : 2); \
    int _lt = min(max(_kr - qgr + 7, 0), 14) * 31 + lt0, _kb = kb0; asm volatile("" : "+v"(_lt), "+v"(_kb)); \
    bias_mask(p0, p1, _mode, tab + _lt, _kb); } while (0)
  f32x16 p0, p1; float mn, al; bf16x8 pa0, pa1, pa2, pa3;
  NA_DMA(0, 0); asm volatile("s_waitcnt vmcnt(0)" ::: "memory"); __syncthreads();
  for (int j = 0; j < NT; ++j) {
    const int bb = j & 1;
    const bool live = j >= NLT || (rbase + j >= rs && rbase + j < rs + 8);
    if (j + 1 < NT) NA_DMA(bb ^ 1, j + 1);
    if (live) {
      DA_SBAR(); qkt(p0, p1, K_lds + bb * SHM_K, qr, r32, hi); NA_BM(p0, p1, j); partialSM(p0, p1, m_reg, mn, al);
      NA_RESC(al);
      da::finishSM(p0, p1, al, l_reg, pa0, pa1, pa2, pa3); DA_SBAR();
      da::pv_d0(o, vb0 + bb * SHM_V, pa0, pa1, pa2, pa3);
    }
    asm volatile("s_waitcnt vmcnt(0)" ::: "memory"); __syncthreads();
  }
  if (hi == 0) li_l[r32] = l_reg; asm volatile("s_waitcnt lgkmcnt(0)" ::: "memory");
  float rli[16];
#pragma unroll
  for (int r = 0; r < 16; ++r) rli[r] = 1.0f / li_l[crow(r, hi)];
  __syncthreads();
  { LAS bf16* OT = (LAS bf16*)(lds + wid * 8192);
#pragma unroll
    for (int r = 0; r < 16; ++r) {
#pragma unroll
      for (int d0 = 0; d0 < 4; ++d0) OT[crow(r, hi) * 128 + d0 * 32 + r32] = (bf16)f2bf(o[d0][r] * rli[r]); }
    asm volatile("s_waitcnt lgkmcnt(0)" ::: "memory");
#pragma unroll
    for (int i = 0; i < 8; ++i) { const int chunk = lane + 64 * i, row = chunk >> 4, c8 = (chunk & 15) * 8;
      *(GAS v4u*)(MIX + (size_t)(qrow0 + wid * 32 + row) * DM + 1024 + hh * 128 + c8) = *(const LAS v4u*)(OT + row * 128 + c8); } }
  __syncthreads();
#undef NA_TROW
#undef NA_DMA
#undef NA_RESC
#undef NA_BM
}
}

namespace sgu {
using da::bf16x8; using da::f32x16; using da::crow; using da::SHM_V;
__device__ __forceinline__ void unit(const bf16* __restrict__ P, bf16* __restrict__ MIX, int row0, int g, const bf16* __restrict__ Wg  , const float* __restrict__ gain  ,
                                     const float* __restrict__ bias  , LAS char* lds, int tid) {
  const int wid = __builtin_amdgcn_readfirstlane(tid >> 6), lane = tid & 63, r32 = lane & 31, hi = lane >> 5, pb = wid & 3, ch = wid >> 2;
  { const int q = tid >> 2, c0 = (tid & 3) * 32; const bf16* vp = P + (size_t)(row0 + q) * INW + 1024 + g * 128 + c0; float v[32];
#pragma unroll
    for (int c8 = 0; c8 < 4; ++c8) { const v4u w = ((const GAS v4u*)vp)[c8];
      v[8 * c8 + 0] = bflo(w.x); v[8 * c8 + 1] = bfhi(w.x); v[8 * c8 + 2] = bflo(w.y); v[8 * c8 + 3] = bfhi(w.y); v[8 * c8 + 4] = bflo(w.z); v[8 * c8 + 5] = bfhi(w.z); v[8 * c8 + 6] = bflo(w.w); v[8 * c8 + 7] = bfhi(w.w); }
    float s = 0.f;
#pragma unroll
    for (int j = 0; j < 32; ++j) s += v[j];
    s += shx<1>(s); s += shx<2>(s);
    const float mu = s * (1.0f / 128.0f); float qq = 0.f;
#pragma unroll
    for (int j = 0; j < 32; ++j) { v[j] -= mu; qq += v[j] * v[j]; }
    qq += shx<1>(qq); qq += shx<2>(qq);
    const float rstd = 1.0f / sqrtf(qq * (1.0f / 128.0f) + 1e-5f);
    LAS char* vt = lds + (q >> 6) * SHM_V;
#pragma unroll
    for (int c8 = 0; c8 < 4; ++c8) { const f32x4 g0 = *(const GAS f32x4*)(gain + c0 + 8 * c8), g1 = *(const GAS f32x4*)(gain + c0 + 8 * c8 + 4); v4u w;
      w.x = pk2(v[8 * c8 + 0] * rstd * g0.x, v[8 * c8 + 1] * rstd * g0.y); w.y = pk2(v[8 * c8 + 2] * rstd * g0.z, v[8 * c8 + 3] * rstd * g0.w);
      w.z = pk2(v[8 * c8 + 4] * rstd * g1.x, v[8 * c8 + 5] * rstd * g1.y); w.w = pk2(v[8 * c8 + 6] * rstd * g1.z, v[8 * c8 + 7] * rstd * g1.w);
      *(LAS v4u*)(vt + da::v_st(q & 63, c0 + 8 * c8)) = w; } }
  bf16x8 wa[8];
  { const bf16* wp = Wg + (size_t)(32 * pb + r32) * 128 + hi * 8;
#pragma unroll
    for (int ks = 0; ks < 8; ++ks) wa[ks] = *reinterpret_cast<const bf16x8*>(wp + ks * 16); }
  __syncthreads();
  f32x16 o0 = {}, o1 = {};
  const int vb = (int)(uintptr_t)lds + da::v_rd_base(lane) + ch * 1024;
  da::pv_one<0>(o0, vb, wa[0], wa[1], wa[2], wa[3]); da::pv_one<1>(o1, vb, wa[0], wa[1], wa[2], wa[3]);
  da::pv_one<0>(o0, vb + SHM_V, wa[4], wa[5], wa[6], wa[7]); da::pv_one<1>(o1, vb + SHM_V, wa[4], wa[5], wa[6], wa[7]);
  LAS float* XT = (LAS float*)(lds + 2 * SHM_V);
#pragma unroll
  for (int r = 0; r < 16; ++r) { const int p = 32 * pb + crow(r, hi); const float bs = bias[p];
    XT[p * 128 + ch * 64 + r32] = o0[r] + bs; XT[p * 128 + ch * 64 + 32 + r32] = o1[r] + bs; }
  __syncthreads();
#pragma unroll
  for (int i = 0; i < 4; ++i) { const int chunk = tid + 512 * i, p = chunk >> 4, c8 = (chunk & 15) * 8; const size_t row = (size_t)(row0 + p);
    const f32x4 m0 = *(const LAS f32x4*)(XT + p * 128 + c8), m1 = *(const LAS f32x4*)(XT + p * 128 + c8 + 4);
    const v4u uw = *(const GAS v4u*)(P + row * INW + g * 128 + c8); v4u w;
    w.x = pk2(bflo(uw.x) * m0.x, bfhi(uw.x) * m0.y); w.y = pk2(bflo(uw.y) * m0.z, bfhi(uw.y) * m0.w); w.z = pk2(bflo(uw.z) * m1.x, bfhi(uw.z) * m1.y); w.w = pk2(bflo(uw.w) * m1.z, bfhi(uw.w) * m1.w);
    *(GAS v4u*)(MIX + row * DM + g * 128 + c8) = w; }
  __syncthreads();
}
}

constexpr int PPL = 11, NPH = 2 + PPL * DEPTH + 1;
struct Args { const float* in[22]; float* out; unsigned char* ws; int ph_lo, ph_hi; };
__global__ void __launch_bounds__(NWAVES * 64, 2) fwd(Args args) {
    extern __shared__ __attribute__((aligned(16))) unsigned char lds_raw[];
    LAS unsigned char* lds = (LAS unsigned char*)lds_raw;
    volatile LAS unsigned* MISC = (volatile LAS unsigned*)(lds + MISC_OFF);
    const int G = gridDim.x;
    typedef const __attribute__((address_space(4))) Args* KArgs;
    const KArgs ka0 = (KArgs)__builtin_amdgcn_kernarg_segment_ptr();
#define KA() ({ KArgs _p = ka0; asm volatile("" : "+s"(_p)); _p; })
#define ARG(i) (KA()->in[i])
#define WSP(T, off) ((T*)(KA()->ws + (off)))
#define THREAD_IDS() int tid = threadIdx.x; asm volatile("" : "+v"(tid)); int bx = blockIdx.x; asm volatile("" : "+s"(bx)); \
    const int lane = tid & 63, wave = __builtin_amdgcn_readfirstlane(tid >> 6); const int gw = bx * NWAVES + wave, NGW = G * NWAVES; const int gt = bx * (NWAVES * 64) + tid, NT = G * NWAVES * 64; \
    (void)lane; (void)wave; (void)gw; (void)NGW; (void)gt; (void)NT;
    {
    THREAD_IDS();
    for (int u = tid; u < (LDS_BYTES - LDSCTL_OFF) / 4; u += NWAVES * 64) ((LAS unsigned*)(lds + LDSCTL_OFF))[u] = 0u;
    __syncthreads();
    }
#if MK_ONE_LAUNCH
    XcdBarrier bar = xcd_barrier_post(WSP(unsigned, WS_CTL) + CW_BAR, MISC + 8);
#define GRID_BAR() xcd_barrier(bar)
#else
    (void)MISC;
#define GRID_BAR() do { } while (0)
#endif
    const int lo = args.ph_lo, hi = args.ph_hi;
#define IN(k) (lo <= (k) && (k) < hi)
#if defined(PROBE_A)
#define STAMP(k) do { if (blockIdx.x == 0 && threadIdx.x == 0) WSP(unsigned long long, WS_STAMP)[k] = __builtin_amdgcn_s_memrealtime(); } while (0)
#else
#define STAMP(k) do { } while (0)
#endif
#define SEAM(k) do { if (IN(k) && IN((k) + 1)) GRID_BAR(); STAMP((k) + 1); } while (0)
    STAMP(0);

    constexpr int I_IN = (DM / 64) * (INW / 32), I_OUT = (DM / 64) * (DM / 32), I_1 = (DM / 64) * (DFF / 32), I_2 = (DFF / 64) * (DM / 32), I_L = I_IN + I_OUT + I_1 + I_2;
#define CONVERT(l_, lo_, hi_, widx_, nw_) do { LAS float* _scr = (LAS float*)(lds + RING_OFF + wave * 16384); const int _l = (l_); \
        const float* _win = ARG(8); const float* _wout = ARG(9); const float* _w1 = ARG(19); const float* _w2 = ARG(20); \
        bf16* _WIN = WSP(bf16, WS_WIN); bf16* _WOUT = WSP(bf16, WS_WOUT); bf16* _W1 = WSP(bf16, WS_W1); bf16* _W2 = WSP(bf16, WS_W2); \
        for (int _it = (lo_) + (widx_); _it < (hi_); _it += (nw_)) { int _r = _it; \
            if (_r < I_IN) { p0_transpose_item(_win + (size_t)_l * DM * INW, DM, INW, _WIN + (size_t)_l * INW * DM, _scr, _r, lane); continue; } _r -= I_IN; \
            if (_r < I_OUT) { p0_transpose_item(_wout + (size_t)_l * DM * DM, DM, DM, _WOUT + (size_t)_l * DM * DM, _scr, _r, lane); continue; } _r -= I_OUT; \
            if (_r < I_1) { p0_transpose_item(_w1 + (size_t)_l * DM * DFF, DM, DFF, _W1 + (size_t)_l * DFF * DM, _scr, _r, lane); continue; } _r -= I_1; \
            p0_transpose_item(_w2 + (size_t)_l * DFF * DM, DFF, DM, _W2 + (size_t)_l * DM * DFF, _scr, _r, lane); } } while (0)
    constexpr int CV0 = 0, CV1 = (I_L * 32) / 100, CV2 = (I_L * 58) / 100, CV3 = (I_L * 86) / 100, CV4 = I_L;
    if (IN(0)) {
        THREAD_IDS();
        const float* c_in = ARG(1); const float* cctx_in = ARG(3); const float* ada_w = ARG(4);
        const float* lq1 = ARG(14); const float* lk1 = ARG(15); const float* lq2 = ARG(16); const float* lk2 = ARG(17);
        float* ADAP = WSP(float, WS_ADAP); float* LAM = WSP(float, WS_LAM);
        LAS float* s_lds = (LAS float*)(lds + RING_OFF);
        for (int it = bx; it < DEPTH * 32 * 6; it += G) {
            const int l = it / 192, rem = it % 192, kc = rem / 6, cb = rem % 6;
            __syncthreads();
            if (tid < 5 * 64) { const int r = tid >> 6, k = tid & 63; const float cv = r < 4 ? c_in[r * DM + kc * 64 + k] : cctx_in[kc * 64 + k]; s_lds[tid] = cv / (1.0f + expf(-cv)); }
            __syncthreads();
            const int col = cb * 2048 + tid * 4; f32x4 a0 = {0.f, 0.f, 0.f, 0.f}, a1 = a0, a2 = a0, a3 = a0, a4 = a0;
            const float* wp = ada_w + ((size_t)l * DM + kc * 64) * ADA + col;
#pragma unroll 16
            for (int k = 0; k < 64; ++k) { const f32x4 w = *(const GAS f32x4*)(wp + (size_t)k * ADA); a0 += s_lds[k] * w; a1 += s_lds[64 + k] * w; a2 += s_lds[128 + k] * w; a3 += s_lds[192 + k] * w; a4 += s_lds[256 + k] * w; }
            float* pp = ADAP + ((size_t)(l * 32 + kc) * 5) * ADA + col;
            *(GAS f32x4*)pp = a0; *(GAS f32x4*)(pp + ADA) = a1; *(GAS f32x4*)(pp + 2 * ADA) = a2; *(GAS f32x4*)(pp + 3 * ADA) = a3; *(GAS f32x4*)(pp + 4 * ADA) = a4;
        }
        __syncthreads();
        CONVERT(0, 0, I_L, gw, NGW);
        { bf16* CS = WSP(bf16, WS_CS);
          for (int i = gt; i < 4096 * 4096 / 8; i += NT) { const int row = i >> 9, n0 = (i & 511) * 8; const bool sinrow = row > 2048; const int k = sinrow ? row - 2048 : row; unsigned w[4];
#pragma unroll
              for (int e = 0; e < 8; e += 2) { float s0, c0, s1, c1; sincospif((float)((k * (n0 + e)) & 4095) * (1.0f / 2048.0f), &s0, &c0); sincospif((float)((k * (n0 + e + 1)) & 4095) * (1.0f / 2048.0f), &s1, &c1);
                  w[e >> 1] = sinrow ? pk2(s0, s1) : pk2(c0, c1); }
              *(GAS v4u*)(CS + (size_t)i * 8) = (v4u){w[0], w[1], w[2], w[3]}; }
          bf16* CT = WSP(bf16, WS_CT);
          for (int i = gt; i < 256 * 512; i += NT) { const int j = i >> 9, cc = i & 255, c = cc & 127; float sn, cs; sincospif((float)((j * c) & 127) * (1.0f / 64.0f), &sn, &cs);
              CT[i] = j < 128 ? (bf16)f2bf(cc < 128 ? cs : -sn) : (bf16)0; } }
        { const float* sgu_w = ARG(11); bf16* SGW = WSP(bf16, WS_SGW); for (int i = gt; i < 2 * 8 * 128 * 128; i += NT) SGW[i] = (bf16)f2bf(sgu_w[i]); }
        { float* ROPE = WSP(float, WS_ROPE); for (int i = gt; i < 64 * 16; i += NT) { const int pos = i >> 4, ii = i & 15; const float inv = exp2f(-(float)ii * (13.287712379549449f / 16.0f)); float sn, cs; sincosf((float)pos * inv, &sn, &cs); ROPE[2 * i] = cs; ROPE[2 * i + 1] = sn; } }
        if (bx == 0 && tid < 2) { float d1 = 0.f, d2 = 0.f; for (int j = 0; j < 64; ++j) { d1 += lq1[tid * 64 + j] * lk1[tid * 64 + j]; d2 += lq2[tid * 64 + j] * lk2[tid * 64 + j]; }
            LAM[tid] = expf(d1) - expf(d2) + (tid == 0 ? LAM_INIT1 : LAM_INIT3); }
    }
    SEAM(0);
    if (IN(1)) {
        THREAD_IDS();
        const float* ada_b = ARG(5); const float* ADAP = WSP(float, WS_ADAP); float* MOD = WSP(float, WS_MOD);
        for (int i = gt; i < DEPTH * 5 * ADA; i += NT) { const int l = i / (5 * ADA), rc = i % (5 * ADA), col = rc % ADA; float s = ada_b[l * ADA + col];
#pragma unroll
            for (int kc = 0; kc < 32; ++kc) s += ADAP[(size_t)(l * 32 + kc) * 5 * ADA + rc];
            MOD[i] = s; }
    }
    SEAM(1);

    for (int l = 0; l < DEPTH; ++l) {
        const int pb = 2 + PPL * l; const bool odd = (l & 1) != 0, need_ctx = l < DEPTH - 1; const int li = l >> 1;
        const int MR = need_ctx ? MALL : MLAT;
#define MODL() (WSP(float, WS_MOD) + (size_t)l * 5 * ADA)
        if (IN(pb + 0)) { THREAD_IDS(); norm_rows<0>(nullptr, l == 0 ? ARG(2) : WSP(float, WS_X) + (size_t)MLAT * DM, WSP(float, WS_X), WSP(bf16, WS_H), nullptr, ARG(6) + l * DM, MODL(), 0, MLAT, MALL, gw, NGW, lane, l > 0 ? WSP(bf16, WS_PART) : nullptr, l == 0);
            if (need_ctx && bx >= 128) CONVERT(l + 1, CV0, CV1, (bx - 128) * NWAVES + wave, (G - 128) * NWAVES); }
        SEAM(pb + 0);
        if (IN(pb + 1)) {
            THREAD_IDS();
            constexpr int NC1 = (MCTX / 256) * (INW / 256);
            if (G > NC1 && bx < NC1) {
                pg8::Gemm g{WSP(bf16, WS_H) + (size_t)MLAT * DM, WSP(bf16, WS_WIN) + (size_t)l * INW * DM, MCTX, INW, DM, DM}; pg8::StaticOrder S; S.init(MCTX, INW, NC1, bx);
                pg8::EpiIn E{WSP(bf16, WS_P) + (size_t)MLAT * INW, INW, nullptr, nullptr};
                pg8::gemm_phase<pg8::EpiIn, pg8::StaticOrder, true, true>(lds + RING_OFF, g, S, E, tid);
            } else {
                const int c0 = G > NC1 ? NC1 : 0;
                norm_lat_rows(l == 0 ? ARG(0) : nullptr, WSP(bf16, WS_XL), WSP(bf16, WS_H), ARG(6) + l * DM, MODL(), 0, (bx - c0) * NWAVES + wave, (G - c0) * NWAVES, lane);
                if (need_ctx) CONVERT(l + 1, CV1, CV2, (bx - c0) * NWAVES + wave, (G - c0) * NWAVES);
            }
        }
        SEAM(pb + 1);
        if (IN(pb + 2)) {
            THREAD_IDS();
            pg8::Gemm g{WSP(bf16, WS_H), WSP(bf16, WS_WIN) + (size_t)l * INW * DM, MLAT, INW, DM, DM}; pg8::StaticOrder S; S.init(MLAT, INW, G, bx);
            pg8::EpiIn E{WSP(bf16, WS_P), INW, odd ? WSP(float, WS_ROPE) : nullptr, WSP(bf16, WS_FT)};
            pg8::gemm_phase<pg8::EpiIn, pg8::StaticOrder, true, true>(lds + RING_OFF, g, S, E, tid);
        }
        SEAM(pb + 2);
        if (IN(pb + 3)) {
            THREAD_IDS();
            const bf16* P = WSP(bf16, WS_P); bf16* MIX = WSP(bf16, WS_MIX);
            const float* sgu_b = ARG(12); const float* na_rpb = ARG(13);
            if (!odd) {
                {
                    const bf16* SGW = WSP(bf16, WS_SGW); const float* sgu_g = ARG(10);
                    for (int u = bx; u < (MALL / 128) * 8; u += G) { const int g8 = u & 7, ck = u >> 3;
                        sgu::unit(P, MIX, ck * 128, g8, SGW + (size_t)(li * 8 + g8) * 16384, sgu_g + li * 1024 + g8 * 128, sgu_b + (li * 8 + g8) * 128, (LAS char*)(lds + RING_OFF), tid); }
                }
                __syncthreads();
                {
                    const int vcu = (G % 8 == 0) ? (bx % 8) * (G / 8) + bx / 8 : bx;
                    const int NU = NB * 8 * 16 + (need_ctx ? NB * 8 : 0);
                    for (int u = vcu; u < NU; u += G) {
                        const bool lat = u < NB * 8 * 16; int b, hh, r0, qrow0;
                        if (lat) { b = u >> 7; hh = (u >> 4) & 7; r0 = (u & 15) * 4; qrow0 = b * SEQ + r0 * 64; }
                        else { const int v = u - NB * 8 * 16; b = v >> 3; hh = v & 7; r0 = 0; qrow0 = MLAT + b * NCTX; }
                        na::unit(P, MIX, qrow0, hh, lat, b, r0, na_rpb + (size_t)(li * 8 + hh) * 465, (LAS char*)(lds + RING_OFF), tid);
                    }
                }
            } else {
                {
                    const int vcu = (G % 8 == 0) ? (bx % 8) * (G / 8) + bx / 8 : bx;
                    const float lam = WSP(float, WS_LAM)[li], post = 1.0f - (li == 0 ? LAM_INIT1 : LAM_INIT3); const float* sub_g = ARG(18) + li * 128;
                    const int NU = NB * 12 * 32 + (need_ctx ? NB * 12 * 2 : 0);
                    for (int u = vcu; u < NU; u += G) {
                        int bh, qrow0, nlt;
                        if (u < NB * 12 * 32) { bh = u >> 5; qrow0 = (bh / 12) * SEQ + (u & 31) * 128; nlt = SEQ / 64; }
                        else { const int v = u - NB * 12 * 32; bh = v >> 1; qrow0 = MLAT + (bh / 12) * NCTX + (v & 1) * 128; nlt = 0; }
                        const int b = bh / 12, hh = bh % 12;
                        da::unit(P, MIX, qrow0, hh, b * SEQ, nlt, MLAT + b * NCTX, lam, post, sub_g, (LAS char*)(lds + RING_OFF), tid);
                    }
                    __syncthreads();
                }
                {
                    pg8::Gemm g{WSP(bf16, WS_CS), WSP(bf16, WS_FT), 4096, 2048, SEQ / 2, SEQ}; pg8::SplitKOrder S{16, 8, 2, SEQ / 2, G, bx};
                    pg8::EpiUV E{WSP(bf16, WS_UV)};
                    pg8::gemm_phase<pg8::EpiUV, pg8::SplitKOrder, true, true>(lds + RING_OFF, g, S, E, tid);
                }
                if (need_ctx) {
                    __syncthreads();
                    LAS f32x2* tw = (LAS f32x2*)(lds + RING_OFF); LAS float* ft = (LAS float*)(lds + RING_OFF + 4096); bf16* UV = WSP(bf16, WS_UV);
                    if (tid < NCTX) { float sn, cs; sincospif(2.0f * (float)tid / (float)NCTX, &sn, &cs); tw[tid] = (f32x2){cs, sn}; }
                    const int vcu2 = (G % 8 == 0) ? (bx % 8) * (G / 8) + bx / 8 : bx;
                    for (int it = (vcu2 >= 128 ? vcu2 - 128 : vcu2 + 128); it < NB * 32; it += G) { const int b = it >> 5, cb = it & 31;
                        __syncthreads();
                        { const int n = tid >> 1, hf = tid & 1; const v4u w = *(const GAS v4u*)(P + (size_t)(MLAT + b * NCTX + n) * INW + 4608 + cb * 16 + hf * 8); LAS float* d = ft + n * 16 + hf * 8;
                          d[0] = bflo(w.x); d[1] = bfhi(w.x); d[2] = bflo(w.y); d[3] = bfhi(w.y); d[4] = bflo(w.z); d[5] = bfhi(w.z); d[6] = bflo(w.w); d[7] = bfhi(w.w); }
                        __syncthreads();
                        const int k = tid & 255, uv = tid >> 8; float acc[16];
#pragma unroll
                        for (int e = 0; e < 16; ++e) acc[e] = 0.f;
#pragma unroll 4
                        for (int n = 0; n < NCTX; ++n) { const f32x2 t = tw[(k * n) & (NCTX - 1)]; const float c = uv ? t.y : t.x; const LAS f32x4* fr4 = (const LAS f32x4*)(ft + n * 16);
#pragma unroll
                            for (int e4 = 0; e4 < 4; ++e4) { const f32x4 f = fr4[e4]; acc[4 * e4] += c * f.x; acc[4 * e4 + 1] += c * f.y; acc[4 * e4 + 2] += c * f.z; acc[4 * e4 + 3] += c * f.w; } }
                        bf16* op = UV + ((size_t)(SEQ + k) * 16 + b * 4 + (cb >> 3)) * 512 + uv * 128 + (cb & 7) * 16;
                        v4u w0, w1; w0.x = pk2(acc[0], acc[1]); w0.y = pk2(acc[2], acc[3]); w0.z = pk2(acc[4], acc[5]); w0.w = pk2(acc[6], acc[7]);
                        w1.x = pk2(acc[8], acc[9]); w1.y = pk2(acc[10], acc[11]); w1.z = pk2(acc[12], acc[13]); w1.w = pk2(acc[14], acc[15]);
                        ((GAS v4u*)op)[0] = w0; ((GAS v4u*)op)[1] = w1; ((GAS v4u*)(op + 256))[0] = (v4u){0u, 0u, 0u, 0u}; ((GAS v4u*)(op + 256))[1] = (v4u){0u, 0u, 0u, 0u};
                    }
                    __syncthreads();
                }
            }
        }
        SEAM(pb + 3);
        if (IN(pb + 4) && odd) {
            THREAD_IDS();
            const int MU = (need_ctx ? SEQ + NCTX : SEQ) * 16;
            pg8::Gemm g{WSP(bf16, WS_UV), WSP(bf16, WS_CT), MU, 256, 512, 512}; pg8::StaticOrder S; S.init(MU, 256, G, bx);
            pg8::EpiChan E{WSP(bf16, WS_MIX), 0.0013810679320049757f, 0.005524271728019903f};
            pg8::gemm_phase<pg8::EpiChan, pg8::StaticOrder, true, true>(lds + RING_OFF, g, S, E, tid);
        }
        if (odd) SEAM(pb + 4);
        if (IN(pb + 5)) {
            THREAD_IDS();
            pg8::Gemm g{WSP(bf16, WS_MIX), WSP(bf16, WS_WOUT) + (size_t)l * DM * DM, MALL, DM, DM, DM};
            pg8::ResidOrder S; S.lat.init(MLAT, DM, G, bx); S.nctx = need_ctx ? 1 : 0; S.kslice = DM / 8; S.c = bx;
            pg8::EpiResidPart E{l == 0 ? ARG(0) : nullptr, WSP(bf16, WS_XL), DM, MODL() + 2 * DM, ADA, WSP(bf16, WS_PART), DM / 8};
            pg8::gemm_phase<pg8::EpiResidPart, pg8::ResidOrder, true, true>(lds + RING_OFF, g, S, E, tid);
        }
        SEAM(pb + 5);
        if (IN(pb + 6) && need_ctx) { THREAD_IDS(); norm_rows<0>(nullptr, WSP(float, WS_X) + (size_t)MLAT * DM, WSP(float, WS_X), WSP(bf16, WS_H), nullptr, ARG(7) + l * DM, MODL(), 3, MLAT, MALL, gw, NGW, lane, WSP(bf16, WS_PART), false);
            if (bx >= 128) CONVERT(l + 1, CV2, CV3, (bx - 128) * NWAVES + wave, (G - 128) * NWAVES); }
        if (need_ctx) SEAM(pb + 6);
        if (IN(pb + 7)) {
            THREAD_IDS();
            constexpr int NC3 = (MCTX / 256) * (DFF / 256);
            const bool split = need_ctx && G > NC3;
            if (split && bx < NC3) {
                pg8::Gemm g{WSP(bf16, WS_H) + (size_t)MLAT * DM, WSP(bf16, WS_W1) + (size_t)l * DFF * DM, MCTX, DFF, DM, DM}; pg8::StaticOrder S; S.init(MCTX, DFF, NC3, bx);
                pg8::EpiBf16<1> E{WSP(bf16, WS_HID) + (size_t)MLAT * DFF, DFF};
                pg8::gemm_phase<pg8::EpiBf16<1>, pg8::StaticOrder, true, true>(lds + RING_OFF, g, S, E, tid);
            } else {
                const int c0 = split ? NC3 : 0;
                norm_lat_rows(nullptr, WSP(bf16, WS_XL), WSP(bf16, WS_H), ARG(7) + l * DM, MODL(), 3, (bx - c0) * NWAVES + wave, (G - c0) * NWAVES, lane);
                if (need_ctx) CONVERT(l + 1, CV3, CV4, (bx - c0) * NWAVES + wave, (G - c0) * NWAVES);
            }
        }
        SEAM(pb + 7);
        if (IN(pb + 8)) {
            THREAD_IDS();
            pg8::Gemm g{WSP(bf16, WS_H), WSP(bf16, WS_W1) + (size_t)l * DFF * DM, MLAT, DFF, DM, DM}; pg8::StaticOrder S; S.init(MLAT / 2, DFF, G, bx, 0);
            pg8::EpiBf16<1> E{WSP(bf16, WS_HID), DFF};
            pg8::gemm_phase<pg8::EpiBf16<1>, pg8::StaticOrder, true, true>(lds + RING_OFF, g, S, E, tid);
        }
        SEAM(pb + 8);
        if (IN(pb + 9)) {
            THREAD_IDS();
            { pg8::Gemm g{WSP(bf16, WS_HID), WSP(bf16, WS_W2) + (size_t)l * DM * DFF, MALL, DM, DFF, DFF};
              pg8::ResidOrder S; S.lat.init(MLAT / 2, DM, G, bx, 0); S.nctx = need_ctx ? 1 : 0; S.kslice = DFF / 8; S.c = bx;
              pg8::EpiResidPart E{nullptr, WSP(bf16, WS_XL), DM, MODL() + 5 * DM, ADA, WSP(bf16, WS_PART), DFF / 8};
              pg8::gemm_phase<pg8::EpiResidPart, pg8::ResidOrder, true, true>(lds + RING_OFF, g, S, E, tid); }
            { pg8::Gemm g{WSP(bf16, WS_H), WSP(bf16, WS_W1) + (size_t)l * DFF * DM, MLAT, DFF, DM, DM}; pg8::StaticOrder S; S.init(MLAT / 2, DFF, G, bx, 32);
              pg8::EpiBf16<1> E{WSP(bf16, WS_HID), DFF};
              pg8::gemm_phase<pg8::EpiBf16<1>, pg8::StaticOrder, true, true>(lds + RING_OFF, g, S, E, tid); }
        }
        SEAM(pb + 9);
        if (IN(pb + 10)) {
            THREAD_IDS();
            pg8::Gemm g{WSP(bf16, WS_HID), WSP(bf16, WS_W2) + (size_t)l * DM * DFF, MALL, DM, DFF, DFF};
            pg8::ResidOrder S; S.lat.init(MLAT / 2, DM, G, bx, 32); S.nctx = 0; S.kslice = DFF / 8; S.c = bx;
            pg8::EpiResidPart E{nullptr, WSP(bf16, WS_XL), DM, MODL() + 5 * DM, ADA, WSP(bf16, WS_PART), DFF / 8};
            pg8::gemm_phase<pg8::EpiResidPart, pg8::ResidOrder, true, true>(lds + RING_OFF, g, S, E, tid);
        }
        SEAM(pb + 10);
    }
    if (IN(NPH - 1)) { THREAD_IDS(); final_norm_rows(WSP(bf16, WS_XL), KA()->out, ARG(21), gw, NGW, lane); }
#if defined(PROBE_A)
    STAMP(NPH);
    if (blockIdx.x == 0 && threadIdx.x == 0) { asm volatile("s_waitcnt vmcnt(0)" ::: "memory"); const unsigned long long* st = WSP(unsigned long long, WS_STAMP); float acc = 0.f;
        for (int k = PROBE_A; k < PROBE_B; k += PROBE_STEP) acc += (float)(st[k + PROBE_LEN] - st[k]) * 0.01f;
        asm volatile("s_waitcnt vmcnt(0)" ::: "memory"); float* o0 = KA()->out; const float v0 = __hip_atomic_load(o0, __ATOMIC_RELAXED, __HIP_MEMORY_SCOPE_AGENT); __hip_atomic_store(o0, v0 + acc * PROBE_SCALE, __ATOMIC_RELAXED, __HIP_MEMORY_SCOPE_AGENT); }
#endif
#undef IN
#undef SEAM
#undef GRID_BAR
}

extern "C" void kernel_launch(void* const* d_in, const int* in_sizes, int n_in, void* d_out, int out_size, void* d_ws, size_t ws_size, hipStream_t stream) {
    static int grid = 0;
    if (grid == 0) {
        if (n_in != 22 || in_sizes[0] != MLAT * DM || out_size != MLAT * DM || ws_size < WS_END) { fprintf(stderr, "kernel_launch: unexpected shapes (n_in %d, in0 %d, out %d, ws %zu); nothing launched\n", n_in, n_in > 0 ? in_sizes[0] : -1, out_size, ws_size); grid = -1; return; }
        int dev = 0, cus = 0, per_cu = 0;
        if (hipGetDevice(&dev) != hipSuccess || hipDeviceGetAttribute(&cus, hipDeviceAttributeMultiprocessorCount, dev) != hipSuccess) { grid = -1; return; }
        if (hipFuncSetAttribute((const void*)fwd, hipFuncAttributeMaxDynamicSharedMemorySize, LDS_BYTES) != hipSuccess) { fprintf(stderr, "kernel_launch: hipFuncSetAttribute failed\n"); grid = -1; return; }
        if (hipOccupancyMaxActiveBlocksPerMultiprocessor(&per_cu, (const void*)fwd, NWAVES * 64, LDS_BYTES) != hipSuccess || per_cu < 1) fprintf(stderr, "kernel_launch: occupancy query reports %d workgroups per CU\n", per_cu);
        (void)hipGetLastError();
        grid = cus;
        if (grid != 256) { fprintf(stderr, "kernel_launch: built for 256 CUs (phase CU splits), device has %d; nothing launched\n", cus); grid = -1; return; }
    }
    if (grid < 0) return;
    if (hipMemsetAsync((char*)d_ws + WS_CTL, 0, CTL_ZERO_BYTES, stream) != hipSuccess) return;
    Args a{};
    for (int i = 0; i < 22; ++i) a.in[i] = (const float*)d_in[i];
    a.out = (float*)d_out; a.ws = (unsigned char*)d_ws;
#if MK_ONE_LAUNCH
    a.ph_lo = 0; a.ph_hi = NPH;
    hipLaunchKernelGGL(fwd, dim3(grid), dim3(NWAVES * 64), LDS_BYTES, stream, a);
#else
    for (int ph = 0; ph < NPH; ++ph) {
        a.ph_lo = ph; a.ph_hi = ph + 1;
        hipLaunchKernelGGL(fwd, dim3(grid), dim3(NWAVES * 64), LDS_BYTES, stream, a);
    }
#endif
    const hipError_t le = hipPeekAtLastError();
    if (le != hipSuccess) fprintf(stderr, "kernel_launch: launch failed: %s\n", hipGetErrorName(le));
}
```

```cpp
#include <hip/hip_runtime.h>
#include <cstdio>
#include <cstdint>
namespace pg8 {
#define PG8_LAS __attribute__((address_space(3)))
typedef unsigned short bf16_t;
typedef short bf16x8 __attribute__((ext_vector_type(8)));
typedef float f32x4 __attribute__((ext_vector_type(4)));
typedef unsigned u32x4 __attribute__((ext_vector_type(4)));
constexpr int BM = 256, BK = 64, HALF = 128, HTB = HALF * BK * 2  , STAGE_BYTES = 8 * HTB, NXCD = 8, WGM = 8;

__host__ __device__ __forceinline__ int lds_byte(int r, int c) { const int st = (r >> 4) * 2 + (c >> 5), rr = r & 15, cc = c & 31, ob = rr * 64 + cc * 2; return st * 1024 + (ob ^ (((ob >> 9) & 1) << 5)); }
__host__ __device__ __forceinline__ void stage_rc(int b, int& R, int& C) { const int st = b / 1024, sb = b % 1024, swz = sb ^ (((sb >> 9) & 1) << 5); R = (st >> 1) * 16 + swz / 64; C = (st & 1) * 32 + (swz % 64) / 2; }
__host__ __device__ __forceinline__ int perm32(int rho) { const int n = rho >> 4, i = rho & 15; return 8 * (i >> 2) + 4 * n + (i & 3); }

struct Unit { int pm, pn, koff, nt; };
struct Unit_doc_;
struct Gemm { const bf16_t* A; const bf16_t* Bt; int M, N, K, ldk; };

struct StaticOrder {
    int nM, nN, nwg, G, c, pm0;
    __host__ __device__ void init(int M, int N, int G_, int c_, int pm0_ = 0) { nM = M / BM; nN = N / BM; nwg = nM * nN; G = G_; c = c_; pm0 = pm0_; }
    __host__ __device__ bool next(int i, Unit& u) const {
        const long L = (long)i * G + c; if (L >= nwg) return false;
        int wgid = (int)L; { const int q = nwg / NXCD, r = nwg % NXCD, xcd = wgid % NXCD, off = wgid / NXCD; wgid = (xcd < r ? xcd * (q + 1) : r * (q + 1) + (xcd - r) * q) + off; }
        const int nig = WGM * nN, gid = wgid / nig, fm = gid * WGM, gsz = (nM - fm) < WGM ? (nM - fm) : WGM;
        u.pm = pm0 + fm + ((wgid % nig) % gsz); u.pn = (wgid % nig) / gsz; u.koff = 0; u.nt = 0; return true;
    }
    __device__ __forceinline__ void a_ready(const Unit&) const {}
    __device__ __forceinline__ void done(const Unit&) const {}
};

struct SplitKOrder {
    int npm, npn, nks, kslice, G, c;
    __host__ __device__ bool next(int i, Unit& u) const {
        const int L = i * G + c; if (L >= npm * npn * nks) return false;
        const int t = L % (npm * npn); u.pn = t % npn; u.pm = t / npn; u.koff = (L / (npm * npn)) * kslice; u.nt = 0; return true;
    }
    __device__ __forceinline__ void a_ready(const Unit&) const {}
    __device__ __forceinline__ void done(const Unit&) const {}
};

struct ResidOrder {
    StaticOrder lat; int nctx, kslice, c;
    __host__ __device__ bool next(int i, Unit& u) const {
        const int nl = (lat.nwg - c + lat.G - 1) / lat.G; const bool first = nctx && (c & 1);
        const int j = first ? i - 1 : i;
        if (j >= 0 && j < nl) return lat.next(j, u);
        if (nctx && ((first && i == 0) || (!first && i == nl))) { const int t = c & 31; u.pn = t & 7; u.pm = 64 + (t >> 3); u.koff = (c >> 5) * kslice; u.nt = kslice / BK; return true; }
        return false;
    }
    __device__ __forceinline__ void a_ready(const Unit&) const {}
    __device__ __forceinline__ void done(const Unit&) const {}
};

__device__ __forceinline__ unsigned cvt_pk_bf16(float lo, float hi) { unsigned r; asm volatile("v_cvt_pk_bf16_f32 %0, %1, %2" : "=v"(r) : "v"(lo), "v"(hi)); return r; }

template <int ACT  > struct EpiBf16 {
    static constexpr bool PERM = true, AFTER_DRAIN = false;
    bf16_t* O; int ldc;
    __device__ __forceinline__ void operator()(const f32x4 (&acc)[2][2][4][2], const Unit& u, int wr, int wc, int fr, int fq) const {
        const int row0 = u.pm * BM + wr * 64 + fr; const int col0 = u.pn * BM + wc * 32 + 8 * fq;
#pragma unroll
        for (int ai = 0; ai < 2; ++ai)
#pragma unroll
            for (int m = 0; m < 4; ++m) { bf16_t* rowp = O + (size_t)(row0 + ai * HALF + m * 16) * ldc + col0;
#pragma unroll
                for (int bj = 0; bj < 2; ++bj) { f32x4 v0 = acc[ai][bj][m][0], v1 = acc[ai][bj][m][1];
                    if (ACT == 1) {
#pragma unroll
                        for (int j = 0; j < 4; ++j) { const float a = fmaxf(v0[j], 0.f), b = fmaxf(v1[j], 0.f); v0[j] = a * a; v1[j] = b * b; } }
                    u32x4 w; w.x = cvt_pk_bf16(v0[0], v0[1]); w.y = cvt_pk_bf16(v0[2], v0[3]); w.z = cvt_pk_bf16(v1[0], v1[1]); w.w = cvt_pk_bf16(v1[2], v1[3]);
                    *(u32x4*)(rowp + bj * HALF) = w; } }
    }
};
struct EpiResid {
    static constexpr bool PERM = false, AFTER_DRAIN = false;
    const float* Xin; float* X; int ldc; const float* gate; int gate_stride;
    __device__ __forceinline__ void operator()(const f32x4 (&acc)[2][2][4][2], const Unit& u, int wr, int wc, int fr, int fq) const {
        const int row0 = u.pm * BM + wr * 64 + fr, col0 = u.pn * BM + wc * 32 + 4 * fq;
        const float* g = gate + (size_t)(u.pm < 64 ? (u.pm >> 4) : 4) * gate_stride;
        f32x4 gv[2][2];
#pragma unroll
        for (int bj = 0; bj < 2; ++bj)
#pragma unroll
            for (int n = 0; n < 2; ++n) gv[bj][n] = *(const f32x4*)(g + col0 + bj * HALF + n * 16);
#pragma unroll
        for (int ai = 0; ai < 2; ++ai)
#pragma unroll
            for (int m = 0; m < 4; ++m) { const size_t off = (size_t)(row0 + ai * HALF + m * 16) * ldc + col0; const float* rin = Xin + off; float* rowp = X + off;
#pragma unroll
                for (int bj = 0; bj < 2; ++bj)
#pragma unroll
                    for (int n = 0; n < 2; ++n) { const f32x4 xo = *(const f32x4*)(rin + bj * HALF + n * 16); *(f32x4*)(rowp + bj * HALF + n * 16) = xo + gv[bj][n] * acc[ai][bj][m][n]; } }
    }
};

struct EpiUV {
    static constexpr bool PERM = true, AFTER_DRAIN = false;
    bf16_t* UV2;
    __device__ __forceinline__ void operator()(const f32x4 (&acc)[2][2][4][2], const Unit& u, int wr, int wc, int fr, int fq) const {
        const int s = u.koff >> 11, vpart = u.pm >> 3, i0 = (u.pm & 7) * BM + wr * 64 + fr, cc = wc * 32 + 8 * fq;
#pragma unroll
        for (int ai = 0; ai < 2; ++ai)
#pragma unroll
            for (int m = 0; m < 4; ++m) { const int idx = i0 + ai * HALF + m * 16;
#pragma unroll
                for (int bj = 0; bj < 2; ++bj) { const int bg = 2 * u.pn + bj; const f32x4 v0 = acc[ai][bj][m][0], v1 = acc[ai][bj][m][1];
                    u32x4 w; w.x = cvt_pk_bf16(v0[0], v0[1]); w.y = cvt_pk_bf16(v0[2], v0[3]); w.z = cvt_pk_bf16(v1[0], v1[1]); w.w = cvt_pk_bf16(v1[2], v1[3]);
                    bf16_t* colp = UV2 + (size_t)bg * 512 + s * 256 + cc;
                    if (vpart == 0) { *(u32x4*)(colp + (size_t)idx * 8192) = w; if (idx > 0) *(u32x4*)(colp + (size_t)(4096 - idx) * 8192) = w; }
                    else if (idx == 0) { const u32x4 z = {0u, 0u, 0u, 0u}; *(u32x4*)(colp + (size_t)2048 * 8192) = w; *(u32x4*)(colp + (size_t)2048 * 8192 + 128) = z; *(u32x4*)(colp + 128) = z; }
                    else { const u32x4 wn = w ^ (u32x4){0x80008000u, 0x80008000u, 0x80008000u, 0x80008000u}; *(u32x4*)(colp + (size_t)idx * 8192 + 128) = w; *(u32x4*)(colp + (size_t)(4096 - idx) * 8192 + 128) = wn; } } }
    }
};
struct EpiIn {
    static constexpr bool PERM = true, AFTER_DRAIN = false;
    bf16_t* O; int ldc; const float* rope; bf16_t* FT;
    __device__ __forceinline__ void operator()(const f32x4 (&acc)[2][2][4][2], const Unit& u, int wr, int wc, int fr, int fq) const {
        const int row0 = u.pm * BM + wr * 64 + fr; const int col0 = u.pn * BM + wc * 32 + 8 * fq;
        const int kind = (rope != nullptr && u.pm < 64) ? (u.pn < 12 ? 1 : (u.pn >= 18 ? 2 : 0)) : 0;
        if (kind == 0) {
#pragma unroll
            for (int ai = 0; ai < 2; ++ai)
#pragma unroll
                for (int m = 0; m < 4; ++m) { bf16_t* rowp = O + (size_t)(row0 + ai * HALF + m * 16) * ldc + col0;
#pragma unroll
                    for (int bj = 0; bj < 2; ++bj) { const f32x4 v0 = acc[ai][bj][m][0], v1 = acc[ai][bj][m][1];
                        u32x4 w; w.x = cvt_pk_bf16(v0[0], v0[1]); w.y = cvt_pk_bf16(v0[2], v0[3]); w.z = cvt_pk_bf16(v1[0], v1[1]); w.w = cvt_pk_bf16(v1[2], v1[3]);
                        *(u32x4*)(rowp + bj * HALF) = w; } }
        } else if (kind == 1) {
            const bool second = (fq & 2) != 0, upper = (fq & 2) != 0;
            const int ioff = 8 * (fq & 1);
#pragma unroll
            for (int ai = 0; ai < 2; ++ai)
#pragma unroll
                for (int m = 0; m < 4; ++m) { const int row = row0 + ai * HALF + m * 16, n = row & 4095, pos = (wc & 1) ? (n & 63) : (n >> 6);
                    const f32x4* tp = (const f32x4*)(rope + (size_t)(pos * 16 + ioff) * 2); const f32x4 t0 = tp[0], t1 = tp[1], t2 = tp[2], t3 = tp[3];
                    const float cs[8] = {t0[0], t0[2], t1[0], t1[2], t2[0], t2[2], t3[0], t3[2]}; const float sn[8] = {t0[1], t0[3], t1[1], t1[3], t2[1], t2[3], t3[1], t3[3]};
                    bf16_t* rowp = O + (size_t)row * ldc + col0;
#pragma unroll
                    for (int bj = 0; bj < 2; ++bj) { float v[8], o[8];
#pragma unroll
                        for (int j = 0; j < 4; ++j) { v[j] = acc[ai][bj][m][0][j]; v[4 + j] = acc[ai][bj][m][1][j]; }
#pragma unroll
                        for (int j = 0; j < 8; ++j) { const auto rr = __builtin_amdgcn_permlane32_swap(__builtin_bit_cast(unsigned, v[j]), __builtin_bit_cast(unsigned, v[j]), false, false);
                            const float pv = __builtin_bit_cast(float, upper ? rr[0] : rr[1]);
                            o[j] = second ? fmaf(pv, sn[j], v[j] * cs[j]) : fmaf(-pv, sn[j], v[j] * cs[j]); }
                        u32x4 w; w.x = cvt_pk_bf16(o[0], o[1]); w.y = cvt_pk_bf16(o[2], o[3]); w.z = cvt_pk_bf16(o[4], o[5]); w.w = cvt_pk_bf16(o[6], o[7]);
                        *(u32x4*)(rowp + bj * HALF) = w; } }
        } else {
#pragma unroll
            for (int ai = 0; ai < 2; ++ai)
#pragma unroll
                for (int m = 0; m < 4; ++m) { const int row = row0 + ai * HALF + m * 16, n = row & 4095, b = row >> 12;
#pragma unroll
                    for (int bj = 0; bj < 2; ++bj) { bf16_t* fp = FT + ((size_t)(b * 512 + (col0 - 4608) + bj * HALF)) * 4096 + n; const f32x4 v0 = acc[ai][bj][m][0], v1 = acc[ai][bj][m][1];
                        const unsigned w0 = cvt_pk_bf16(v0[0], v0[1]), w1 = cvt_pk_bf16(v0[2], v0[3]), w2 = cvt_pk_bf16(v1[0], v1[1]), w3 = cvt_pk_bf16(v1[2], v1[3]);
                        fp[0] = (bf16_t)w0; fp[4096] = (bf16_t)(w0 >> 16); fp[2 * 4096] = (bf16_t)w1; fp[3 * 4096] = (bf16_t)(w1 >> 16);
                        fp[4 * 4096] = (bf16_t)w2; fp[5 * 4096] = (bf16_t)(w2 >> 16); fp[6 * 4096] = (bf16_t)w3; fp[7 * 4096] = (bf16_t)(w3 >> 16); } }
        }
    }
};
struct EpiChan {
    static constexpr bool PERM = true, AFTER_DRAIN = false;
    bf16_t* MIX; float scale_lat, scale_ctx;
    __device__ __forceinline__ void operator()(const f32x4 (&acc)[2][2][4][2], const Unit& u, int wr, int wc, int fr, int fq) const {
        const bool lat = u.pm < 256; const float scale = lat ? scale_lat : scale_ctx;
        const int b = fr >> 2, g = fr & 3, kq0 = (lat ? u.pm : u.pm - 256) * 16 + wr * 4, j0 = wc * 32 + 8 * fq;
        const size_t rbase = lat ? (size_t)b * 4096 : (size_t)16384 + b * 256;
#pragma unroll
        for (int ai = 0; ai < 2; ++ai)
#pragma unroll
            for (int m = 0; m < 4; ++m) { const int k = kq0 + ai * 8 + m; const f32x4 v0 = acc[ai][0][m][0] * scale, v1 = acc[ai][0][m][1] * scale;
                u32x4 w; w.x = cvt_pk_bf16(v0[0], v0[1]); w.y = cvt_pk_bf16(v0[2], v0[3]); w.z = cvt_pk_bf16(v1[0], v1[1]); w.w = cvt_pk_bf16(v1[2], v1[3]);
                *(u32x4*)(MIX + (rbase + k) * 2048 + 1536 + g * 128 + j0) = w; }
    }
};

struct EpiPart {
    static constexpr bool PERM = false, AFTER_DRAIN = false;
    bf16_t* PART; int ldc; const float* gate; int kslice;
    __device__ __forceinline__ void operator()(const f32x4 (&acc)[2][2][4][2], const Unit& u, int wr, int wc, int fr, int fq) const {
        const int row0 = u.pm * BM + wr * 64 + fr, col0 = u.pn * BM + wc * 32 + 4 * fq; bf16_t* base = PART + (size_t)(u.koff / kslice) * 1024 * ldc;
        f32x4 gv[2][2];
#pragma unroll
        for (int bj = 0; bj < 2; ++bj)
#pragma unroll
            for (int n = 0; n < 2; ++n) gv[bj][n] = *(const f32x4*)(gate + col0 + bj * HALF + n * 16);
#pragma unroll
        for (int ai = 0; ai < 2; ++ai)
#pragma unroll
            for (int m = 0; m < 4; ++m) { bf16_t* rowp = base + (size_t)(row0 + ai * HALF + m * 16) * ldc + col0;
#pragma unroll
                for (int bj = 0; bj < 2; ++bj)
#pragma unroll
                    for (int n = 0; n < 2; ++n) { const f32x4 v = gv[bj][n] * acc[ai][bj][m][n]; typedef unsigned u32x2 __attribute__((ext_vector_type(2)));
                        u32x2 w; w.x = cvt_pk_bf16(v[0], v[1]); w.y = cvt_pk_bf16(v[2], v[3]); *(u32x2*)(rowp + bj * HALF + n * 16) = w; } }
    }
};

struct EpiResidPart {
    static constexpr bool PERM = true, AFTER_DRAIN = false;
    const float* Xin32; bf16_t* XL; int ldc; const float* gate; int gate_stride; bf16_t* PART; int kslice;
    __device__ __forceinline__ void operator()(const f32x4 (&acc)[2][2][4][2], const Unit& u, int wr, int wc, int fr, int fq) const {
        const int col0 = u.pn * BM + wc * 32 + 8 * fq; const bool lat = u.pm < 64;
        const float* g = gate + (size_t)(lat ? (u.pm >> 4) : 4) * gate_stride;
        f32x4 gv[2][2];
#pragma unroll
        for (int bj = 0; bj < 2; ++bj)
#pragma unroll
            for (int n = 0; n < 2; ++n) gv[bj][n] = *(const f32x4*)(g + col0 + bj * HALF + n * 4);
        if (lat) {
            const int row0 = u.pm * BM + wr * 64 + fr;
#pragma unroll
            for (int ai = 0; ai < 2; ++ai)
#pragma unroll
                for (int m = 0; m < 4; ++m) { const size_t off = (size_t)(row0 + ai * HALF + m * 16) * ldc + col0;
#pragma unroll
                    for (int bj = 0; bj < 2; ++bj) { f32x4 x0, x1;
                        if (Xin32 != nullptr) { x0 = *(const f32x4*)(Xin32 + off + bj * HALF); x1 = *(const f32x4*)(Xin32 + off + bj * HALF + 4); }
                        else { const u32x4 xw = *(const u32x4*)(XL + off + bj * HALF);
                            x0 = (f32x4){__builtin_bit_cast(float, xw.x << 16), __builtin_bit_cast(float, xw.x & 0xffff0000u), __builtin_bit_cast(float, xw.y << 16), __builtin_bit_cast(float, xw.y & 0xffff0000u)};
                            x1 = (f32x4){__builtin_bit_cast(float, xw.z << 16), __builtin_bit_cast(float, xw.z & 0xffff0000u), __builtin_bit_cast(float, xw.w << 16), __builtin_bit_cast(float, xw.w & 0xffff0000u)}; }
                        const f32x4 v0 = x0 + gv[bj][0] * acc[ai][bj][m][0], v1 = x1 + gv[bj][1] * acc[ai][bj][m][1];
                        u32x4 w; w.x = cvt_pk_bf16(v0[0], v0[1]); w.y = cvt_pk_bf16(v0[2], v0[3]); w.z = cvt_pk_bf16(v1[0], v1[1]); w.w = cvt_pk_bf16(v1[2], v1[3]);
                        *(u32x4*)(XL + off + bj * HALF) = w; } }
        } else {
            const int row0 = (u.pm - 64) * BM + wr * 64 + fr; bf16_t* base = PART + (size_t)(u.koff / kslice) * 1024 * ldc;
#pragma unroll
            for (int ai = 0; ai < 2; ++ai)
#pragma unroll
                for (int m = 0; m < 4; ++m) { bf16_t* rowp = base + (size_t)(row0 + ai * HALF + m * 16) * ldc + col0;
#pragma unroll
                    for (int bj = 0; bj < 2; ++bj) { const f32x4 v0 = gv[bj][0] * acc[ai][bj][m][0], v1 = gv[bj][1] * acc[ai][bj][m][1];
                        u32x4 w; w.x = cvt_pk_bf16(v0[0], v0[1]); w.y = cvt_pk_bf16(v0[2], v0[3]); w.z = cvt_pk_bf16(v1[0], v1[1]); w.w = cvt_pk_bf16(v1[2], v1[3]);
                        *(u32x4*)(rowp + bj * HALF) = w; } }
        }
    }
};

template <class Epi, class Sched, bool ALIGN_EPI = false, bool SP2 = false>
__device__ __forceinline__ void gemm_phase(PG8_LAS unsigned char* lds, const Gemm g, const Sched& S, const Epi& E, const int tid) {
    const int wid = __builtin_amdgcn_readfirstlane(tid >> 6), lane = tid & 63, wr = wid >> 2, wc = wid & 3, fr = lane & 15, fq = lane >> 4;
    const int K = g.ldk, ntd = g.K / BK;
    unsigned voffA[2], voffB[2];
#pragma unroll
    for (int i = 0; i < 2; ++i) { int R, C; stage_rc(tid * 16 + i * 8192, R, C); const int Rb = Epi::PERM ? ((R & ~31) + perm32(R & 31)) : R;
        voffA[i] = (unsigned)(R * K + C) * 2u; voffB[i] = (unsigned)(Rb * K + C) * 2u; }
    const size_t kstep = (size_t)(BK * 2);
    const size_t hstep = (size_t)HALF * K * 2;
    const size_t tstep = 2 * hstep;
    const unsigned ldsw = (unsigned)wid * 1024u;
    const int aoff = lds_byte(wr * 64 + fr, fq * 8), boff = lds_byte(wc * 32 + fr, fq * 8);
#define PG8_SA(b, h) (((b) * 2 + (h)) * HTB)
#define PG8_SB(b, h) ((4 + (b) * 2 + (h)) * HTB)
#define PG8_STAGE(bufoff, gbase, voff) do { _Pragma("unroll") for (int _i = 0; _i < 2; ++_i) \
        __builtin_amdgcn_global_load_lds((const unsigned*)((const char*)(gbase) + (voff)[_i]), (PG8_LAS unsigned*)(lds + (bufoff) + ldsw + _i * 8192), 16, 0, 0); } while (0)
#define PG8_LDA(dst, b, h) do { _Pragma("unroll") for (int m = 0; m < 4; ++m) _Pragma("unroll") for (int k = 0; k < 2; ++k) dst[m][k] = *(const PG8_LAS bf16x8*)(lds + PG8_SA(b, h) + aoff + m * 2048 + k * 1024); } while (0)
#define PG8_LDB(dst, b, h) do { _Pragma("unroll") for (int n = 0; n < 2; ++n) _Pragma("unroll") for (int k = 0; k < 2; ++k) dst[n][k] = *(const PG8_LAS bf16x8*)(lds + PG8_SB(b, h) + boff + n * 2048 + k * 1024); } while (0)
#define PG8_MMA(ai, bj, At, Bt) do { __builtin_amdgcn_s_setprio(1); _Pragma("unroll") for (int m = 0; m < 4; ++m) _Pragma("unroll") for (int n = 0; n < 2; ++n) _Pragma("unroll") for (int k = 0; k < 2; ++k) \
        acc[ai][bj][m][n] = __builtin_amdgcn_mfma_f32_16x16x32_bf16(Bt[n][k], At[m][k], acc[ai][bj][m][n], 0, 0, 0); __builtin_amdgcn_s_setprio(0); } while (0)
#define PG8_WAIT_V(n) asm volatile("s_waitcnt vmcnt(" #n ")" ::: "memory")
#define PG8_WAIT_L(n) asm volatile("s_waitcnt lgkmcnt(" #n ")" ::: "memory")
#define PG8_BAR __builtin_amdgcn_s_barrier()
#define PG8_SCHED __builtin_amdgcn_sched_barrier(0)
    Unit cur, nxt; int ui = 0;
    if (!S.next(0, cur)) return;
    int nt = cur.nt ? cur.nt : ntd;
    f32x4 acc[2][2][4][2];
#pragma unroll
    for (int a = 0; a < 2; ++a)
#pragma unroll
        for (int b = 0; b < 2; ++b)
#pragma unroll
            for (int m = 0; m < 4; ++m)
#pragma unroll
                for (int n = 0; n < 2; ++n) acc[a][b][m][n] = (f32x4){0.f, 0.f, 0.f, 0.f};
    bf16x8 At[4][2], B0[2][2], B1[2][2];
    const char* cA = (const char*)g.A + (size_t)cur.pm * tstep + (size_t)cur.koff * 2; const char* cB = (const char*)g.Bt + (size_t)cur.pn * tstep + (size_t)cur.koff * 2;
    S.a_ready(cur);
    if constexpr (SP2) {
        PG8_STAGE(PG8_SB(0, 0), cB, voffB); PG8_STAGE(PG8_SB(0, 1), cB + hstep, voffB); PG8_STAGE(PG8_SA(0, 0), cA, voffA); PG8_STAGE(PG8_SA(0, 1), cA + hstep, voffA);
        if (wr == 1) PG8_BAR;
        PG8_WAIT_V(2); PG8_BAR;
        PG8_STAGE(PG8_SB(1, 0), cB + kstep, voffB); PG8_STAGE(PG8_SA(1, 0), cA + kstep, voffA); PG8_STAGE(PG8_SB(1, 1), cB + hstep + kstep, voffB);
        PG8_WAIT_V(6); PG8_BAR;
    } else {
        PG8_STAGE(PG8_SB(0, 0), cB, voffB); PG8_STAGE(PG8_SA(0, 0), cA, voffA); PG8_STAGE(PG8_SB(0, 1), cB + hstep, voffB); PG8_STAGE(PG8_SA(0, 1), cA + hstep, voffA);
        if (wr == 1) PG8_BAR;
        PG8_WAIT_V(4); PG8_BAR;
        PG8_STAGE(PG8_SB(1, 0), cB + kstep, voffB); PG8_STAGE(PG8_SA(1, 0), cA + kstep, voffA); PG8_STAGE(PG8_SB(1, 1), cB + hstep + kstep, voffB);
        PG8_WAIT_V(6); PG8_BAR;
    }
    for (;;) {
        const bool has_next = S.next(ui + 1, nxt);
        const char* nA = has_next ? (const char*)g.A + (size_t)nxt.pm * tstep + (size_t)nxt.koff * 2 : cA; const char* nB = has_next ? (const char*)g.Bt + (size_t)nxt.pn * tstep + (size_t)nxt.koff * 2 : cB;
        for (int t = 0; t < nt; t += 2) {
            const bool last = (t == nt - 2);
            const char* a1 = cA + (size_t)(t + 1) * kstep;
            const char* a2 = last ? nA : cA + (size_t)(t + 2) * kstep; const char* b2 = last ? nB : cB + (size_t)(t + 2) * kstep;
            const char* a3 = a2 + kstep; const char* b3 = b2 + kstep;
            if (last && has_next) S.a_ready(nxt);
            if constexpr (SP2) {
            PG8_LDB(B0, 0, 0); PG8_LDB(B1, 0, 1); PG8_SCHED; PG8_LDA(At, 0, 0); PG8_STAGE(PG8_SA(1, 1), a1 + hstep, voffA);
            PG8_WAIT_V(8); PG8_WAIT_L(0); PG8_BAR; PG8_MMA(0, 0, At, B0); PG8_MMA(0, 1, At, B1); PG8_BAR; PG8_SCHED;
            PG8_LDA(At, 0, 1); PG8_STAGE(PG8_SB(0, 0), b2, voffB); PG8_STAGE(PG8_SB(0, 1), b2 + hstep, voffB); PG8_STAGE(PG8_SA(0, 0), a2, voffA);
            PG8_WAIT_V(8); PG8_WAIT_L(0); PG8_BAR; PG8_MMA(1, 0, At, B0); PG8_MMA(1, 1, At, B1); PG8_BAR; PG8_SCHED;
            PG8_LDB(B0, 1, 0); PG8_LDB(B1, 1, 1); PG8_SCHED; PG8_LDA(At, 1, 0); PG8_STAGE(PG8_SA(0, 1), a2 + hstep, voffA);
            PG8_WAIT_V(8); PG8_WAIT_L(0); PG8_BAR; PG8_MMA(0, 0, At, B0); PG8_MMA(0, 1, At, B1); PG8_BAR; PG8_SCHED;
            PG8_LDA(At, 1, 1); PG8_STAGE(PG8_SB(1, 0), b3, voffB); PG8_STAGE(PG8_SB(1, 1), b3 + hstep, voffB); PG8_STAGE(PG8_SA(1, 0), a3, voffA);
            PG8_WAIT_V(8); PG8_WAIT_L(0); PG8_BAR; PG8_MMA(1, 0, At, B0); PG8_MMA(1, 1, At, B1); PG8_BAR; PG8_SCHED;
            } else {
            PG8_LDB(B0, 0, 0); PG8_SCHED; PG8_LDA(At, 0, 0); PG8_STAGE(PG8_SA(1, 1), a1 + hstep, voffA);
            PG8_WAIT_L(8); PG8_BAR; PG8_WAIT_L(0); PG8_MMA(0, 0, At, B0); PG8_BAR; PG8_SCHED;
            PG8_LDB(B1, 0, 1); PG8_STAGE(PG8_SB(0, 0), b2, voffB);
            PG8_BAR; PG8_WAIT_L(0); PG8_MMA(0, 1, At, B1); PG8_BAR;
            PG8_LDA(At, 0, 1); PG8_STAGE(PG8_SA(0, 0), a2, voffA);
            PG8_BAR; PG8_WAIT_L(0); PG8_MMA(1, 0, At, B0); PG8_BAR; PG8_SCHED;
            PG8_STAGE(PG8_SB(0, 1), b2 + hstep, voffB);
            PG8_WAIT_V(6); PG8_BAR; PG8_MMA(1, 1, At, B1); PG8_BAR;
            PG8_LDB(B0, 1, 0); PG8_SCHED; PG8_LDA(At, 1, 0); PG8_STAGE(PG8_SA(0, 1), a2 + hstep, voffA);
            PG8_WAIT_L(8); PG8_BAR; PG8_WAIT_L(0); PG8_MMA(0, 0, At, B0); PG8_BAR; PG8_SCHED;
            PG8_LDB(B1, 1, 1); PG8_STAGE(PG8_SB(1, 0), b3, voffB);
            PG8_BAR; PG8_WAIT_L(0); PG8_MMA(0, 1, At, B1); PG8_BAR;
            PG8_LDA(At, 1, 1); PG8_STAGE(PG8_SA(1, 0), a3, voffA);
            PG8_BAR; PG8_WAIT_L(0); PG8_MMA(1, 0, At, B0); PG8_BAR; PG8_SCHED;
            PG8_STAGE(PG8_SB(1, 1), b3 + hstep, voffB);
            PG8_WAIT_V(6); PG8_BAR; PG8_MMA(1, 1, At, B1); PG8_BAR;
            }
        }
        if constexpr (ALIGN_EPI) { if (wr == 0) PG8_BAR; }
        if constexpr (!Epi::AFTER_DRAIN) { E(acc, cur, wr, wc, fr, fq); S.done(cur); }
        if (!has_next) break;
#pragma unroll
        for (int a = 0; a < 2; ++a)
#pragma unroll
            for (int b = 0; b < 2; ++b)
#pragma unroll
                for (int m = 0; m < 4; ++m)
#pragma unroll
                    for (int n = 0; n < 2; ++n) acc[a][b][m][n] = (f32x4){0.f, 0.f, 0.f, 0.f};
        cur = nxt; cA = nA; cB = nB; ++ui; nt = cur.nt ? cur.nt : ntd;
        if constexpr (ALIGN_EPI) { if (wr == 1) PG8_BAR; }
    }
    PG8_WAIT_V(0);
    if constexpr (!ALIGN_EPI) { if (wr == 0) PG8_BAR; }
    PG8_BAR;
    if constexpr (Epi::AFTER_DRAIN) { E.fused(acc, cur, wr, wc, fr, fq, lds, wid, lane); S.done(cur); }
#undef PG8_SA
#undef PG8_SB
#undef PG8_STAGE
#undef PG8_LDA
#undef PG8_LDB
#undef PG8_MMA
#undef PG8_WAIT_V
#undef PG8_WAIT_L
#undef PG8_BAR
#undef PG8_SCHED
}
}

constexpr int NWAVES = 8;
#ifndef MK_ONE_LAUNCH
#define MK_ONE_LAUNCH 1
#endif

constexpr int DM = 2048, NB = 4, SEQ = 4096, DEPTH = 4, NCTX = 256, INW = 5120, DFF = 8192, ADA = 6 * DM;
constexpr int MLAT = NB * SEQ, MCTX = NB * NCTX, MALL = MLAT + MCTX;
constexpr float LAM_INIT1 = 0.35550906759096926f, LAM_INIT3 = 0.5560582041556405f;

constexpr size_t MiB = 1u << 20;
constexpr size_t WS_CTL = 0, CTL_ZERO_BYTES = 1 * MiB;
constexpr size_t WS_MOD = 1 * MiB;
constexpr size_t WS_LAM = 2 * MiB;
constexpr size_t WS_ADAP = 1353 * MiB;
constexpr size_t WS_WIN = 16 * MiB, WS_WOUT = 96 * MiB, WS_W1 = 128 * MiB, WS_W2 = 256 * MiB;
constexpr size_t WS_X = 384 * MiB;
constexpr size_t WS_H = 520 * MiB;
constexpr size_t WS_P = 588 * MiB;
constexpr size_t WS_MIX = 758 * MiB;
constexpr size_t WS_HID = 826 * MiB;
constexpr size_t WS_VN = 826 * MiB;
constexpr size_t WS_O12 = 826 * MiB;
constexpr size_t WS_FA = 1030 * MiB, WS_FB = 1064 * MiB;
constexpr size_t WS_CS = 1098 * MiB;
constexpr size_t WS_CT = 1162 * MiB;
constexpr size_t WS_FT = 1163 * MiB;
constexpr size_t WS_UV = 1281 * MiB;
constexpr size_t WS_SGW = 1214 * MiB;
constexpr size_t WS_ROPE = 1215 * MiB;
constexpr size_t WS_PART = 1217 * MiB;
constexpr size_t WS_STAMP = 1216 * MiB;
constexpr size_t WS_XL = 1385 * MiB;
constexpr size_t WS_END = 1449 * MiB;
constexpr int CW_BAR = 4096;

constexpr int RING_OFF = 0, RING_BYTES = 131072;
constexpr int LDSCTL_OFF = RING_BYTES, MISC_OFF = LDSCTL_OFF + 320;
constexpr int LDS_BYTES = 147456;

#define GAS __attribute__((address_space(1)))
#define LAS __attribute__((address_space(3)))
typedef unsigned short bf16;
typedef unsigned v4u __attribute__((ext_vector_type(4)));
typedef unsigned v2u __attribute__((ext_vector_type(2)));
typedef float f32x4 __attribute__((ext_vector_type(4)));
typedef float f32x2 __attribute__((ext_vector_type(2)));
#define LDS_WAIT() asm volatile("s_waitcnt lgkmcnt(0)" ::: "memory")
__device__ __forceinline__ unsigned f2bf(float f) { unsigned u = __builtin_bit_cast(unsigned, f); return (u + 0x7fffu + ((u >> 16) & 1u)) >> 16; }
__device__ __forceinline__ unsigned pk2(float lo, float hi) { return f2bf(lo) | (f2bf(hi) << 16); }
__device__ __forceinline__ float bf2f(bf16 v) { return __builtin_bit_cast(float, (unsigned)v << 16); }
__device__ __forceinline__ float bflo(unsigned w) { return __builtin_bit_cast(float, w << 16); }
__device__ __forceinline__ float bfhi(unsigned w) { return __builtin_bit_cast(float, w & 0xffff0000u); }
template <int M> __device__ __forceinline__ float shx(float v) { return __builtin_bit_cast(float, __builtin_amdgcn_ds_swizzle(__builtin_bit_cast(int, v), (M << 10) | 0x1f)); }
__device__ __forceinline__ float half_sum(float v) { return __builtin_bit_cast(float, __builtin_amdgcn_readlane(__builtin_bit_cast(int, v), 0)) + __builtin_bit_cast(float, __builtin_amdgcn_readlane(__builtin_bit_cast(int, v), 32)); }
#define XB_TMO      128
#define XB_XCNT(j)  (256  + 64 * (j))
#define XB_XSUB(j)  (1280 + 64 * (j))
#define XB_XGEN(j)  (2304 + 64 * (j))
#define XB_TOP      3328
#define XB_TOPGEN   3392
#define XCD_BAR_WORDS 3456
#define XB_SPIN_CAP (1u << 20)

__device__ __forceinline__ unsigned xb_ld(unsigned* p)              { return __hip_atomic_load(p, __ATOMIC_RELAXED, __HIP_MEMORY_SCOPE_AGENT); }
__device__ __forceinline__ unsigned xb_add(unsigned* p, unsigned v) { return __hip_atomic_fetch_add(p, v, __ATOMIC_RELAXED, __HIP_MEMORY_SCOPE_AGENT); }
__device__ __forceinline__ unsigned xb_xcc_id() { return (unsigned)__builtin_amdgcn_s_getreg((3 << 11) | 20) & 0xFu; }
#define XB_SPIN(cond, bar) do { unsigned _sp = 0; while (cond) { __builtin_amdgcn_s_sleep(1); \
    if ((++_sp & 255u) == 0u) { if (xb_ld(&(bar)[XB_TMO])) break; if (_sp > XB_SPIN_CAP) { atomicAdd(&(bar)[XB_TMO], 1u); break; } } } } while (0)

struct XcdBarrier {
    unsigned* bar; unsigned x;
    volatile LAS unsigned* st;
};

__device__ __forceinline__ XcdBarrier xcd_barrier_post(unsigned* bar, volatile LAS unsigned* st) {
    XcdBarrier b; b.bar = bar; b.x = xb_xcc_id(); b.st = st;
    if (threadIdx.x == 0) (void)xb_add(&bar[XB_XCNT(b.x)], 1u);
    return b;
}
__device__ __forceinline__ void xcd_barrier_complete(unsigned* bar, unsigned x, unsigned& nloc, unsigned& nx) {
    const unsigned G = gridDim.x * gridDim.y * gridDim.z;
    unsigned sum, cnt, mine, sp = 0u;
    for (;;) {
        sum = 0u; cnt = 0u; mine = 0u;
#pragma unroll
        for (unsigned j = 0; j < 16; ++j) { const unsigned c = xb_ld(&bar[XB_XCNT(j)]); sum += c; cnt += (c > 0u) ? 1u : 0u; mine = (j == x) ? c : mine; }
        if (sum == G) break;
        __builtin_amdgcn_s_sleep(1);
        if ((++sp & 255u) == 0u) { if (xb_ld(&bar[XB_TMO])) break; if (sp > XB_SPIN_CAP) { atomicAdd(&bar[XB_TMO], 1u); break; } }
    }
    nloc = mine > 0u ? mine : 1u; nx = cnt > 0u ? cnt : 1u;
}

__device__ __forceinline__ void xcd_barrier(const XcdBarrier& b) {
    asm volatile("s_waitcnt vmcnt(0)" ::: "memory");
    __syncthreads();
    if (threadIdx.x == 0) {
        unsigned* bar = b.bar;
        __builtin_amdgcn_s_waitcnt(0);
        unsigned nloc = b.st[0], nx = b.st[1];
        if (nloc == 0u) { xcd_barrier_complete(bar, b.x, nloc, nx); b.st[0] = nloc; b.st[1] = nx; }
        const unsigned old = xb_add(&bar[XB_XSUB(b.x)], 1u);
        const unsigned gen = old / nloc;
        if (old + 1u == (gen + 1u) * nloc) {
            __builtin_amdgcn_fence(__ATOMIC_RELEASE, "agent");
            asm volatile("s_waitcnt vmcnt(0)" ::: "memory");
            const unsigned og = xb_add(&bar[XB_TOP], 1u);
            const unsigned tg = og / nx;
            if (og + 1u == (tg + 1u) * nx) xb_add(&bar[XB_TOPGEN], 1u);
            else XB_SPIN(xb_ld(&bar[XB_TOPGEN]) == tg, bar);
            __builtin_amdgcn_fence(__ATOMIC_ACQUIRE, "agent");
            xb_add(&bar[XB_XGEN(b.x)], 1u);
            asm volatile("s_waitcnt vmcnt(0)" ::: "memory");
        } else {
            XB_SPIN(xb_ld(&bar[XB_XGEN(b.x)]) == gen, bar);
            __builtin_amdgcn_fence(__ATOMIC_ACQUIRE, "agent");
            asm volatile("s_waitcnt vmcnt(0)" ::: "memory");
        }
    }
    __syncthreads();
}

__device__ __forceinline__ float wave_sum(float v) {
    v += shx<1>(v); v += shx<2>(v); v += shx<4>(v); v += shx<8>(v); v += shx<16>(v);
    return half_sum(v);
}
__device__ __forceinline__ void p0_transpose_item(const float* W, int K, int N, bf16* WT, LAS float* scr, int item, int lane) {
    const int nblk = N / 32, kb = item / nblk, nb = item % nblk, k0 = 64 * kb, n0 = 32 * nb;
    float wv[32];
#pragma unroll
    for (int i = 0; i < 32; ++i) wv[i] = __builtin_nontemporal_load(W + (size_t)(k0 + 2 * i + (lane >> 5)) * N + n0 + (lane & 31));
#pragma unroll
    for (int i = 0; i < 32; ++i) scr[(2 * i + (lane >> 5)) * 33 + (lane & 31)] = wv[i];
    LDS_WAIT(); asm volatile("" ::: "memory");
    const int c = lane & 7;
#pragma unroll
    for (int j = 0; j < 4; ++j) { const int n = (lane >> 3) + 8 * j; const LAS float* s = scr + (8 * c) * 33 + n;
        v4u o; o.x = pk2(s[0 * 33], s[1 * 33]); o.y = pk2(s[2 * 33], s[3 * 33]); o.z = pk2(s[4 * 33], s[5 * 33]); o.w = pk2(s[6 * 33], s[7 * 33]);
        *(GAS v4u*)(WT + (size_t)(n0 + n) * K + k0 + 8 * c) = o; }
    LDS_WAIT(); asm volatile("" ::: "memory");
}

template <int MODE>
__device__ __forceinline__ void norm_rows(const float* Xlat, const float* Xctx, float* X, bf16* H, float* OUT, const float* gain, const float* modl, int sh_chunk, int R0, int M, int gw, int NGW, int lane, const bf16* part, bool wb_ctx) {
    for (int row0 = R0 + gw; row0 < M; row0 += 2 * NGW) {
        f32x4 v[2][8]; float ss[2];
#pragma unroll
        for (int u = 0; u < 2; ++u) { const int row = row0 + u * NGW; if (row < M) {
            const GAS f32x4* xr = (const GAS f32x4*)(row < MLAT ? Xlat + (size_t)row * DM : Xctx + (size_t)(row - MLAT) * DM) + lane;
#pragma unroll
            for (int j = 0; j < 8; ++j) v[u][j] = xr[64 * j]; } }
#pragma unroll
        for (int u = 0; u < 2; ++u) { const int row = row0 + u * NGW; if (row < M) {
            if (MODE == 0 && row >= MLAT) {
                if (part != nullptr) {
#pragma unroll
                    for (int ks = 0; ks < 8; ++ks) { const GAS v2u* pr = (const GAS v2u*)(part + ((size_t)ks * MCTX + (row - MLAT)) * DM) + lane;
#pragma unroll
                        for (int j = 0; j < 8; ++j) { const v2u w = pr[64 * j]; v[u][j] += (f32x4){bflo(w.x), bfhi(w.x), bflo(w.y), bfhi(w.y)}; } } }
                if (part != nullptr || wb_ctx) { GAS f32x4* xw = (GAS f32x4*)(X + (size_t)row * DM) + lane;
#pragma unroll
                    for (int j = 0; j < 8; ++j) xw[64 * j] = v[u][j]; }
            }
            float s = 0.f;
#pragma unroll
            for (int j = 0; j < 8; ++j) s += (v[u][j].x * v[u][j].x + v[u][j].y * v[u][j].y) + (v[u][j].z * v[u][j].z + v[u][j].w * v[u][j].w);
            ss[u] = s; } else ss[u] = 0.f; }
        ss[0] = wave_sum(ss[0]); ss[1] = wave_sum(ss[1]);
#pragma unroll
        for (int u = 0; u < 2; ++u) { const int row = row0 + u * NGW; if (row < M) {
            const float rstd = 1.0f / sqrtf(ss[u] * (1.0f / DM) + 1e-6f);
            if (MODE == 0) {
                const float* mr = modl + (size_t)(row < MLAT ? (row >> 12) : 4) * ADA;
                const GAS f32x4* sh = (const GAS f32x4*)(mr + sh_chunk * DM) + lane; const GAS f32x4* sc = (const GAS f32x4*)(mr + (sh_chunk + 1) * DM) + lane;
                const GAS f32x4* gg = (const GAS f32x4*)gain + lane;
                GAS v2u* o8 = (GAS v2u*)(H + (size_t)row * DM) + lane;
#pragma unroll
                for (int j = 0; j < 8; ++j) { const f32x4 g4 = gg[64 * j], s4 = sc[64 * j], h4 = sh[64 * j]; const f32x4 y = v[u][j] * rstd * g4 * (s4 + 1.0f) + h4;
                    v2u w; w.x = pk2(y.x, y.y); w.y = pk2(y.z, y.w); o8[64 * j] = w; }
            } else {
                const GAS f32x4* gg = (const GAS f32x4*)gain + lane; GAS f32x4* o = (GAS f32x4*)(OUT + (size_t)row * DM) + lane;
#pragma unroll
                for (int j = 0; j < 8; ++j) o[64 * j] = v[u][j] * rstd * gg[64 * j];
            } } }
    }
}

__device__ __forceinline__ void load_row8(const float* X32, const bf16* XL, size_t rowoff, int lane, f32x4 (&v)[8]) {
    if (X32 != nullptr) { const GAS f32x4* xr = (const GAS f32x4*)(X32 + rowoff) + 2 * lane;
#pragma unroll
        for (int j = 0; j < 4; ++j) { v[2 * j] = xr[128 * j]; v[2 * j + 1] = xr[128 * j + 1]; } }
    else { const GAS v4u* xr = (const GAS v4u*)(XL + rowoff) + lane;
#pragma unroll
        for (int j = 0; j < 4; ++j) { const v4u w = xr[64 * j]; v[2 * j] = (f32x4){bflo(w.x), bfhi(w.x), bflo(w.y), bfhi(w.y)}; v[2 * j + 1] = (f32x4){bflo(w.z), bfhi(w.z), bflo(w.w), bfhi(w.w)}; } }
}
__device__ __forceinline__ void norm_lat_rows(const float* X32, const bf16* XL, bf16* H, const float* gain, const float* modl, int sh_chunk, int w, int NW, int lane) {
    const int b = w & 3, w4 = w >> 2, NW4 = NW >> 2;
    f32x4 gp[8], sh[8];
    { const float* mr = modl + (size_t)b * ADA; const GAS f32x4* shp = (const GAS f32x4*)(mr + sh_chunk * DM) + 2 * lane; const GAS f32x4* scp = (const GAS f32x4*)(mr + (sh_chunk + 1) * DM) + 2 * lane; const GAS f32x4* gg = (const GAS f32x4*)gain + 2 * lane;
#pragma unroll
      for (int j = 0; j < 4; ++j) { gp[2 * j] = gg[128 * j] * (scp[128 * j] + 1.0f); gp[2 * j + 1] = gg[128 * j + 1] * (scp[128 * j + 1] + 1.0f); sh[2 * j] = shp[128 * j]; sh[2 * j + 1] = shp[128 * j + 1]; } }
    for (int r0 = w4; r0 < SEQ; r0 += 2 * NW4) {
        f32x4 v[2][8]; float ss[2] = {0.f, 0.f};
#pragma unroll
        for (int u = 0; u < 2; ++u) { const int r = r0 + u * NW4; if (r < SEQ) load_row8(X32, XL, ((size_t)b * SEQ + r) * DM, lane, v[u]); }
#pragma unroll
        for (int u = 0; u < 2; ++u) { const int r = r0 + u * NW4; if (r < SEQ) { float s = 0.f;
#pragma unroll
            for (int j = 0; j < 8; ++j) s += (v[u][j].x * v[u][j].x + v[u][j].y * v[u][j].y) + (v[u][j].z * v[u][j].z + v[u][j].w * v[u][j].w);
            ss[u] = s; } }
        ss[0] = wave_sum(ss[0]); ss[1] = wave_sum(ss[1]);
#pragma unroll
        for (int u = 0; u < 2; ++u) { const int r = r0 + u * NW4; if (r < SEQ) { const float rstd = 1.0f / sqrtf(ss[u] * (1.0f / DM) + 1e-6f);
            GAS v4u* o16 = (GAS v4u*)(H + ((size_t)b * SEQ + r) * DM) + lane;
#pragma unroll
            for (int j = 0; j < 4; ++j) { const f32x4 y0 = v[u][2 * j] * rstd * gp[2 * j] + sh[2 * j], y1 = v[u][2 * j + 1] * rstd * gp[2 * j + 1] + sh[2 * j + 1];
                v4u wv; wv.x = pk2(y0.x, y0.y); wv.y = pk2(y0.z, y0.w); wv.z = pk2(y1.x, y1.y); wv.w = pk2(y1.z, y1.w); o16[64 * j] = wv; } } }
    }
}
__device__ __forceinline__ void final_norm_rows(const bf16* XL, float* OUT, const float* gain, int gw, int NGW, int lane) {
    f32x4 gg[8];
    { const GAS f32x4* gp = (const GAS f32x4*)gain + 2 * lane;
#pragma unroll
      for (int j = 0; j < 4; ++j) { gg[2 * j] = gp[128 * j]; gg[2 * j + 1] = gp[128 * j + 1]; } }
    for (int row0 = gw; row0 < MLAT; row0 += 2 * NGW) {
        f32x4 v[2][8]; float ss[2] = {0.f, 0.f};
#pragma unroll
        for (int u = 0; u < 2; ++u) { const int row = row0 + u * NGW; if (row < MLAT) load_row8(nullptr, XL, (size_t)row * DM, lane, v[u]); }
#pragma unroll
        for (int u = 0; u < 2; ++u) { const int row = row0 + u * NGW; if (row < MLAT) { float s = 0.f;
#pragma unroll
            for (int j = 0; j < 8; ++j) s += (v[u][j].x * v[u][j].x + v[u][j].y * v[u][j].y) + (v[u][j].z * v[u][j].z + v[u][j].w * v[u][j].w);
            ss[u] = s; } }
        ss[0] = wave_sum(ss[0]); ss[1] = wave_sum(ss[1]);
#pragma unroll
        for (int u = 0; u < 2; ++u) { const int row = row0 + u * NGW; if (row < MLAT) { const float rstd = 1.0f / sqrtf(ss[u] * (1.0f / DM) + 1e-6f);
            GAS f32x4* o = (GAS f32x4*)(OUT + (size_t)row * DM) + 2 * lane;
#pragma unroll
            for (int j = 0; j < 4; ++j) { o[128 * j] = v[u][2 * j] * rstd * gg[2 * j]; o[128 * j + 1] = v[u][2 * j + 1] * rstd * gg[2 * j + 1]; } } }
    }
}

template <int N> __device__ __forceinline__ float dot_bf(const bf16* kp, const float (&q)[N]) {
    float s = 0.f;
#pragma unroll
    for (int c = 0; c < N / 8; ++c) { const v4u w = ((const GAS v4u*)kp)[c];
        s += q[8 * c + 0] * bflo(w.x) + q[8 * c + 1] * bfhi(w.x) + q[8 * c + 2] * bflo(w.y) + q[8 * c + 3] * bfhi(w.y)
           + q[8 * c + 4] * bflo(w.z) + q[8 * c + 5] * bfhi(w.z) + q[8 * c + 6] * bflo(w.w) + q[8 * c + 7] * bfhi(w.w); }
    return s;
}
template <int DQK, int DVS, class KeyF>
__device__ __forceinline__ void naive_attn(const bf16* P, const float (&q)[DQK], int nkeys, const KeyF& keyf, float (&o)[DVS]) {
    float m = -1e30f, l = 0.f;
    for (int i = 0; i < nkeys; ++i) { size_t koff, voff; float bias; keyf(i, koff, voff, bias);
        const float s = dot_bf<DQK>(P + koff, q) + bias; const float mn = fmaxf(m, s); l = l * __expf(m - mn) + __expf(s - mn); m = mn; }
    const float il = 1.0f / l;
#pragma unroll
    for (int j = 0; j < DVS; ++j) o[j] = 0.f;
    for (int i = 0; i < nkeys; ++i) { size_t koff, voff; float bias; keyf(i, koff, voff, bias);
        const float s = dot_bf<DQK>(P + koff, q) + bias; const float p = __expf(s - m) * il;
#pragma unroll
        for (int c = 0; c < DVS / 8; ++c) { const v4u w = ((const GAS v4u*)(P + voff))[c];
            o[8 * c + 0] += p * bflo(w.x); o[8 * c + 1] += p * bfhi(w.x); o[8 * c + 2] += p * bflo(w.y); o[8 * c + 3] += p * bfhi(w.y);
            o[8 * c + 4] += p * bflo(w.z); o[8 * c + 5] += p * bfhi(w.z); o[8 * c + 6] += p * bflo(w.w); o[8 * c + 7] += p * bfhi(w.w); } }
}
template <int N> __device__ __forceinline__ void load_q(const bf16* qp, float scale, float (&q)[N]) {
#pragma unroll
    for (int c = 0; c < N / 8; ++c) { const v4u w = ((const GAS v4u*)qp)[c];
        q[8 * c + 0] = scale * bflo(w.x); q[8 * c + 1] = scale * bfhi(w.x); q[8 * c + 2] = scale * bflo(w.y); q[8 * c + 3] = scale * bfhi(w.y);
        q[8 * c + 4] = scale * bflo(w.z); q[8 * c + 5] = scale * bfhi(w.z); q[8 * c + 6] = scale * bflo(w.w); q[8 * c + 7] = scale * bfhi(w.w); }
}
template <int N> __device__ __forceinline__ void store_bf(bf16* op, const float (&o)[N]) {
#pragma unroll
    for (int c = 0; c < N / 8; ++c) { v4u w; w.x = pk2(o[8 * c], o[8 * c + 1]); w.y = pk2(o[8 * c + 2], o[8 * c + 3]); w.z = pk2(o[8 * c + 4], o[8 * c + 5]); w.w = pk2(o[8 * c + 6], o[8 * c + 7]); ((GAS v4u*)op)[c] = w; }
}

namespace da {
using bf16x8 = __attribute__((ext_vector_type(8))) short;
using s16x4  = __attribute__((ext_vector_type(4))) short;
using f32x16 = __attribute__((ext_vector_type(16))) float;
using u32x4  = __attribute__((ext_vector_type(4))) unsigned;
constexpr int KVBLK = 64;
constexpr int SHM_V = KVBLK * 128 * 2, SHM_K = KVBLK * 128 * 2;
constexpr int LDS_X2 = 0;
constexpr int LDS_WS = 2 * SHM_V + 2 * SHM_K;
constexpr int LDS_OT = LDS_WS + 4096;
constexpr int LDS_WS3 = 3 * SHM_V + 3 * SHM_K, LDS_OT3 = 4 * SHM_V;
constexpr float SCALE = 0.125f;
constexpr float THR = 8.f;
#define DA_KSWZ(row, colB) ((row) * 256 + ((colB) ^ (((row) & 15) << 4)))
#define DA_SBAR() __builtin_amdgcn_sched_barrier(0)
__device__ __forceinline__ int crow(int r, int hi) { return (r & 3) + 8 * (r >> 2) + 4 * hi; }
__device__ __forceinline__ unsigned cvtpk(float lo, float hi) { unsigned r; asm volatile("v_cvt_pk_bf16_f32 %0, %1, %2" : "=v"(r) : "v"(lo), "v"(hi)); return r; }

__device__ __forceinline__ void partialSM(f32x16& p0, f32x16& p1, float& m_reg, float& mn, float& alpha) {
  constexpr float C = SCALE * 1.4426950408889634f;
  float pmax = p0[0];
#pragma unroll
  for (int r = 1; r < 16; ++r) pmax = fmaxf(pmax, p0[r]);
#pragma unroll
  for (int r = 0; r < 16; ++r) pmax = fmaxf(pmax, p1[r]);
  { auto rr = __builtin_amdgcn_permlane32_swap(__float_as_uint(pmax), __float_as_uint(pmax), false, false);
    pmax = fmaxf(__uint_as_float(rr[0]), __uint_as_float(rr[1])); }
  if (__builtin_expect(__all(pmax - m_reg <= THR / SCALE), 1)) { mn = m_reg; alpha = 1.f; }
  else { mn = fmaxf(m_reg, pmax); alpha = __builtin_amdgcn_exp2f((m_reg - mn) * C); m_reg = mn; }
  const float mnC = -mn * C;
#pragma unroll
  for (int r = 0; r < 16; ++r) p0[r] = fmaf(p0[r], C, mnC);
#pragma unroll
  for (int r = 0; r < 16; ++r) p1[r] = fmaf(p1[r], C, mnC);
#pragma unroll
  for (int r = 0; r < 16; ++r) p0[r] = __builtin_amdgcn_exp2f(p0[r]);
}
__device__ __forceinline__ void finishSM(f32x16& p0, f32x16& p1, float alpha, float& l_reg, bf16x8& pa0, bf16x8& pa1, bf16x8& pa2, bf16x8& pa3) {
#pragma unroll
  for (int r = 0; r < 16; ++r) p1[r] = __builtin_amdgcn_exp2f(p1[r]);
  float ps = 0;
#pragma unroll
  for (int r = 0; r < 16; ++r) ps += p0[r];
#pragma unroll
  for (int r = 0; r < 16; ++r) ps += p1[r];
  { auto rr = __builtin_amdgcn_permlane32_swap(__float_as_uint(ps), __float_as_uint(ps), false, false);
    ps = __uint_as_float(rr[0]) + __uint_as_float(rr[1]); }
  l_reg = l_reg * alpha + ps;
#define DA_PK4(P, BASE, OUT) do { unsigned a0 = cvtpk(P[BASE + 0], P[BASE + 1]), a1 = cvtpk(P[BASE + 2], P[BASE + 3]);   \
    unsigned b0 = cvtpk(P[BASE + 4], P[BASE + 5]), b1 = cvtpk(P[BASE + 6], P[BASE + 7]);                              \
    auto r0 = __builtin_amdgcn_permlane32_swap(a0, b0, false, false); auto r1 = __builtin_amdgcn_permlane32_swap(a1, b1, false, false); \
    u32x4 w = {r0[0], r1[0], r0[1], r1[1]}; OUT = *reinterpret_cast<bf16x8*>(&w); } while (0)
  DA_PK4(p0, 0, pa0); DA_PK4(p0, 8, pa1); DA_PK4(p1, 0, pa2); DA_PK4(p1, 8, pa3);
#undef DA_PK4
}
__device__ __forceinline__ void qkt(f32x16& p0, f32x16& p1, const LAS char* Ks, const bf16x8 (&qr)[4], int r32, int hi, int mapcolB) {
  p0 = f32x16{}; p1 = f32x16{};
#pragma unroll
  for (int d0 = 0; d0 < 4; ++d0) { const int cb = mapcolB + (d0 * 16 + hi * 8) * 2;
    const bf16x8 b0 = *reinterpret_cast<const LAS bf16x8*>(Ks + DA_KSWZ(r32, cb));
    const bf16x8 b1 = *reinterpret_cast<const LAS bf16x8*>(Ks + DA_KSWZ(32 + r32, cb));
    p0 = __builtin_amdgcn_mfma_f32_32x32x16_bf16(b0, qr[d0], p0, 0, 0, 0);
    p1 = __builtin_amdgcn_mfma_f32_32x32x16_bf16(b1, qr[d0], p1, 0, 0, 0); }
}
__device__ __forceinline__ bf16x8 k_read(int addr) { bf16x8 r; asm volatile("ds_read_b128 %0, %1" : "=&v"(r) : "v"(addr) : "memory"); return r; }
__device__ __forceinline__ bf16x8 k_read_hi(int addr) { bf16x8 r; asm volatile("ds_read_b128 %0, %1 offset:8192" : "=&v"(r) : "v"(addr) : "memory"); return r; }
__device__ __forceinline__ void qkt_pipe(f32x16& p0, f32x16& p1, const LAS char* Ks, const bf16x8 (&qr)[4], int r32, int hi, int mapcolB, const f32x16& seed) {
  const int kb = (int)(uintptr_t)Ks;
  const int a0 = kb + DA_KSWZ(r32, mapcolB + (0 * 16 + hi * 8) * 2), a1 = kb + DA_KSWZ(r32, mapcolB + (1 * 16 + hi * 8) * 2), a2 = kb + DA_KSWZ(r32, mapcolB + (2 * 16 + hi * 8) * 2), a3 = kb + DA_KSWZ(r32, mapcolB + (3 * 16 + hi * 8) * 2);
  bf16x8 k0 = k_read(a0), k1 = k_read_hi(a0), k2 = k_read(a1), k3 = k_read_hi(a1), k4 = k_read(a2), k5 = k_read_hi(a2), k6 = k_read(a3), k7 = k_read_hi(a3);
  asm volatile("s_waitcnt lgkmcnt(6)" : "+v"(k0), "+v"(k1) :: "memory");
  p0 = __builtin_amdgcn_mfma_f32_32x32x16_bf16(k0, qr[0], seed, 0, 0, 0); p1 = __builtin_amdgcn_mfma_f32_32x32x16_bf16(k1, qr[0], seed, 0, 0, 0);
  asm volatile("s_waitcnt lgkmcnt(4)" : "+v"(k2), "+v"(k3) :: "memory");
  p0 = __builtin_amdgcn_mfma_f32_32x32x16_bf16(k2, qr[1], p0, 0, 0, 0); p1 = __builtin_amdgcn_mfma_f32_32x32x16_bf16(k3, qr[1], p1, 0, 0, 0);
  asm volatile("s_waitcnt lgkmcnt(2)" : "+v"(k4), "+v"(k5) :: "memory");
  p0 = __builtin_amdgcn_mfma_f32_32x32x16_bf16(k4, qr[2], p0, 0, 0, 0); p1 = __builtin_amdgcn_mfma_f32_32x32x16_bf16(k5, qr[2], p1, 0, 0, 0);
  asm volatile("s_waitcnt lgkmcnt(0)" : "+v"(k6), "+v"(k7) :: "memory");
  p0 = __builtin_amdgcn_mfma_f32_32x32x16_bf16(k6, qr[3], p0, 0, 0, 0); p1 = __builtin_amdgcn_mfma_f32_32x32x16_bf16(k7, qr[3], p1, 0, 0, 0);
}
__device__ __forceinline__ int v_st(int k, int c) { const int kk = (k & ~0xC) | ((k & 4) << 1) | ((k & 8) >> 1); return ((kk >> 3) * 4 + (c >> 5)) * 512 + ((kk & 7) * 32 + (c & 31)) * 2; }
__device__ __forceinline__ int v_rd_base(int lane) { return ((lane & 3) << 3) | (((lane >> 2) & 3) << 6) | (((lane >> 4) & 1) << 5) | (((lane >> 5) & 1) << 8); }
constexpr int v_rd_off(int d0, int ks, int half) { return d0 * 512 + ks * 4096 + half * 2048; }
template <int OFF> __device__ __forceinline__ s16x4 tr_read(int vb) {
  s16x4 r; asm volatile("ds_read_b64_tr_b16 %0, %1 offset:%2" : "=&v"(r) : "v"(vb), "i"(OFF) : "memory"); return r;
}
template <int D0> __device__ __forceinline__ void pv_one(f32x16& od, int vb, bf16x8 pa0, bf16x8 pa1, bf16x8 pa2, bf16x8 pa3) {
  const s16x4 l0 = tr_read<v_rd_off(D0, 0, 0)>(vb), h0 = tr_read<v_rd_off(D0, 0, 1)>(vb), l1 = tr_read<v_rd_off(D0, 1, 0)>(vb), h1 = tr_read<v_rd_off(D0, 1, 1)>(vb);
  const s16x4 l2 = tr_read<v_rd_off(D0, 2, 0)>(vb), h2 = tr_read<v_rd_off(D0, 2, 1)>(vb), l3 = tr_read<v_rd_off(D0, 3, 0)>(vb), h3 = tr_read<v_rd_off(D0, 3, 1)>(vb);
  asm volatile("s_waitcnt lgkmcnt(0)" ::: "memory"); DA_SBAR();
#define DA_PK(L, H) (bf16x8){L[0], L[1], L[2], L[3], H[0], H[1], H[2], H[3]}
  od = __builtin_amdgcn_mfma_f32_32x32x16_bf16(pa0, DA_PK(l0, h0), od, 0, 0, 0);
  od = __builtin_amdgcn_mfma_f32_32x32x16_bf16(pa1, DA_PK(l1, h1), od, 0, 0, 0);
  od = __builtin_amdgcn_mfma_f32_32x32x16_bf16(pa2, DA_PK(l2, h2), od, 0, 0, 0);
  od = __builtin_amdgcn_mfma_f32_32x32x16_bf16(pa3, DA_PK(l3, h3), od, 0, 0, 0);
#undef DA_PK
}
__device__ __forceinline__ void pv_d0(f32x16 (&o)[4], int vb, bf16x8 pa0, bf16x8 pa1, bf16x8 pa2, bf16x8 pa3) {
  pv_one<0>(o[0], vb, pa0, pa1, pa2, pa3); pv_one<1>(o[1], vb, pa0, pa1, pa2, pa3); pv_one<2>(o[2], vb, pa0, pa1, pa2, pa3); pv_one<3>(o[3], vb, pa0, pa1, pa2, pa3);
}

__device__ __forceinline__ float fma1(float a, float c, float b) { float d; asm("v_fma_f32 %0, %1, %2, %3" : "=v"(d) : "v"(a), "s"(c), "v"(b)); return d; }
template <class MID>
__device__ __forceinline__ void pv_sm(f32x16 (&o)[4], int vb, bf16x8 pa0, bf16x8 pa1, bf16x8 pa2, bf16x8 pa3, f32x16& p0, f32x16& p1, float& m_reg, float& alpha, f32x16& negm, MID&& mid) {
  s16x4 a0, a1, a2, a3, a4, a5, a6, a7, b0, b1, b2, b3, b4, b5, b6, b7; float x, y;
#define DA_TR4(D0, X) X##0 = tr_read<v_rd_off(D0, 0, 0)>(vb); X##1 = tr_read<v_rd_off(D0, 0, 1)>(vb); X##2 = tr_read<v_rd_off(D0, 1, 0)>(vb); X##3 = tr_read<v_rd_off(D0, 1, 1)>(vb); \
    X##4 = tr_read<v_rd_off(D0, 2, 0)>(vb); X##5 = tr_read<v_rd_off(D0, 2, 1)>(vb); X##6 = tr_read<v_rd_off(D0, 3, 0)>(vb); X##7 = tr_read<v_rd_off(D0, 3, 1)>(vb)
#define DA_LW() asm volatile("s_waitcnt lgkmcnt(0)" ::: "memory")
#define DA_PK(L, H) (bf16x8){L[0], L[1], L[2], L[3], H[0], H[1], H[2], H[3]}
#define DA_MF(od, pa, L, H) od = __builtin_amdgcn_mfma_f32_32x32x16_bf16(pa, DA_PK(L, H), od, 0, 0, 0)
#define DA_MX3(v, a, b) v = fmaxf(fmaxf(v, a), b)
#define DA_EX(i) do { float t_ = p0[i]; asm volatile("v_exp_f32 %0, %0" : "+v"(t_)); p0[i] = t_; } while (0)
  DA_TR4(0, a); DA_LW(); DA_SBAR();
  DA_TR4(1, b);
  DA_MF(o[0], pa0, a0, a1); x = fmaxf(fmaxf(p0[0], p0[1]), p0[2]); DA_MX3(x, p0[3], p0[4]); DA_MX3(x, p0[5], p0[6]); DA_MX3(x, p0[7], p0[8]); DA_SBAR();
  DA_MF(o[0], pa1, a2, a3); DA_MX3(x, p0[9], p0[10]); DA_MX3(x, p0[11], p0[12]); DA_MX3(x, p0[13], p0[14]); x = fmaxf(x, p0[15]); DA_SBAR();
  DA_MF(o[0], pa2, a4, a5); y = fmaxf(fmaxf(p1[0], p1[1]), p1[2]); DA_MX3(y, p1[3], p1[4]); DA_MX3(y, p1[5], p1[6]); DA_MX3(y, p1[7], p1[8]); DA_SBAR();
  DA_MF(o[0], pa3, a6, a7); DA_MX3(y, p1[9], p1[10]); DA_MX3(y, p1[11], p1[12]); DA_MX3(y, p1[13], p1[14]); DA_MX3(y, p1[15], x); DA_LW(); DA_SBAR();
  DA_TR4(2, a);
  DA_MF(o[1], pa0, b0, b1);
  { auto rr = __builtin_amdgcn_permlane32_swap(__float_as_uint(y), __float_as_uint(y), false, false);
    const float pmax = fmaxf(__uint_as_float(rr[0]), __uint_as_float(rr[1]));
    alpha = 1.0f;
    if (__builtin_expect(!__all(pmax <= THR * 1.4426950408889634f), 0)) {
      const float sh = fmaxf(pmax, 0.0f); alpha = __builtin_amdgcn_exp2f(-sh); m_reg += sh;
#pragma unroll
      for (int r = 0; r < 16; ++r) { p0[r] -= sh; p1[r] -= sh; negm[r] = -m_reg; }
    } }
  DA_SBAR();
  DA_MF(o[1], pa1, b2, b3); DA_EX(0); DA_EX(1); DA_SBAR();
  DA_MF(o[1], pa2, b4, b5); DA_EX(2); DA_SBAR();
  DA_MF(o[1], pa3, b6, b7); DA_EX(3); DA_EX(4); DA_LW(); DA_SBAR();
  DA_TR4(3, b);
  DA_MF(o[2], pa0, a0, a1); mid(); DA_EX(5); DA_SBAR();
  DA_MF(o[2], pa1, a2, a3); DA_EX(6); DA_EX(7); DA_SBAR();
  DA_MF(o[2], pa2, a4, a5); DA_EX(8); DA_SBAR();
  DA_MF(o[2], pa3, a6, a7); DA_EX(9); DA_EX(10); DA_LW(); DA_SBAR();
  DA_MF(o[3], pa0, b0, b1); DA_EX(11); DA_SBAR();
  DA_MF(o[3], pa1, b2, b3); DA_EX(12); DA_EX(13); DA_SBAR();
  DA_MF(o[3], pa2, b4, b5); DA_EX(14); DA_SBAR();
  DA_MF(o[3], pa3, b6, b7); DA_EX(15); DA_SBAR();
#undef DA_TR4
#undef DA_EX
#undef DA_LW
#undef DA_PK
#undef DA_MF
#undef DA_MX3
}

__device__ __forceinline__ void unit(const bf16* __restrict__ P, bf16* __restrict__ MIX, int qrow0, int hh, int lat_row0, int n_lat_tiles, int ctx_row0,
                                     float lam, float post, const float* __restrict__ sub_g, LAS char* lds, int tid) {
  const int wid = __builtin_amdgcn_readfirstlane(tid >> 6), lane = tid & 63, r32 = lane & 31, hi = lane >> 5, mp = wid >> 2, wq = wid & 3;
  LAS char* V_lds = lds; LAS char* K_lds = lds + 3 * SHM_V;
  LAS float* wsl = (LAS float*)(lds + LDS_WS3) + wid * 64; LAS float* li_l = wsl; LAS float* al_l = wsl + 32;
  float m_reg = 0.f, l_reg = 0; f32x16 o[4] = {}; bf16x8 qr[4];
  { const bf16* Qw = P + (size_t)(qrow0 + wq * 32 + r32) * INW + hh * 128 + mp * 64 + hi * 8;
#pragma unroll
    for (int d0 = 0; d0 < 4; ++d0) qr[d0] = *reinterpret_cast<const bf16x8*>(Qw + d0 * 16); }
#pragma unroll
  for (int d0 = 0; d0 < 4; ++d0)
#pragma unroll
    for (int e = 0; e < 8; ++e) qr[d0][e] = (short)f2bf(bf2f((bf16)(unsigned short)qr[d0][e]) * (SCALE * 1.4426950408889634f));
  const int mapcolB = mp * 128;
  const int sr = tid >> 4, sc = (tid & 15) * 8, vst0 = v_st(sr, sc), vst1 = v_st(32 + sr, sc);
  const int vb0 = (int)(uintptr_t)V_lds + v_rd_base(lane);
  const bf16* Kc = P + 1536 + hh * 128 + sc; const bf16* Vc = P + 3072 + hh * 128 + sc;
  const int NT = n_lat_tiles + 4;
  unsigned voK[2], voV[2];
#pragma unroll
  for (int j = 0; j < 2; ++j) { const int p = 2 * wid + j, row = 4 * p + (lane >> 4), chunk = (lane & 15) ^ (row & 15); voK[j] = (unsigned)(row * INW * 2 + chunk * 16);
    const int sub = 2 * p + (lane >> 5), kk = (sub >> 2) * 8 + ((lane & 31) >> 2), c = (sub & 3) * 32 + (lane & 3) * 8, k = (kk & ~0xC) | ((kk & 4) << 1) | ((kk & 8) >> 1); voV[j] = (unsigned)(k * INW * 2 + c * 2); }
  const char* Kb = (const char*)(P + 1536 + hh * 128); const char* Vb = (const char*)(P + 3072 + hh * 128);
#define DA_TROW(j) ((j) < n_lat_tiles ? lat_row0 + (j) * KVBLK : ctx_row0 + ((j) - n_lat_tiles) * KVBLK)
#define DA_DMA(off, j) do { const size_t _t = (size_t)DA_TROW(j) * (INW * 2); \
    _Pragma("unroll") for (int _i = 0; _i < 2; ++_i) { \
      __builtin_amdgcn_global_load_lds((const unsigned*)(Kb + _t + voK[_i]), (LAS unsigned*)(K_lds + (off) + wid * 2048 + _i * 1024), 16, 0, 0); \
      __builtin_amdgcn_global_load_lds((const unsigned*)(Vb + _t + voV[_i]), (LAS unsigned*)(V_lds + (off) + wid * 2048 + _i * 1024), 16, 0, 0); } } while (0)
#define DA_SWAIT() asm volatile("s_waitcnt vmcnt(0)" ::: "memory")
#define DA_RESC(a) do { if (__any((a) < 1.f)) { if (hi == 0) al_l[r32] = (a); asm volatile("s_waitcnt lgkmcnt(0)" ::: "memory"); \
    _Pragma("unroll") for (int d = 0; d < 4; ++d) _Pragma("unroll") for (int r = 0; r < 16; ++r) o[d][r] *= al_l[crow(r, hi)]; } } while (0)
  f32x16 pA0, pA1, pB0, pB1, negm; float alA, alB; bf16x8 pa0, pa1, pa2, pa3;
  DA_DMA(0, 0); DA_DMA(SHM_V, 1); DA_SWAIT(); __syncthreads();
  qkt(pA0, pA1, K_lds, qr, r32, hi, mapcolB);
  { float pm = pA0[0];
#pragma unroll
    for (int r = 1; r < 16; ++r) pm = fmaxf(pm, pA0[r]);
#pragma unroll
    for (int r = 0; r < 16; ++r) pm = fmaxf(pm, pA1[r]);
    { auto rr = __builtin_amdgcn_permlane32_swap(__float_as_uint(pm), __float_as_uint(pm), false, false); pm = fmaxf(__uint_as_float(rr[0]), __uint_as_float(rr[1])); }
    m_reg = pm; alA = 1.0f;
#pragma unroll
    for (int r = 0; r < 16; ++r) { pA0[r] = __builtin_amdgcn_exp2f(pA0[r] - pm); pA1[r] = pA1[r] - pm; negm[r] = -pm; } }
  if (wid >= 4) __builtin_amdgcn_s_setprio(1);
  int bp = 0, bc = SHM_V, bn = 2 * SHM_V;
  for (int s = 1; s + 1 < NT; s += 2) {
    DA_DMA(bn, s + 1);
    DA_SBAR(); qkt_pipe(pB0, pB1, K_lds + bc, qr, r32, hi, mapcolB, negm);
    finishSM(pA0, pA1, alA, l_reg, pa0, pa1, pa2, pa3); DA_SBAR();
    pv_sm(o, vb0 + bp, pa0, pa1, pa2, pa3, pB0, pB1, m_reg, alB, negm, [] {});
    DA_RESC(alB); DA_SWAIT(); __syncthreads();
    if (s + 2 < NT) DA_DMA(bp, s + 2);
    DA_SBAR(); qkt_pipe(pA0, pA1, K_lds + bn, qr, r32, hi, mapcolB, negm);
    finishSM(pB0, pB1, alB, l_reg, pa0, pa1, pa2, pa3); DA_SBAR();
    pv_sm(o, vb0 + bc, pa0, pa1, pa2, pa3, pA0, pA1, m_reg, alA, negm, [] {});
    DA_RESC(alA); DA_SWAIT(); __syncthreads();
    { const int t = bp; bp = bn; bn = bc; bc = t; }
  }
  DA_SBAR(); qkt_pipe(pB0, pB1, K_lds + bc, qr, r32, hi, mapcolB, negm);
  finishSM(pA0, pA1, alA, l_reg, pa0, pa1, pa2, pa3); DA_SBAR();
  pv_sm(o, vb0 + bp, pa0, pa1, pa2, pa3, pB0, pB1, m_reg, alB, negm, [] {});
  DA_RESC(alB);
  finishSM(pB0, pB1, alB, l_reg, pa0, pa1, pa2, pa3); DA_SBAR();
  pv_d0(o, vb0 + bc, pa0, pa1, pa2, pa3);
  __builtin_amdgcn_s_setprio(0);
  int te = tid; asm volatile("" : "+v"(te)); const int lane_e = te & 63, r32e = lane_e & 31, hie = lane_e >> 5;
  if (hie == 0) li_l[r32e] = l_reg; asm volatile("s_waitcnt lgkmcnt(0)" ::: "memory");
  float rli[16];
#pragma unroll
  for (int r = 0; r < 16; ++r) rli[r] = 1.0f / li_l[crow(r, hie)];
  __syncthreads();
  LAS float* X2 = (LAS float*)(lds + LDS_X2);
  if (mp == 1) {
#pragma unroll
    for (int r = 0; r < 16; ++r) { const int row = wq * 32 + crow(r, hie);
#pragma unroll
      for (int d0 = 0; d0 < 4; ++d0) X2[row * 128 + d0 * 32 + r32e] = lam * o[d0][r] * rli[r]; }
  }
  __syncthreads();
  if (mp == 0) {
    float ss[16];
#pragma unroll
    for (int r = 0; r < 16; ++r) { const int row = wq * 32 + crow(r, hie); float s = 0.f;
#pragma unroll
      for (int d0 = 0; d0 < 4; ++d0) { const float v = o[d0][r] * rli[r] - X2[row * 128 + d0 * 32 + r32e]; o[d0][r] = v; s += v * v; }
      ss[r] = s; }
#pragma unroll
    for (int r = 0; r < 16; ++r) { float s = ss[r];
      s += shx<1>(s); s += shx<2>(s); s += shx<4>(s); s += shx<8>(s); s += shx<16>(s);
      ss[r] = post / sqrtf(s * (1.0f / 128.0f) + 1e-6f); }
    float gsub[4];
#pragma unroll
    for (int d0 = 0; d0 < 4; ++d0) gsub[d0] = sub_g[d0 * 32 + r32e];
    LAS bf16* OT = (LAS bf16*)(lds + LDS_OT3);
#pragma unroll
    for (int r = 0; r < 16; ++r) { const int row = wq * 32 + crow(r, hie);
#pragma unroll
      for (int d0 = 0; d0 < 4; ++d0) OT[row * 128 + d0 * 32 + r32e] = (bf16)f2bf(o[d0][r] * ss[r] * gsub[d0]); }
  }
  __syncthreads();
  { const LAS bf16* OT = (const LAS bf16*)(lds + LDS_OT3);
#pragma unroll
    for (int i = 0; i < 4; ++i) { const int chunk = te + 512 * i, row = chunk >> 4, c8 = (chunk & 15) * 8;
      *(GAS v4u*)(MIX + (size_t)(qrow0 + row) * DM + hh * 128 + c8) = *(const LAS v4u*)(OT + row * 128 + c8); } }
  __syncthreads();
#undef DA_TROW
#undef DA_DMA
#undef DA_SWAIT
#undef DA_RESC
}
}

namespace na {
using da::bf16x8; using da::s16x4; using da::f32x16; using da::u32x4; using da::crow; using da::SHM_V; using da::SHM_K; using da::LDS_WS;
constexpr float QSCALE = 0.08838834764831845f, LOG2E = 1.4426950408889634f, THR2 = 8.f * LOG2E, NEG = -1e30f;
constexpr int LDS_TAB = LDS_WS + 8 * 64 * 4 + 512;
__device__ __forceinline__ void qkt(f32x16& p0, f32x16& p1, const LAS char* Ks, const bf16x8 (&qr)[8], int r32, int hi) {
  p0 = f32x16{}; p1 = f32x16{};
#pragma unroll
  for (int d0 = 0; d0 < 8; ++d0) { const int cb = (d0 * 16 + hi * 8) * 2;
    const bf16x8 b0 = *reinterpret_cast<const LAS bf16x8*>(Ks + DA_KSWZ(r32, cb));
    const bf16x8 b1 = *reinterpret_cast<const LAS bf16x8*>(Ks + DA_KSWZ(32 + r32, cb));
    p0 = __builtin_amdgcn_mfma_f32_32x32x16_bf16(b0, qr[d0], p0, 0, 0, 0);
    p1 = __builtin_amdgcn_mfma_f32_32x32x16_bf16(b1, qr[d0], p1, 0, 0, 0); }
}
__device__ __forceinline__ void bias_mask(f32x16& p0, f32x16& p1, int mode, const LAS float* lanetab, int kb) {
  constexpr float C = QSCALE * LOG2E;
  if (mode == 0) {
#pragma unroll
    for (int r = 0; r < 16; ++r) { p0[r] *= C; p1[r] *= C; }
  } else if (mode == 2) {
#pragma unroll
    for (int r = 0; r < 16; ++r) { p0[r] = NEG; p1[r] = NEG; }
  } else {
#pragma unroll
    for (int r = 0; r < 16; ++r) { const int c = (r & 3) + 8 * (r >> 2);
      const float b0 = lanetab[c], b1 = lanetab[c + 32];
      p0[r] = ((unsigned)(kb + c) < 16u) ? fmaf(p0[r], C, b0) : NEG;
      p1[r] = ((unsigned)(kb + c + 32) < 16u) ? fmaf(p1[r], C, b1) : NEG; }
  }
}
__device__ __forceinline__ void partialSM(f32x16& p0, f32x16& p1, float& m_reg, float& mn, float& alpha) {
  float pmax = p0[0];
#pragma unroll
  for (int r = 1; r < 16; ++r) pmax = fmaxf(pmax, p0[r]);
#pragma unroll
  for (int r = 0; r < 16; ++r) pmax = fmaxf(pmax, p1[r]);
  { auto rr = __builtin_amdgcn_permlane32_swap(__float_as_uint(pmax), __float_as_uint(pmax), false, false);
    pmax = fmaxf(__uint_as_float(rr[0]), __uint_as_float(rr[1])); }
  if (__builtin_expect(__all(pmax - m_reg <= THR2), 1)) { mn = m_reg; alpha = 1.f; }
  else { mn = fmaxf(m_reg, pmax); alpha = __builtin_amdgcn_exp2f(m_reg - mn); m_reg = mn; }
#pragma unroll
  for (int r = 0; r < 16; ++r) p0[r] = __builtin_amdgcn_exp2f(p0[r] - mn);
#pragma unroll
  for (int r = 0; r < 16; ++r) p1[r] = p1[r] - mn;
}

__device__ __forceinline__ void unit(const bf16* __restrict__ P, bf16* __restrict__ MIX, int qrow0, int hh, bool lat, int b, int r0, const float* __restrict__ rpb_h, LAS char* lds, int tid) {
  const int wid = __builtin_amdgcn_readfirstlane(tid >> 6), lane = tid & 63, r32 = lane & 31, hi = lane >> 5;
  LAS char* V_lds = lds; LAS char* K_lds = lds + 2 * SHM_V;
  LAS float* wsl = (LAS float*)(lds + LDS_WS) + wid * 64; LAS float* li_l = wsl; LAS float* al_l = wsl + 32;
  LAS float* tab = (LAS float*)(lds + LDS_TAB);
  if (lat) for (int i = tid; i < 15 * 31; i += 512) tab[i] = rpb_h[i] * LOG2E;
  float m_reg = -1e28f, l_reg = 0; f32x16 o[4] = {}; bf16x8 qr[8];
  { const bf16* Qw = P + (size_t)(qrow0 + wid * 32 + r32) * INW + 2048 + hh * 128 + hi * 8;
#pragma unroll
    for (int d0 = 0; d0 < 8; ++d0) qr[d0] = *reinterpret_cast<const bf16x8*>(Qw + d0 * 16); }
  const int qgr = r0 + (wid >> 1), rs = min(max(qgr - 4, 0), 56), rbase = min(max(r0 - 4, 0), 52);
  const int qc = 32 * (wid & 1) + r32, cs = min(max(qc - 8, 0), 48), lt0 = 4 * hi - qc + 15, kb0 = 4 * hi - cs;
  const int sr = tid >> 4, sc = (tid & 15) * 8, vst0 = da::v_st(sr, sc), vst1 = da::v_st(32 + sr, sc);
  const int vb0 = (int)(uintptr_t)V_lds + da::v_rd_base(lane);
  const bf16* Kc = P + 3072 + hh * 128 + sc; const bf16* Vc = P + 4096 + hh * 128 + sc;
  const int NLT = lat ? 12 : 0, NT = NLT + 4;
  const int lat_row0 = b * SEQ + rbase * 64, ctx_row0 = MLAT + b * NCTX;
  unsigned voK[2], voV[2];
#pragma unroll
  for (int j = 0; j < 2; ++j) { const int p = 2 * wid + j, row = 4 * p + (lane >> 4), chunk = (lane & 15) ^ (row & 15); voK[j] = (unsigned)(row * INW * 2 + chunk * 16);
    const int sub = 2 * p + (lane >> 5), kk = (sub >> 2) * 8 + ((lane & 31) >> 2), c = (sub & 3) * 32 + (lane & 3) * 8, k = (kk & ~0xC) | ((kk & 4) << 1) | ((kk & 8) >> 1); voV[j] = (unsigned)(k * INW * 2 + c * 2); }
  const char* Kb = (const char*)(P + 3072 + hh * 128); const char* Vb = (const char*)(P + 4096 + hh * 128);
#define NA_TROW(j) ((j) < NLT ? lat_row0 + (j) * 64 : ctx_row0 + ((j) - NLT) * 64)
#define NA_DMA(bb, j) do { const size_t _t = (size_t)NA_TROW(j) * (INW * 2); \
    _Pragma("unroll") for (int _i = 0; _i < 2; ++_i) { \
      __builtin_amdgcn_global_load_lds((const unsigned*)(Kb + _t + voK[_i]), (LAS unsigned*)(K_lds + (bb) * SHM_K + wid * 2048 + _i * 1024), 16, 0, 0); \
      __builtin_amdgcn_global_load_lds((const unsigned*)(Vb + _t + voV[_i]), (LAS unsigned*)(V_lds + (bb) * SHM_V + wid * 2048 + _i * 1024), 16, 0, 0); } } while (0)
#define NA_RESC(a) do { if (__any((a) < 1.f)) { if (hi == 0) al_l[r32] = (a); asm volatile("s_waitcnt lgkmcnt(0)" ::: "memory"); \
    _Pragma("unroll") for (int d = 0; d < 4; ++d) _Pragma("unroll") for (int r = 0; r < 16; ++r) o[d][r] *= al_l[crow(r, hi)]; } } while (0)
#define NA_BM(p0, p1, j) do { const int _kr = rbase + (j); const int _mode = (j) >= NLT ? 0 : ((_kr >= rs && _kr < rs + 8) ? 1 : 2); \
    int _lt = min(max(_kr - qgr + 7, 0), 14) * 31 + lt0, _kb = kb0; asm volatile("" : "+v"(_lt), "+v"(_kb)); \
    bias_mask(p0, p1, _mode, tab + _lt, _kb); } while (0)
  f32x16 p0, p1; float mn, al; bf16x8 pa0, pa1, pa2, pa3;
  NA_DMA(0, 0); asm volatile("s_waitcnt vmcnt(0)" ::: "memory"); __syncthreads();
  for (int j = 0; j < NT; ++j) {
    const int bb = j & 1;
    const bool live = j >= NLT || (rbase + j >= rs && rbase + j < rs + 8);
    if (j + 1 < NT) NA_DMA(bb ^ 1, j + 1);
    if (live) {
      DA_SBAR(); qkt(p0, p1, K_lds + bb * SHM_K, qr, r32, hi); NA_BM(p0, p1, j); partialSM(p0, p1, m_reg, mn, al);
      NA_RESC(al);
      da::finishSM(p0, p1, al, l_reg, pa0, pa1, pa2, pa3); DA_SBAR();
      da::pv_d0(o, vb0 + bb * SHM_V, pa0, pa1, pa2, pa3);
    }
    asm volatile("s_waitcnt vmcnt(0)" ::: "memory"); __syncthreads();
  }
  if (hi == 0) li_l[r32] = l_reg; asm volatile("s_waitcnt lgkmcnt(0)" ::: "memory");
  float rli[16];
#pragma unroll
  for (int r = 0; r < 16; ++r) rli[r] = 1.0f / li_l[crow(r, hi)];
  __syncthreads();
  { LAS bf16* OT = (LAS bf16*)(lds + wid * 8192);
#pragma unroll
    for (int r = 0; r < 16; ++r) {
#pragma unroll
      for (int d0 = 0; d0 < 4; ++d0) OT[crow(r, hi) * 128 + d0 * 32 + r32] = (bf16)f2bf(o[d0][r] * rli[r]); }
    asm volatile("s_waitcnt lgkmcnt(0)" ::: "memory");
#pragma unroll
    for (int i = 0; i < 8; ++i) { const int chunk = lane + 64 * i, row = chunk >> 4, c8 = (chunk & 15) * 8;
      *(GAS v4u*)(MIX + (size_t)(qrow0 + wid * 32 + row) * DM + 1024 + hh * 128 + c8) = *(const LAS v4u*)(OT + row * 128 + c8); } }
  __syncthreads();
#undef NA_TROW
#undef NA_DMA
#undef NA_RESC
#undef NA_BM
}
}

namespace sgu {
using da::bf16x8; using da::f32x16; using da::crow; using da::SHM_V;
__device__ __forceinline__ void unit(const bf16* __restrict__ P, bf16* __restrict__ MIX, int row0, int g, const bf16* __restrict__ Wg  , const float* __restrict__ gain  ,
                                     const float* __restrict__ bias  , LAS char* lds, int tid) {
  const int wid = __builtin_amdgcn_readfirstlane(tid >> 6), lane = tid & 63, r32 = lane & 31, hi = lane >> 5, pb = wid & 3, ch = wid >> 2;
  { const int q = tid >> 2, c0 = (tid & 3) * 32; const bf16* vp = P + (size_t)(row0 + q) * INW + 1024 + g * 128 + c0; float v[32];
#pragma unroll
    for (int c8 = 0; c8 < 4; ++c8) { const v4u w = ((const GAS v4u*)vp)[c8];
      v[8 * c8 + 0] = bflo(w.x); v[8 * c8 + 1] = bfhi(w.x); v[8 * c8 + 2] = bflo(w.y); v[8 * c8 + 3] = bfhi(w.y); v[8 * c8 + 4] = bflo(w.z); v[8 * c8 + 5] = bfhi(w.z); v[8 * c8 + 6] = bflo(w.w); v[8 * c8 + 7] = bfhi(w.w); }
    float s = 0.f;
#pragma unroll
    for (int j = 0; j < 32; ++j) s += v[j];
    s += shx<1>(s); s += shx<2>(s);
    const float mu = s * (1.0f / 128.0f); float qq = 0.f;
#pragma unroll
    for (int j = 0; j < 32; ++j) { v[j] -= mu; qq += v[j] * v[j]; }
    qq += shx<1>(qq); qq += shx<2>(qq);
    const float rstd = 1.0f / sqrtf(qq * (1.0f / 128.0f) + 1e-5f);
    LAS char* vt = lds + (q >> 6) * SHM_V;
#pragma unroll
    for (int c8 = 0; c8 < 4; ++c8) { const f32x4 g0 = *(const GAS f32x4*)(gain + c0 + 8 * c8), g1 = *(const GAS f32x4*)(gain + c0 + 8 * c8 + 4); v4u w;
      w.x = pk2(v[8 * c8 + 0] * rstd * g0.x, v[8 * c8 + 1] * rstd * g0.y); w.y = pk2(v[8 * c8 + 2] * rstd * g0.z, v[8 * c8 + 3] * rstd * g0.w);
      w.z = pk2(v[8 * c8 + 4] * rstd * g1.x, v[8 * c8 + 5] * rstd * g1.y); w.w = pk2(v[8 * c8 + 6] * rstd * g1.z, v[8 * c8 + 7] * rstd * g1.w);
      *(LAS v4u*)(vt + da::v_st(q & 63, c0 + 8 * c8)) = w; } }
  bf16x8 wa[8];
  { const bf16* wp = Wg + (size_t)(32 * pb + r32) * 128 + hi * 8;
#pragma unroll
    for (int ks = 0; ks < 8; ++ks) wa[ks] = *reinterpret_cast<const bf16x8*>(wp + ks * 16); }
  __syncthreads();
  f32x16 o0 = {}, o1 = {};
  const int vb = (int)(uintptr_t)lds + da::v_rd_base(lane) + ch * 1024;
  da::pv_one<0>(o0, vb, wa[0], wa[1], wa[2], wa[3]); da::pv_one<1>(o1, vb, wa[0], wa[1], wa[2], wa[3]);
  da::pv_one<0>(o0, vb + SHM_V, wa[4], wa[5], wa[6], wa[7]); da::pv_one<1>(o1, vb + SHM_V, wa[4], wa[5], wa[6], wa[7]);
  LAS float* XT = (LAS float*)(lds + 2 * SHM_V);
#pragma unroll
  for (int r = 0; r < 16; ++r) { const int p = 32 * pb + crow(r, hi); const float bs = bias[p];
    XT[p * 128 + ch * 64 + r32] = o0[r] + bs; XT[p * 128 + ch * 64 + 32 + r32] = o1[r] + bs; }
  __syncthreads();
#pragma unroll
  for (int i = 0; i < 4; ++i) { const int chunk = tid + 512 * i, p = chunk >> 4, c8 = (chunk & 15) * 8; const size_t row = (size_t)(row0 + p);
    const f32x4 m0 = *(const LAS f32x4*)(XT + p * 128 + c8), m1 = *(const LAS f32x4*)(XT + p * 128 + c8 + 4);
    const v4u uw = *(const GAS v4u*)(P + row * INW + g * 128 + c8); v4u w;
    w.x = pk2(bflo(uw.x) * m0.x, bfhi(uw.x) * m0.y); w.y = pk2(bflo(uw.y) * m0.z, bfhi(uw.y) * m0.w); w.z = pk2(bflo(uw.z) * m1.x, bfhi(uw.z) * m1.y); w.w = pk2(bflo(uw.w) * m1.z, bfhi(uw.w) * m1.w);
    *(GAS v4u*)(MIX + row * DM + g * 128 + c8) = w; }
  __syncthreads();
}
}

constexpr int PPL = 11, NPH = 2 + PPL * DEPTH + 1;
struct Args { const float* in[22]; float* out; unsigned char* ws; int ph_lo, ph_hi; };
__global__ void __launch_bounds__(NWAVES * 64, 2) fwd(Args args) {
    extern __shared__ __attribute__((aligned(16))) unsigned char lds_raw[];
    LAS unsigned char* lds = (LAS unsigned char*)lds_raw;
    volatile LAS unsigned* MISC = (volatile LAS unsigned*)(lds + MISC_OFF);
    const int G = gridDim.x;
    typedef const __attribute__((address_space(4))) Args* KArgs;
    const KArgs ka0 = (KArgs)__builtin_amdgcn_kernarg_segment_ptr();
#define KA() ({ KArgs _p = ka0; asm volatile("" : "+s"(_p)); _p; })
#define ARG(i) (KA()->in[i])
#define WSP(T, off) ((T*)(KA()->ws + (off)))
#define THREAD_IDS() int tid = threadIdx.x; asm volatile("" : "+v"(tid)); int bx = blockIdx.x; asm volatile("" : "+s"(bx)); \
    const int lane = tid & 63, wave = __builtin_amdgcn_readfirstlane(tid >> 6); const int gw = bx * NWAVES + wave, NGW = G * NWAVES; const int gt = bx * (NWAVES * 64) + tid, NT = G * NWAVES * 64; \
    (void)lane; (void)wave; (void)gw; (void)NGW; (void)gt; (void)NT;
    {
    THREAD_IDS();
    for (int u = tid; u < (LDS_BYTES - LDSCTL_OFF) / 4; u += NWAVES * 64) ((LAS unsigned*)(lds + LDSCTL_OFF))[u] = 0u;
    __syncthreads();
    }
#if MK_ONE_LAUNCH
    XcdBarrier bar = xcd_barrier_post(WSP(unsigned, WS_CTL) + CW_BAR, MISC + 8);
#define GRID_BAR() xcd_barrier(bar)
#else
    (void)MISC;
#define GRID_BAR() do { } while (0)
#endif
    const int lo = args.ph_lo, hi = args.ph_hi;
#define IN(k) (lo <= (k) && (k) < hi)
#if defined(PROBE_A)
#define STAMP(k) do { if (blockIdx.x == 0 && threadIdx.x == 0) WSP(unsigned long long, WS_STAMP)[k] = __builtin_amdgcn_s_memrealtime(); } while (0)
#else
#define STAMP(k) do { } while (0)
#endif
#define SEAM(k) do { if (IN(k) && IN((k) + 1)) GRID_BAR(); STAMP((k) + 1); } while (0)
    STAMP(0);

    constexpr int I_IN = (DM / 64) * (INW / 32), I_OUT = (DM / 64) * (DM / 32), I_1 = (DM / 64) * (DFF / 32), I_2 = (DFF / 64) * (DM / 32), I_L = I_IN + I_OUT + I_1 + I_2;
#define CONVERT(l_, lo_, hi_, widx_, nw_) do { LAS float* _scr = (LAS float*)(lds + RING_OFF + wave * 16384); const int _l = (l_); \
        const float* _win = ARG(8); const float* _wout = ARG(9); const float* _w1 = ARG(19); const float* _w2 = ARG(20); \
        bf16* _WIN = WSP(bf16, WS_WIN); bf16* _WOUT = WSP(bf16, WS_WOUT); bf16* _W1 = WSP(bf16, WS_W1); bf16* _W2 = WSP(bf16, WS_W2); \
        for (int _it = (lo_) + (widx_); _it < (hi_); _it += (nw_)) { int _r = _it; \
            if (_r < I_IN) { p0_transpose_item(_win + (size_t)_l * DM * INW, DM, INW, _WIN + (size_t)_l * INW * DM, _scr, _r, lane); continue; } _r -= I_IN; \
            if (_r < I_OUT) { p0_transpose_item(_wout + (size_t)_l * DM * DM, DM, DM, _WOUT + (size_t)_l * DM * DM, _scr, _r, lane); continue; } _r -= I_OUT; \
            if (_r < I_1) { p0_transpose_item(_w1 + (size_t)_l * DM * DFF, DM, DFF, _W1 + (size_t)_l * DFF * DM, _scr, _r, lane); continue; } _r -= I_1; \
            p0_transpose_item(_w2 + (size_t)_l * DFF * DM, DFF, DM, _W2 + (size_t)_l * DM * DFF, _scr, _r, lane); } } while (0)
    constexpr int CV0 = 0, CV1 = (I_L * 32) / 100, CV2 = (I_L * 58) / 100, CV3 = (I_L * 86) / 100, CV4 = I_L;
    if (IN(0)) {
        THREAD_IDS();
        const float* c_in = ARG(1); const float* cctx_in = ARG(3); const float* ada_w = ARG(4);
        const float* lq1 = ARG(14); const float* lk1 = ARG(15); const float* lq2 = ARG(16); const float* lk2 = ARG(17);
        float* ADAP = WSP(float, WS_ADAP); float* LAM = WSP(float, WS_LAM);
        LAS float* s_lds = (LAS float*)(lds + RING_OFF);
        for (int it = bx; it < DEPTH * 32 * 6; it += G) {
            const int l = it / 192, rem = it % 192, kc = rem / 6, cb = rem % 6;
            __syncthreads();
            if (tid < 5 * 64) { const int r = tid >> 6, k = tid & 63; const float cv = r < 4 ? c_in[r * DM + kc * 64 + k] : cctx_in[kc * 64 + k]; s_lds[tid] = cv / (1.0f + expf(-cv)); }
            __syncthreads();
            const int col = cb * 2048 + tid * 4; f32x4 a0 = {0.f, 0.f, 0.f, 0.f}, a1 = a0, a2 = a0, a3 = a0, a4 = a0;
            const float* wp = ada_w + ((size_t)l * DM + kc * 64) * ADA + col;
#pragma unroll 16
            for (int k = 0; k < 64; ++k) { const f32x4 w = *(const GAS f32x4*)(wp + (size_t)k * ADA); a0 += s_lds[k] * w; a1 += s_lds[64 + k] * w; a2 += s_lds[128 + k] * w; a3 += s_lds[192 + k] * w; a4 += s_lds[256 + k] * w; }
            float* pp = ADAP + ((size_t)(l * 32 + kc) * 5) * ADA + col;
            *(GAS f32x4*)pp = a0; *(GAS f32x4*)(pp + ADA) = a1; *(GAS f32x4*)(pp + 2 * ADA) = a2; *(GAS f32x4*)(pp + 3 * ADA) = a3; *(GAS f32x4*)(pp + 4 * ADA) = a4;
        }
        __syncthreads();
        CONVERT(0, 0, I_L, gw, NGW);
        { bf16* CS = WSP(bf16, WS_CS);
          for (int i = gt; i < 4096 * 4096 / 8; i += NT) { const int row = i >> 9, n0 = (i & 511) * 8; const bool sinrow = row > 2048; const int k = sinrow ? row - 2048 : row; unsigned w[4];
#pragma unroll
              for (int e = 0; e < 8; e += 2) { float s0, c0, s1, c1; sincospif((float)((k * (n0 + e)) & 4095) * (1.0f / 2048.0f), &s0, &c0); sincospif((float)((k * (n0 + e + 1)) & 4095) * (1.0f / 2048.0f), &s1, &c1);
                  w[e >> 1] = sinrow ? pk2(s0, s1) : pk2(c0, c1); }
              *(GAS v4u*)(CS + (size_t)i * 8) = (v4u){w[0], w[1], w[2], w[3]}; }
          bf16* CT = WSP(bf16, WS_CT);
          for (int i = gt; i < 256 * 512; i += NT) { const int j = i >> 9, cc = i & 255, c = cc & 127; float sn, cs; sincospif((float)((j * c) & 127) * (1.0f / 64.0f), &sn, &cs);
              CT[i] = j < 128 ? (bf16)f2bf(cc < 128 ? cs : -sn) : (bf16)0; } }
        { const float* sgu_w = ARG(11); bf16* SGW = WSP(bf16, WS_SGW); for (int i = gt; i < 2 * 8 * 128 * 128; i += NT) SGW[i] = (bf16)f2bf(sgu_w[i]); }
        { float* ROPE = WSP(float, WS_ROPE); for (int i = gt; i < 64 * 16; i += NT) { const int pos = i >> 4, ii = i & 15; const float inv = exp2f(-(float)ii * (13.287712379549449f / 16.0f)); float sn, cs; sincosf((float)pos * inv, &sn, &cs); ROPE[2 * i] = cs; ROPE[2 * i + 1] = sn; } }
        if (bx == 0 && tid < 2) { float d1 = 0.f, d2 = 0.f; for (int j = 0; j < 64; ++j) { d1 += lq1[tid * 64 + j] * lk1[tid * 64 + j]; d2 += lq2[tid * 64 + j] * lk2[tid * 64 + j]; }
            LAM[tid] = expf(d1) - expf(d2) + (tid == 0 ? LAM_INIT1 : LAM_INIT3); }
    }
    SEAM(0);
    if (IN(1)) {
        THREAD_IDS();
        const float* ada_b = ARG(5); const float* ADAP = WSP(float, WS_ADAP); float* MOD = WSP(float, WS_MOD);
        for (int i = gt; i < DEPTH * 5 * ADA; i += NT) { const int l = i / (5 * ADA), rc = i % (5 * ADA), col = rc % ADA; float s = ada_b[l * ADA + col];
#pragma unroll
            for (int kc = 0; kc < 32; ++kc) s += ADAP[(size_t)(l * 32 + kc) * 5 * ADA + rc];
            MOD[i] = s; }
    }
    SEAM(1);

    for (int l = 0; l < DEPTH; ++l) {
        const int pb = 2 + PPL * l; const bool odd = (l & 1) != 0, need_ctx = l < DEPTH - 1; const int li = l >> 1;
        const int MR = need_ctx ? MALL : MLAT;
#define MODL() (WSP(float, WS_MOD) + (size_t)l * 5 * ADA)
        if (IN(pb + 0)) { THREAD_IDS(); norm_rows<0>(nullptr, l == 0 ? ARG(2) : WSP(float, WS_X) + (size_t)MLAT * DM, WSP(float, WS_X), WSP(bf16, WS_H), nullptr, ARG(6) + l * DM, MODL(), 0, MLAT, MALL, gw, NGW, lane, l > 0 ? WSP(bf16, WS_PART) : nullptr, l == 0);
            if (need_ctx && bx >= 128) CONVERT(l + 1, CV0, CV1, (bx - 128) * NWAVES + wave, (G - 128) * NWAVES); }
        SEAM(pb + 0);
        if (IN(pb + 1)) {
            THREAD_IDS();
            constexpr int NC1 = (MCTX / 256) * (INW / 256);
            if (G > NC1 && bx < NC1) {
                pg8::Gemm g{WSP(bf16, WS_H) + (size_t)MLAT * DM, WSP(bf16, WS_WIN) + (size_t)l * INW * DM, MCTX, INW, DM, DM}; pg8::StaticOrder S; S.init(MCTX, INW, NC1, bx);
                pg8::EpiIn E{WSP(bf16, WS_P) + (size_t)MLAT * INW, INW, nullptr, nullptr};
                pg8::gemm_phase<pg8::EpiIn, pg8::StaticOrder, true, true>(lds + RING_OFF, g, S, E, tid);
            } else {
                const int c0 = G > NC1 ? NC1 : 0;
                norm_lat_rows(l == 0 ? ARG(0) : nullptr, WSP(bf16, WS_XL), WSP(bf16, WS_H), ARG(6) + l * DM, MODL(), 0, (bx - c0) * NWAVES + wave, (G - c0) * NWAVES, lane);
                if (need_ctx) CONVERT(l + 1, CV1, CV2, (bx - c0) * NWAVES + wave, (G - c0) * NWAVES);
            }
        }
        SEAM(pb + 1);
        if (IN(pb + 2)) {
            THREAD_IDS();
            pg8::Gemm g{WSP(bf16, WS_H), WSP(bf16, WS_WIN) + (size_t)l * INW * DM, MLAT, INW, DM, DM}; pg8::StaticOrder S; S.init(MLAT, INW, G, bx);
            pg8::EpiIn E{WSP(bf16, WS_P), INW, odd ? WSP(float, WS_ROPE) : nullptr, WSP(bf16, WS_FT)};
            pg8::gemm_phase<pg8::EpiIn, pg8::StaticOrder, true, true>(lds + RING_OFF, g, S, E, tid);
        }
        SEAM(pb + 2);
        if (IN(pb + 3)) {
            THREAD_IDS();
            const bf16* P = WSP(bf16, WS_P); bf16* MIX = WSP(bf16, WS_MIX);
            const float* sgu_b = ARG(12); const float* na_rpb = ARG(13);
            if (!odd) {
                {
                    const bf16* SGW = WSP(bf16, WS_SGW); const float* sgu_g = ARG(10);
                    for (int u = bx; u < (MALL / 128) * 8; u += G) { const int g8 = u & 7, ck = u >> 3;
                        sgu::unit(P, MIX, ck * 128, g8, SGW + (size_t)(li * 8 + g8) * 16384, sgu_g + li * 1024 + g8 * 128, sgu_b + (li * 8 + g8) * 128, (LAS char*)(lds + RING_OFF), tid); }
                }
                __syncthreads();
                {
                    const int vcu = (G % 8 == 0) ? (bx % 8) * (G / 8) + bx / 8 : bx;
                    const int NU = NB * 8 * 16 + (need_ctx ? NB * 8 : 0);
                    for (int u = vcu; u < NU; u += G) {
                        const bool lat = u < NB * 8 * 16; int b, hh, r0, qrow0;
                        if (lat) { b = u >> 7; hh = (u >> 4) & 7; r0 = (u & 15) * 4; qrow0 = b * SEQ + r0 * 64; }
                        else { const int v = u - NB * 8 * 16; b = v >> 3; hh = v & 7; r0 = 0; qrow0 = MLAT + b * NCTX; }
                        na::unit(P, MIX, qrow0, hh, lat, b, r0, na_rpb + (size_t)(li * 8 + hh) * 465, (LAS char*)(lds + RING_OFF), tid);
                    }
                }
            } else {
                {
                    const int vcu = (G % 8 == 0) ? (bx % 8) * (G / 8) + bx / 8 : bx;
                    const float lam = WSP(float, WS_LAM)[li], post = 1.0f - (li == 0 ? LAM_INIT1 : LAM_INIT3); const float* sub_g = ARG(18) + li * 128;
                    const int NU = NB * 12 * 32 + (need_ctx ? NB * 12 * 2 : 0);
                    for (int u = vcu; u < NU; u += G) {
                        int bh, qrow0, nlt;
                        if (u < NB * 12 * 32) { bh = u >> 5; qrow0 = (bh / 12) * SEQ + (u & 31) * 128; nlt = SEQ / 64; }
                        else { const int v = u - NB * 12 * 32; bh = v >> 1; qrow0 = MLAT + (bh / 12) * NCTX + (v & 1) * 128; nlt = 0; }
                        const int b = bh / 12, hh = bh % 12;
                        da::unit(P, MIX, qrow0, hh, b * SEQ, nlt, MLAT + b * NCTX, lam, post, sub_g, (LAS char*)(lds + RING_OFF), tid);
                    }
                    __syncthreads();
                }
                {
                    pg8::Gemm g{WSP(bf16, WS_CS), WSP(bf16, WS_FT), 4096, 2048, SEQ / 2, SEQ}; pg8::SplitKOrder S{16, 8, 2, SEQ / 2, G, bx};
                    pg8::EpiUV E{WSP(bf16, WS_UV)};
                    pg8::gemm_phase<pg8::EpiUV, pg8::SplitKOrder, true, true>(lds + RING_OFF, g, S, E, tid);
                }
                if (need_ctx) {
                    __syncthreads();
                    LAS f32x2* tw = (LAS f32x2*)(lds + RING_OFF); LAS float* ft = (LAS float*)(lds + RING_OFF + 4096); bf16* UV = WSP(bf16, WS_UV);
                    if (tid < NCTX) { float sn, cs; sincospif(2.0f * (float)tid / (float)NCTX, &sn, &cs); tw[tid] = (f32x2){cs, sn}; }
                    const int vcu2 = (G % 8 == 0) ? (bx % 8) * (G / 8) + bx / 8 : bx;
                    for (int it = (vcu2 >= 128 ? vcu2 - 128 : vcu2 + 128); it < NB * 32; it += G) { const int b = it >> 5, cb = it & 31;
                        __syncthreads();
                        { const int n = tid >> 1, hf = tid & 1; const v4u w = *(const GAS v4u*)(P + (size_t)(MLAT + b * NCTX + n) * INW + 4608 + cb * 16 + hf * 8); LAS float* d = ft + n * 16 + hf * 8;
                          d[0] = bflo(w.x); d[1] = bfhi(w.x); d[2] = bflo(w.y); d[3] = bfhi(w.y); d[4] = bflo(w.z); d[5] = bfhi(w.z); d[6] = bflo(w.w); d[7] = bfhi(w.w); }
                        __syncthreads();
                        const int k = tid & 255, uv = tid >> 8; float acc[16];
#pragma unroll
                        for (int e = 0; e < 16; ++e) acc[e] = 0.f;
#pragma unroll 4
                        for (int n = 0; n < NCTX; ++n) { const f32x2 t = tw[(k * n) & (NCTX - 1)]; const float c = uv ? t.y : t.x; const LAS f32x4* fr4 = (const LAS f32x4*)(ft + n * 16);
#pragma unroll
                            for (int e4 = 0; e4 < 4; ++e4) { const f32x4 f = fr4[e4]; acc[4 * e4] += c * f.x; acc[4 * e4 + 1] += c * f.y; acc[4 * e4 + 2] += c * f.z; acc[4 * e4 + 3] += c * f.w; } }
                        bf16* op = UV + ((size_t)(SEQ + k) * 16 + b * 4 + (cb >> 3)) * 512 + uv * 128 + (cb & 7) * 16;
                        v4u w0, w1; w0.x = pk2(acc[0], acc[1]); w0.y = pk2(acc[2], acc[3]); w0.z = pk2(acc[4], acc[5]); w0.w = pk2(acc[6], acc[7]);
                        w1.x = pk2(acc[8], acc[9]); w1.y = pk2(acc[10], acc[11]); w1.z = pk2(acc[12], acc[13]); w1.w = pk2(acc[14], acc[15]);
                        ((GAS v4u*)op)[0] = w0; ((GAS v4u*)op)[1] = w1; ((GAS v4u*)(op + 256))[0] = (v4u){0u, 0u, 0u, 0u}; ((GAS v4u*)(op + 256))[1] = (v4u){0u, 0u, 0u, 0u};
                    }
                    __syncthreads();
                }
            }
        }
        SEAM(pb + 3);
        if (IN(pb + 4) && odd) {
            THREAD_IDS();
            const int MU = (need_ctx ? SEQ + NCTX : SEQ) * 16;
            pg8::Gemm g{WSP(bf16, WS_UV), WSP(bf16, WS_CT), MU, 256, 512, 512}; pg8::StaticOrder S; S.init(MU, 256, G, bx);
            pg8::EpiChan E{WSP(bf16, WS_MIX), 0.0013810679320049757f, 0.005524271728019903f};
            pg8::gemm_phase<pg8::EpiChan, pg8::StaticOrder, true, true>(lds + RING_OFF, g, S, E, tid);
        }
        if (odd) SEAM(pb + 4);
        if (IN(pb + 5)) {
            THREAD_IDS();
            pg8::Gemm g{WSP(bf16, WS_MIX), WSP(bf16, WS_WOUT) + (size_t)l * DM * DM, MALL, DM, DM, DM};
            pg8::ResidOrder S; S.lat.init(MLAT, DM, G, bx); S.nctx = need_ctx ? 1 : 0; S.kslice = DM / 8; S.c = bx;
            pg8::EpiResidPart E{l == 0 ? ARG(0) : nullptr, WSP(bf16, WS_XL), DM, MODL() + 2 * DM, ADA, WSP(bf16, WS_PART), DM / 8};
            pg8::gemm_phase<pg8::EpiResidPart, pg8::ResidOrder, true, true>(lds + RING_OFF, g, S, E, tid);
        }
        SEAM(pb + 5);
        if (IN(pb + 6) && need_ctx) { THREAD_IDS(); norm_rows<0>(nullptr, WSP(float, WS_X) + (size_t)MLAT * DM, WSP(float, WS_X), WSP(bf16, WS_H), nullptr, ARG(7) + l * DM, MODL(), 3, MLAT, MALL, gw, NGW, lane, WSP(bf16, WS_PART), false);
            if (bx >= 128) CONVERT(l + 1, CV2, CV3, (bx - 128) * NWAVES + wave, (G - 128) * NWAVES); }
        if (need_ctx) SEAM(pb + 6);
        if (IN(pb + 7)) {
            THREAD_IDS();
            constexpr int NC3 = (MCTX / 256) * (DFF / 256);
            const bool split = need_ctx && G > NC3;
            if (split && bx < NC3) {
                pg8::Gemm g{WSP(bf16, WS_H) + (size_t)MLAT * DM, WSP(bf16, WS_W1) + (size_t)l * DFF * DM, MCTX, DFF, DM, DM}; pg8::StaticOrder S; S.init(MCTX, DFF, NC3, bx);
                pg8::EpiBf16<1> E{WSP(bf16, WS_HID) + (size_t)MLAT * DFF, DFF};
                pg8::gemm_phase<pg8::EpiBf16<1>, pg8::StaticOrder, true, true>(lds + RING_OFF, g, S, E, tid);
            } else {
                const int c0 = split ? NC3 : 0;
                norm_lat_rows(nullptr, WSP(bf16, WS_XL), WSP(bf16, WS_H), ARG(7) + l * DM, MODL(), 3, (bx - c0) * NWAVES + wave, (G - c0) * NWAVES, lane);
                if (need_ctx) CONVERT(l + 1, CV3, CV4, (bx - c0) * NWAVES + wave, (G - c0) * NWAVES);
            }
        }
        SEAM(pb + 7);
        if (IN(pb + 8)) {
            THREAD_IDS();
            pg8::Gemm g{WSP(bf16, WS_H), WSP(bf16, WS_W1) + (size_t)l * DFF * DM, MLAT, DFF, DM, DM}; pg8::StaticOrder S; S.init(MLAT / 2, DFF, G, bx, 0);
            pg8::EpiBf16<1> E{WSP(bf16, WS_HID), DFF};
            pg8::gemm_phase<pg8::EpiBf16<1>, pg8::StaticOrder, true, true>(lds + RING_OFF, g, S, E, tid);
        }
        SEAM(pb + 8);
        if (IN(pb + 9)) {
            THREAD_IDS();
            { pg8::Gemm g{WSP(bf16, WS_HID), WSP(bf16, WS_W2) + (size_t)l * DM * DFF, MALL, DM, DFF, DFF};
              pg8::ResidOrder S; S.lat.init(MLAT / 2, DM, G, bx, 0); S.nctx = need_ctx ? 1 : 0; S.kslice = DFF / 8; S.c = bx;
              pg8::EpiResidPart E{nullptr, WSP(bf16, WS_XL), DM, MODL() + 5 * DM, ADA, WSP(bf16, WS_PART), DFF / 8};
              pg8::gemm_phase<pg8::EpiResidPart, pg8::ResidOrder, true, true>(lds + RING_OFF, g, S, E, tid); }
            { pg8::Gemm g{WSP(bf16, WS_H), WSP(bf16, WS_W1) + (size_t)l * DFF * DM, MLAT, DFF, DM, DM}; pg8::StaticOrder S; S.init(MLAT / 2, DFF, G, bx, 32);
              pg8::EpiBf16<1> E{WSP(bf16, WS_HID), DFF};
              pg8::gemm_phase<pg8::EpiBf16<1>, pg8::StaticOrder, true, true>(lds + RING_OFF, g, S, E, tid); }
        }
        SEAM(pb + 9);
        if (IN(pb + 10)) {
            THREAD_IDS();
            pg8::Gemm g{WSP(bf16, WS_HID), WSP(bf16, WS_W2) + (size_t)l * DM * DFF, MALL, DM, DFF, DFF};
            pg8::ResidOrder S; S.lat.init(MLAT / 2, DM, G, bx, 32); S.nctx = 0; S.kslice = DFF / 8; S.c = bx;
            pg8::EpiResidPart E{nullptr, WSP(bf16, WS_XL), DM, MODL() + 5 * DM, ADA, WSP(bf16, WS_PART), DFF / 8};
            pg8::gemm_phase<pg8::EpiResidPart, pg8::ResidOrder, true, true>(lds + RING_OFF, g, S, E, tid);
        }
        SEAM(pb + 10);
    }
    if (IN(NPH - 1)) { THREAD_IDS(); final_norm_rows(WSP(bf16, WS_XL), KA()->out, ARG(21), gw, NGW, lane); }
#if defined(PROBE_A)
    STAMP(NPH);
    if (blockIdx.x == 0 && threadIdx.x == 0) { asm volatile("s_waitcnt vmcnt(0)" ::: "memory"); const unsigned long long* st = WSP(unsigned long long, WS_STAMP); float acc = 0.f;
        for (int k = PROBE_A; k < PROBE_B; k += PROBE_STEP) acc += (float)(st[k + PROBE_LEN] - st[k]) * 0.01f;
        asm volatile("s_waitcnt vmcnt(0)" ::: "memory"); float* o0 = KA()->out; const float v0 = __hip_atomic_load(o0, __ATOMIC_RELAXED, __HIP_MEMORY_SCOPE_AGENT); __hip_atomic_store(o0, v0 + acc * PROBE_SCALE, __ATOMIC_RELAXED, __HIP_MEMORY_SCOPE_AGENT); }
#endif
#undef IN
#undef SEAM
#undef GRID_BAR
}

extern "C" void kernel_launch(void* const* d_in, const int* in_sizes, int n_in, void* d_out, int out_size, void* d_ws, size_t ws_size, hipStream_t stream) {
    static int grid = 0;
    if (grid == 0) {
        if (n_in != 22 || in_sizes[0] != MLAT * DM || out_size != MLAT * DM || ws_size < WS_END) { fprintf(stderr, "kernel_launch: unexpected shapes (n_in %d, in0 %d, out %d, ws %zu); nothing launched\n", n_in, n_in > 0 ? in_sizes[0] : -1, out_size, ws_size); grid = -1; return; }
        int dev = 0, cus = 0, per_cu = 0;
        if (hipGetDevice(&dev) != hipSuccess || hipDeviceGetAttribute(&cus, hipDeviceAttributeMultiprocessorCount, dev) != hipSuccess) { grid = -1; return; }
        if (hipFuncSetAttribute((const void*)fwd, hipFuncAttributeMaxDynamicSharedMemorySize, LDS_BYTES) != hipSuccess) { fprintf(stderr, "kernel_launch: hipFuncSetAttribute failed\n"); grid = -1; return; }
        if (hipOccupancyMaxActiveBlocksPerMultiprocessor(&per_cu, (const void*)fwd, NWAVES * 64, LDS_BYTES) != hipSuccess || per_cu < 1) fprintf(stderr, "kernel_launch: occupancy query reports %d workgroups per CU\n", per_cu);
        (void)hipGetLastError();
        grid = cus;
        if (grid != 256) { fprintf(stderr, "kernel_launch: built for 256 CUs (phase CU splits), device has %d; nothing launched\n", cus); grid = -1; return; }
    }
    if (grid < 0) return;
    if (hipMemsetAsync((char*)d_ws + WS_CTL, 0, CTL_ZERO_BYTES, stream) != hipSuccess) return;
    Args a{};
    for (int i = 0; i < 22; ++i) a.in[i] = (const float*)d_in[i];
    a.out = (float*)d_out; a.ws = (unsigned char*)d_ws;
#if MK_ONE_LAUNCH
    a.ph_lo = 0; a.ph_hi = NPH;
    hipLaunchKernelGGL(fwd, dim3(grid), dim3(NWAVES * 64), LDS_BYTES, stream, a);
#else
    for (int ph = 0; ph < NPH; ++ph) {
        a.ph_lo = ph; a.ph_hi = ph + 1;
        hipLaunchKernelGGL(fwd, dim3(grid), dim3(NWAVES * 64), LDS_BYTES, stream, a);
    }
#endif
    const hipError_t le = hipPeekAtLastError();
    if (le != hipSuccess) fprintf(stderr, "kernel_launch: launch failed: %s\n", hipGetErrorName(le));
}
```
